# Optimizing an MI355X kernel written in HIP

```python
import math
import jax
import jax.numpy as jnp
from jax import lax
import numpy as np

D_MODEL = 2048
BATCH = 8
SEQ = 2048
DEPTH = 4

GRID_W = 64
CTX_LEN = 256
CHUNK = 64
N_DIR = 2
N_BRANCH = 3
EPS = 1e-6

GLA_HEADS = 4
GLA_DK = 128
GLA_DV = 256
GLA_RANK = 16
GLA_TAU = 16.0

GDN_HEADS = 8
GDN_DK = 128
GDN_DV = 128
GDN_CONV_K = 3

POOL_WINDOWS = (2, 4, 8, 16)
POOL_GROUPS = 4
POOL_GROUP = 256

D_FF = 5632
FFN_CONV_K = 3

GLA_QK = GLA_HEADS * GLA_DK
GLA_V = GLA_HEADS * GLA_DV
GDN_QK = GDN_HEADS * GDN_DK
GDN_V = GDN_HEADS * GDN_DV
POOL_WIDTH = POOL_GROUPS * POOL_GROUP
IN_SPLITS = (GLA_QK, GLA_QK, GLA_V, GLA_V, N_DIR * GLA_RANK,
             2 * GDN_QK + GDN_V, N_DIR * GDN_HEADS, N_DIR * GDN_HEADS, GDN_V,
             POOL_WIDTH, N_BRANCH * D_MODEL)
IN_WIDTH = (2 * GLA_QK + 2 * GLA_V + N_DIR * GLA_RANK + 2 * GDN_QK + 2 * GDN_V
            + 2 * N_DIR * GDN_HEADS + POOL_WIDTH + N_BRANCH * D_MODEL)
F32 = jnp.float32

kernel_name = 'hybrid_gla_deltanet_pool_dit'


def _split_cols(t, sizes):
    parts, start = [], 0
    for size in sizes:
        parts.append(t[..., start:start + size])
        start += size
    return parts


def rmsnorm(t, w):
    tf = t.astype(F32)
    y = tf * lax.rsqrt(jnp.mean(tf * tf, axis=-1, keepdims=True) + EPS)
    return (y * w.astype(F32)).astype(t.dtype)


def l2norm(t):
    return t * lax.rsqrt(jnp.sum(t * t, axis=-1, keepdims=True) + EPS)


def ada_mod(cond, w, b):
    m = jax.nn.silu(cond) @ w + b
    return m.reshape(cond.shape[:-1] + (6, D_MODEL))


def modulate(h, shift, scale):
    return h * (1.0 + scale) + shift


def dwconv1d_centred(t, w):
    k, T = w.shape[0], t.shape[1]
    half = k // 2
    tp = jnp.pad(t, ((0, 0), (half, half), (0, 0)))
    out = tp[:, 0:T] * w[0]
    for j in range(1, k):
        out = out + tp[:, j:j + T] * w[j]
    return out


def dwconv2d_grid(t, w, rows, cols):
    B, T, C = t.shape
    img = t.reshape(B, rows, cols, C)
    y = lax.conv_general_dilated(img, w[:, :, None, :].astype(t.dtype), (1, 1), 'SAME',
                                 dimension_numbers=('NHWC', 'HWIO', 'NHWC'),
                                 feature_group_count=C)
    return y.reshape(B, T, C)


def _to_chunks(t):
    B, T, H, d = t.shape
    return t.reshape(B, T // CHUNK, CHUNK, H, d).transpose(0, 3, 1, 2, 4)


def _from_chunks(t):
    B, H, N, C, d = t.shape
    return t.transpose(0, 2, 3, 1, 4).reshape(B, N * C, H, d)


def gla_chunked(q, k, v, log_a, s0):
    q, k, v, log_a = (_to_chunks(t) for t in (q, k, v, log_a))
    b = jnp.cumsum(log_a, axis=3)
    b_last = b[:, :, :, -1:, :]
    q_dec = q * jnp.exp(b)
    scores = jnp.einsum('bhncd,bhnsd->bhncs', q_dec, k * jnp.exp(-b))
    incl = jnp.tril(jnp.ones((CHUNK, CHUNK), bool))
    scores = jnp.where(incl, scores, 0.0)
    o_intra = jnp.einsum('bhncs,bhnsv->bhncv', scores, v)
    kv = jnp.einsum('bhncd,bhncv->bhndv', k * jnp.exp(b_last - b), v)
    decay = jnp.exp(b_last[:, :, :, 0, :])

    def step(s, inp):
        d_i, kv_i = inp
        return d_i[..., None] * s + kv_i, s

    s_final, s_start = lax.scan(step, s0, (jnp.moveaxis(decay, 2, 0), jnp.moveaxis(kv, 2, 0)))
    o_inter = jnp.einsum('bhncd,nbhdv->bhncv', q_dec, s_start)
    return _from_chunks(o_intra + o_inter), s_final


def gdn_chunked(q, k, v, g, beta, s0):
    q, k, v = (_to_chunks(t) for t in (q, k, v))
    g, beta = (_to_chunks(t[..., None])[..., 0] for t in (g, beta))
    b = jnp.cumsum(g, axis=-1)
    b_last = b[..., -1:]
    incl = jnp.tril(jnp.ones((CHUNK, CHUNK), bool))
    strict = jnp.tril(jnp.ones((CHUNK, CHUNK), bool), -1)
    diff = b[..., :, None] - b[..., None, :]
    decay = jnp.where(incl, jnp.exp(jnp.where(incl, diff, 0.0)), 0.0)
    kb = k * beta[..., None]
    L = jnp.where(strict, jnp.einsum('bhncd,bhnsd->bhncs', kb, k) * decay, 0.0)
    eye = jnp.eye(CHUNK, dtype=F32)
    tinv = lax.linalg.triangular_solve(eye + L, jnp.broadcast_to(eye, L.shape),
                                       left_side=True, lower=True, unit_diagonal=True)
    u = tinv @ (v * beta[..., None])
    w = tinv @ (kb * jnp.exp(b)[..., None])
    attn = jnp.einsum('bhncd,bhnsd->bhncs', q, k) * decay
    q_dec = q * jnp.exp(b)[..., None]
    k_dec = k * jnp.exp(b_last - b)[..., None]
    chunk_decay = jnp.exp(b_last)[..., 0]

    def step(s, inp):
        u_i, w_i, attn_i, q_i, k_i, d_i = inp
        v_new = u_i - jnp.einsum('bhck,bhkv->bhcv', w_i, s)
        o_i = (jnp.einsum('bhck,bhkv->bhcv', q_i, s)
               + jnp.einsum('bhcs,bhsv->bhcv', attn_i, v_new))
        s = d_i[..., None, None] * s + jnp.einsum('bhck,bhcv->bhkv', k_i, v_new)
        return s, o_i

    xs = tuple(jnp.moveaxis(t, 2, 0) for t in (u, w, attn, q_dec, k_dec, chunk_decay))
    s_final, o = lax.scan(step, s0, xs)
    return _from_chunks(jnp.moveaxis(o, 0, 2)), s_final


def _rev(t, d):
    return t if d == 0 else jnp.flip(t, axis=1)


def bidirectional_scan(scan_fn, lat_args, lat_dir, ctx_args, ctx_dir, s0):
    out_lat, out_ctx = None, None
    for d in range(N_DIR):
        o_c, s_c = scan_fn(*[_rev(t, d) for t in ctx_args + ctx_dir[d]], s0)
        o_x, _ = scan_fn(*[_rev(t, d) for t in lat_args + lat_dir[d]], s_c)
        o_c, o_x = _rev(o_c, d), _rev(o_x, d)
        out_lat = o_x if out_lat is None else out_lat + o_x
        out_ctx = o_c if out_ctx is None else out_ctx + o_c
    return out_lat, out_ctx


def gla_prep(q, k, v, lr, w2, b):
    B, T, _ = q.shape
    q = q.astype(F32).reshape(B, T, GLA_HEADS, GLA_DK) * GLA_DK ** -0.5
    k = k.astype(F32).reshape(B, T, GLA_HEADS, GLA_DK)
    v = v.astype(F32).reshape(B, T, GLA_HEADS, GLA_DV)
    z = jnp.einsum('btdr,drk->dbtk', lr.reshape(B, T, N_DIR, GLA_RANK), w2) + b[:, None, None, :]
    log_a = jax.nn.log_sigmoid(z.astype(F32)) / GLA_TAU
    log_a = log_a.reshape(N_DIR, B, T, GLA_HEADS, GLA_DK)
    return (q, k, v), tuple((log_a[d],) for d in range(N_DIR))


def gdn_prep(qkv, a, bt, conv_w, a_log, dt_bias):
    B, T, _ = qkv.shape
    qkv = jax.nn.silu(dwconv1d_centred(qkv, conv_w)).astype(F32)
    q, k, v = _split_cols(qkv, (GDN_QK, GDN_QK, GDN_V))
    q = l2norm(q.reshape(B, T, GDN_HEADS, GDN_DK)) * GDN_DK ** -0.5
    k = l2norm(k.reshape(B, T, GDN_HEADS, GDN_DK))
    v = v.reshape(B, T, GDN_HEADS, GDN_DV)
    a = a.astype(F32).reshape(B, T, N_DIR, GDN_HEADS)
    g = -jnp.exp(a_log.astype(F32)) * jax.nn.softplus(a + dt_bias.astype(F32))
    beta = jax.nn.sigmoid(bt.astype(F32).reshape(B, T, N_DIR, GDN_HEADS))
    return (q, k, v), tuple((g[:, :, d], beta[:, :, d]) for d in range(N_DIR))


def multiscale_pool(u, pool_w, pool_scale):
    B, T, _ = u.shape
    uf = u.astype(F32)
    cs = jnp.concatenate([jnp.zeros((B, 1, POOL_WIDTH), F32), jnp.cumsum(uf, axis=1)], axis=1)
    t = jnp.arange(T)
    means = []
    for gi, win in enumerate(POOL_WINDOWS):
        lo = jnp.clip(t - win // 2, 0, T)
        hi = jnp.clip(t - win // 2 + win, 0, T)
        csg = cs[..., gi * POOL_GROUP:(gi + 1) * POOL_GROUP]
        win_sum = jnp.take(csg, hi, axis=1) - jnp.take(csg, lo, axis=1)
        means.append(win_sum / (hi - lo).astype(F32)[None, :, None])
    p = jnp.concatenate(means, axis=-1) - uf
    p = jnp.einsum('btgc,gcd->btgd', p.reshape(B, T, POOL_GROUPS, POOL_GROUP), pool_w.astype(F32))
    return p.reshape(B, T, POOL_WIDTH) * pool_scale.astype(F32)


def hybrid_mixer(hx, hc, w_in, gla_w2, gla_b, gla_nw, gdn_cw, gdn_alog, gdn_dtb, gdn_nw,
                 pool_w, pool_scale, w_br_gla, w_br_gdn, w_br_pool, w_out, need_ctx):
    dt = hx.dtype
    B = hx.shape[0]
    px = _split_cols(hx @ w_in, IN_SPLITS)
    pc = _split_cols(hc @ w_in, IN_SPLITS)
    ax, ax_dir = gla_prep(px[0], px[1], px[2], px[4], gla_w2, gla_b)
    ac, ac_dir = gla_prep(pc[0], pc[1], pc[2], pc[4], gla_w2, gla_b)
    s0_gla = jnp.zeros((B, GLA_HEADS, GLA_DK, GLA_DV), F32)
    o_gla_x, o_gla_c = bidirectional_scan(gla_chunked, ax, ax_dir, ac, ac_dir, s0_gla)
    bx, bx_dir = gdn_prep(px[5], px[6], px[7], gdn_cw, gdn_alog, gdn_dtb)
    bc, bc_dir = gdn_prep(pc[5], pc[6], pc[7], gdn_cw, gdn_alog, gdn_dtb)
    s0_gdn = jnp.zeros((B, GDN_HEADS, GDN_DK, GDN_DV), F32)
    o_gdn_x, o_gdn_c = bidirectional_scan(gdn_chunked, bx, bx_dir, bc, bc_dir, s0_gdn)

    def merge(p, o_gla, o_gdn):
        Bq, T, _ = p[0].shape
        z_gla = jax.nn.silu(p[3].astype(F32)).reshape(Bq, T, GLA_HEADS, GLA_DV)
        y_gla = (rmsnorm(o_gla, gla_nw) * z_gla).reshape(Bq, T, GLA_V).astype(dt)
        z_gdn = jax.nn.silu(p[8].astype(F32)).reshape(Bq, T, GDN_HEADS, GDN_DV)
        y_gdn = (rmsnorm(o_gdn, gdn_nw) * z_gdn).reshape(Bq, T, GDN_V).astype(dt)
        y_pool = multiscale_pool(p[9], pool_w, pool_scale).astype(dt)
        gates = jax.nn.sigmoid(p[10].astype(F32)).reshape(Bq, T, N_BRANCH, D_MODEL)
        m = (gates[:, :, 0] * (y_gla @ w_br_gla) + gates[:, :, 1] * (y_gdn @ w_br_gdn)
             + gates[:, :, 2] * (y_pool @ w_br_pool))
        return m.astype(dt) @ w_out

    y_x = merge(px, o_gla_x, o_gdn_x)
    y_c = merge(pc, o_gla_c, o_gdn_c) if need_ctx else None
    return y_x, y_c


def conv_ffn(h, w_up, w_conv, w_down, rows, cols):
    a, v = _split_cols(h @ w_up, (D_FF, D_FF))
    a = dwconv2d_grid(a, w_conv, rows, cols)
    return (jax.nn.silu(a) * v) @ w_down


def setup_inputs(seed: int = 0) -> dict:
    key = jax.random.key(seed)
    ks = jax.random.split(key, 26)
    L, D = DEPTH, D_MODEL

    def nrm(k, shape, scale):
        return jax.random.normal(k, shape, F32) * scale

    def gain(k, shape):
        return 1.0 + 0.02 * jax.random.normal(k, shape, F32)

    dt = jnp.exp(jax.random.uniform(ks[13], (L, N_DIR, GDN_HEADS), F32,
                                    math.log(1e-3), math.log(1e-1)))
    return {
        'x': nrm(ks[0], (BATCH, SEQ, D), 1.0),
        'c': nrm(ks[1], (BATCH, D), 1.0),
        'ctx': nrm(ks[2], (BATCH, CTX_LEN, D), 1.0),
        'c_ctx': nrm(ks[3], (D,), 1.0),
        'ada_w': nrm(ks[4], (L, D, 6 * D), 0.5 * D ** -0.5),
        'ada_b': nrm(ks[5], (L, 6 * D), 0.01),
        'norm1_w': gain(ks[6], (L, D)),
        'norm2_w': gain(ks[7], (L, D)),
        'w_in': nrm(ks[8], (L, D, IN_WIDTH), D ** -0.5),
        'gla_lr_w2': nrm(ks[9], (L, N_DIR, GLA_RANK, GLA_QK), GLA_RANK ** -0.5),
        'gla_lr_b': nrm(ks[10], (L, N_DIR, GLA_QK), 0.1),
        'gla_norm_w': gain(ks[11], (L, GLA_DV)),
        'gdn_conv_w': nrm(ks[12], (L, GDN_CONV_K, 2 * GDN_QK + GDN_V), GDN_CONV_K ** -0.5),
        'gdn_a_log': jnp.log(jax.random.uniform(ks[14], (L, N_DIR, GDN_HEADS), F32, 1.0, 16.0)),
        'gdn_dt_bias': dt + jnp.log(-jnp.expm1(-dt)),
        'gdn_norm_w': gain(ks[15], (L, GDN_DV)),
        'pool_w': nrm(ks[16], (L, POOL_GROUPS, POOL_GROUP, POOL_GROUP), POOL_GROUP ** -0.5),
        'pool_scale': gain(ks[17], (L, POOL_WIDTH)),
        'w_br_gla': nrm(ks[18], (L, GLA_V, D), GLA_V ** -0.5),
        'w_br_gdn': nrm(ks[19], (L, GDN_V, D), GDN_V ** -0.5),
        'w_br_pool': nrm(ks[20], (L, POOL_WIDTH, D), POOL_WIDTH ** -0.5),
        'w_out': nrm(ks[21], (L, D, D), D ** -0.5),
        'ffn_up': nrm(ks[22], (L, D, 2 * D_FF), D ** -0.5),
        'ffn_conv': nrm(ks[23], (L, FFN_CONV_K, FFN_CONV_K, D_FF), 1.0 / FFN_CONV_K),
        'ffn_down': nrm(ks[24], (L, D_FF, D), D_FF ** -0.5),
        'final_norm_w': gain(ks[25], (D,)),
    }


def reference(x, c, ctx, c_ctx, ada_w, ada_b, norm1_w, norm2_w, w_in, gla_lr_w2, gla_lr_b,
              gla_norm_w, gdn_conv_w, gdn_a_log, gdn_dt_bias, gdn_norm_w, pool_w, pool_scale,
              w_br_gla, w_br_gdn, w_br_pool, w_out, ffn_up, ffn_conv, ffn_down, final_norm_w):
    T = x.shape[1]
    rows = T // GRID_W
    ctx_len = ctx.shape[1]
    h_ctx = ctx
    for l in range(DEPTH):
        last = l == DEPTH - 1
        mx = ada_mod(c, ada_w[l], ada_b[l])
        mc = ada_mod(c_ctx, ada_w[l], ada_b[l])
        hx = modulate(rmsnorm(x, norm1_w[l]), mx[:, None, 0], mx[:, None, 1])
        hc = modulate(rmsnorm(h_ctx, norm1_w[l]), mc[0], mc[1])
        y_x, y_c = hybrid_mixer(hx, hc, w_in[l], gla_lr_w2[l], gla_lr_b[l], gla_norm_w[l],
                                gdn_conv_w[l], gdn_a_log[l], gdn_dt_bias[l], gdn_norm_w[l],
                                pool_w[l], pool_scale[l], w_br_gla[l], w_br_gdn[l],
                                w_br_pool[l], w_out[l], not last)
        x = x + mx[:, None, 2] * y_x
        hx2 = modulate(rmsnorm(x, norm2_w[l]), mx[:, None, 3], mx[:, None, 4])
        x = x + mx[:, None, 5] * conv_ffn(hx2, ffn_up[l], ffn_conv[l], ffn_down[l], rows, GRID_W)
        if not last:
            h_ctx = h_ctx + mc[2] * y_c
            hc2 = modulate(rmsnorm(h_ctx, norm2_w[l]), mc[3], mc[4])
            h_ctx = h_ctx + mc[5] * conv_ffn(hc2, ffn_up[l], ffn_conv[l], ffn_down[l], 1, ctx_len)
    return rmsnorm(x, final_norm_w)
```

```cpp
#include <hip/hip_runtime.h>
#include <cstdio>
#include <cstdint>

#define LAS __attribute__((address_space(3)))
typedef unsigned short bf16_t;
typedef short bf16x8 __attribute__((ext_vector_type(8)));
typedef float f32x4 __attribute__((ext_vector_type(4)));
typedef unsigned u32x4 __attribute__((ext_vector_type(4)));
typedef unsigned u32x2 __attribute__((ext_vector_type(2)));

constexpr int D = 2048, NB = 8, SEQ = 2048, CTXL = 256, DEPTH = 4;
constexpr int RL = NB * SEQ, RC = NB * CTXL, R = RL + RC;
constexpr int NP = 14336, NIN = 14592, NIN_ORIG = 14400;
constexpr int DFF = 5632, NAV = 2 * DFF;
constexpr int PC_GLA_Q = 0, PC_GLA_K = 512, PC_GLA_V = 1024, PC_GLA_Z = 2048, PC_GDN_Q = 3072, PC_GDN_K = 4096, PC_GDN_V = 5120, PC_GDN_Z = 6144, PC_POOL = 7168, PC_GATE = 8192;
constexpr int NCH = 36;
constexpr float EPS = 1e-6f;
constexpr int NTHR = 512;

constexpr size_t al256(size_t x) { return (x + 255) & ~(size_t)255; }
constexpr size_t WS_CTL = 0;
constexpr size_t CTL_BYTES = 65536;
constexpr size_t WS_MODS = WS_CTL + CTL_BYTES;
constexpr size_t MODS_BYTES = (size_t)DEPTH * 9 * 12288 * 4;
constexpr size_t ZERO_BYTES = CTL_BYTES;
constexpr size_t WS_SMALL = al256(WS_MODS + MODS_BYTES);
constexpr size_t WS_XRES = al256(WS_SMALL + (size_t)R * 64 * 4);
constexpr size_t WS_HA = al256(WS_XRES + (size_t)R * D * 4);
constexpr size_t WS_WIN = al256(WS_HA + (size_t)R * D * 2);
constexpr size_t WS_WBR = al256(WS_WIN + (size_t)NIN * D * 2);
constexpr size_t WS_WOUT = al256(WS_WBR + (size_t)3 * D * 1024 * 2);
constexpr size_t WS_WUP = al256(WS_WOUT + (size_t)D * D * 2);
constexpr size_t WS_WDN = al256(WS_WUP + (size_t)NAV * D * 2);
constexpr size_t WS_WPOOL = al256(WS_WDN + (size_t)D * DFF * 2);
constexpr size_t WS_BIG = al256(WS_WPOOL + (size_t)4 * 256 * 256 * 2);
constexpr size_t WS_P = WS_BIG;
constexpr size_t WS_MODP = WS_BIG;
constexpr size_t GLA_UNIT = 66048, GDN_UNIT = 73984;
constexpr size_t WS_GLAPREP = al256(WS_P + (size_t)R * NP * 2);
constexpr size_t WS_GDNPREP = al256(WS_GLAPREP + (size_t)NB * NCH * 4 * 2 * GLA_UNIT);
constexpr size_t GDNPREP_BYTES = (size_t)NB * NCH * 8 * 2 * GDN_UNIT;
constexpr size_t WS_OGLA = al256(WS_GDNPREP + GDNPREP_BYTES);
constexpr size_t WS_OGDN = al256(WS_OGLA + (size_t)2 * R * 1024 * 2);
constexpr size_t WS_MIX_END = al256(WS_OGDN + (size_t)2 * R * 1024 * 2);
constexpr size_t WS_YGLA = WS_GDNPREP;
constexpr size_t WS_YGDN = WS_YGLA + (size_t)R * 1024 * 2;
constexpr size_t WS_PLD = WS_YGDN + (size_t)R * 1024 * 2;
constexpr size_t WS_YPOOL = WS_PLD + (size_t)R * 1024 * 2;
constexpr size_t WS_M32 = WS_YPOOL + (size_t)R * 1024 * 2;
static_assert(WS_M32 + (size_t)R * D * 4 <= WS_GDNPREP + GDNPREP_BYTES, "overlay");
constexpr size_t WS_AV = WS_BIG;
constexpr size_t WS_G = al256(WS_AV + (size_t)R * NAV * 2);
static_assert(WS_G + (size_t)R * DFF * 2 <= WS_MIX_END, "ffn overlay");
constexpr size_t WS_END = WS_MIX_END;

constexpr int LDS_BYTES = 131072 + 1024;
constexpr int MISC_OFF = 131072;

__device__ __forceinline__ float bf2f(bf16_t b) { return __uint_as_float(((unsigned)b) << 16); }
__device__ __forceinline__ bf16_t f2bf(float f) { unsigned u = __float_as_uint(f); u += 0x7FFFu + ((u >> 16) & 1u); return (bf16_t)(u >> 16); }
__device__ __forceinline__ unsigned pk2(float lo, float hi) { return (unsigned)f2bf(lo) | ((unsigned)f2bf(hi) << 16); }
__device__ __forceinline__ float lo16(unsigned w) { return __uint_as_float(w << 16); }
__device__ __forceinline__ float hi16(unsigned w) { return __uint_as_float(w & 0xFFFF0000u); }
__device__ __forceinline__ float sigmoidf_(float x) { return 1.0f / (1.0f + __expf(-x)); }
__device__ __forceinline__ float siluf_(float x) { return x / (1.0f + __expf(-x)); }
__device__ __forceinline__ float softplusf_(float x) { return x > 20.f ? x : __logf(1.0f + __expf(x)); }
__device__ __forceinline__ float logsigf_(float z) { return fminf(z, 0.f) - __logf(1.0f + __expf(-fabsf(z))); }
__device__ __forceinline__ void unpack8(const u32x4 w, float (&f)[8]) { f[0] = lo16(w.x); f[1] = hi16(w.x); f[2] = lo16(w.y); f[3] = hi16(w.y); f[4] = lo16(w.z); f[5] = hi16(w.z); f[6] = lo16(w.w); f[7] = hi16(w.w); }
__device__ __forceinline__ u32x4 pack8(const float (&f)[8]) { u32x4 w; w.x = pk2(f[0], f[1]); w.y = pk2(f[2], f[3]); w.z = pk2(f[4], f[5]); w.w = pk2(f[6], f[7]); return w; }
__device__ __forceinline__ float shx(float v, int o, int lane) { return __int_as_float(__builtin_amdgcn_ds_bpermute((lane ^ o) << 2, __float_as_int(v))); }
__device__ __forceinline__ float shup(float v, int o, int lane) { return __int_as_float(__builtin_amdgcn_ds_bpermute((lane - o) << 2, __float_as_int(v))); }
#define MFMA16(a, b, c) __builtin_amdgcn_mfma_f32_16x16x32_bf16((a), (b), (c), 0, 0, 0)

#define XB_TMO      128
#define XB_XCNT(j)  (256  + 64 * (j))
#define XB_XSUB(j)  (1280 + 64 * (j))
#define XB_XGEN(j)  (2304 + 64 * (j))
#define XB_TOP      3328
#define XB_TOPGEN   3392
#define XCD_BAR_WORDS 3456
#define XB_SPIN_CAP (1u << 22)
__device__ __forceinline__ unsigned xb_ld(unsigned* p)              { return __hip_atomic_load(p, __ATOMIC_RELAXED, __HIP_MEMORY_SCOPE_AGENT); }
__device__ __forceinline__ unsigned xb_add(unsigned* p, unsigned v) { return __hip_atomic_fetch_add(p, v, __ATOMIC_RELAXED, __HIP_MEMORY_SCOPE_AGENT); }
__device__ __forceinline__ unsigned xb_xcc_id() { return (unsigned)__builtin_amdgcn_s_getreg((3 << 11) | 20) & 0xFu; }
#define XB_SPIN(cond, bar) do { unsigned _sp = 0; while (cond) { __builtin_amdgcn_s_sleep(1); \
    if ((++_sp & 255u) == 0u) { if (xb_ld(&(bar)[XB_TMO])) break; if (_sp > XB_SPIN_CAP) { atomicAdd(&(bar)[XB_TMO], 1u); break; } } } } while (0)
struct XcdBarrier { unsigned* bar; unsigned x; volatile LAS unsigned* st; };
__device__ __forceinline__ XcdBarrier xcd_barrier_post(unsigned* bar, volatile LAS unsigned* st) {
    XcdBarrier b; b.bar = bar; b.x = xb_xcc_id(); b.st = st;
    if (threadIdx.x == 0) (void)xb_add(&bar[XB_XCNT(b.x)], 1u);
    return b;
}
__device__ __forceinline__ void xcd_barrier_complete(unsigned* bar, unsigned x, unsigned& nloc, unsigned& nx) {
    const unsigned G = gridDim.x * gridDim.y * gridDim.z;
    unsigned sum, cnt, mine, sp = 0u;
    for (;;) {
        sum = 0u; cnt = 0u; mine = 0u;
#pragma unroll
        for (unsigned j = 0; j < 16; ++j) { const unsigned c = xb_ld(&bar[XB_XCNT(j)]); sum += c; cnt += (c > 0u) ? 1u : 0u; }
        mine = xb_ld(&bar[XB_XCNT(x)]);
        if (sum == G) break;
        __builtin_amdgcn_s_sleep(1);
        if ((++sp & 255u) == 0u) { if (xb_ld(&bar[XB_TMO])) break; if (sp > XB_SPIN_CAP) { atomicAdd(&bar[XB_TMO], 1u); break; } }
    }
    nloc = mine > 0u ? mine : 1u; nx = cnt > 0u ? cnt : 1u;
}
__device__ __forceinline__ void xcd_barrier(const XcdBarrier& b) {
    asm volatile("s_waitcnt vmcnt(0)" ::: "memory");
    __syncthreads();
    if (threadIdx.x == 0) {
        unsigned bz_ = 0; asm volatile("" : "+s"(bz_)); unsigned* bar = b.bar + bz_;
        __builtin_amdgcn_s_waitcnt(0);
        unsigned nloc = b.st[0], nx = b.st[1];
        if (nloc == 0u) { xcd_barrier_complete(bar, b.x, nloc, nx); b.st[0] = nloc; b.st[1] = nx; }
        const unsigned old = xb_add(&bar[XB_XSUB(b.x)], 1u);
        const unsigned gen = old / nloc;
        if (old + 1u == (gen + 1u) * nloc) {
            __builtin_amdgcn_fence(__ATOMIC_RELEASE, "agent");
            asm volatile("s_waitcnt vmcnt(0)" ::: "memory");
            const unsigned og = xb_add(&bar[XB_TOP], 1u);
            const unsigned tg = og / nx;
            if (og + 1u == (tg + 1u) * nx) xb_add(&bar[XB_TOPGEN], 1u);
            else XB_SPIN(xb_ld(&bar[XB_TOPGEN]) == tg, bar);
            __builtin_amdgcn_fence(__ATOMIC_ACQUIRE, "agent");
            xb_add(&bar[XB_XGEN(b.x)], 1u);
            asm volatile("s_waitcnt vmcnt(0)" ::: "memory");
        } else {
            XB_SPIN(xb_ld(&bar[XB_XGEN(b.x)]) == gen, bar);
            __builtin_amdgcn_fence(__ATOMIC_ACQUIRE, "agent");
            asm volatile("s_waitcnt vmcnt(0)" ::: "memory");
        }
    }
    __syncthreads();
}

namespace pg8 {
constexpr int BM = 256, BK = 64, HALF = 128, HTB = HALF * BK * 2, STAGE_BYTES = 8 * HTB, NXCD = 8, WGM = 8;
__device__ __forceinline__ int lds_byte(int r, int c) { const int st = (r >> 4) * 2 + (c >> 5), rr = r & 15, cc = c & 31, ob = rr * 64 + cc * 2; return st * 1024 + (ob ^ (((ob >> 9) & 1) << 5)); }
__device__ __forceinline__ void stage_rc(int b, int& R_, int& C_) { const int st = b / 1024, sb = b % 1024, swz = sb ^ (((sb >> 9) & 1) << 5); R_ = (st >> 1) * 16 + swz / 64; C_ = (st & 1) * 32 + (swz % 64) / 2; }
__device__ __forceinline__ int perm32(int rho) { const int n = rho >> 4, i = rho & 15; return 8 * (i >> 2) + 4 * n + (i & 3); }
struct Unit { int pm, pn, z; const char* a; const char* b; };
struct Sched {
    int nM, nN, nZ, per, G, c; const char* A; const char* B; size_t sA, sB, zA, zB;
    __device__ __forceinline__ void init(const void* A_, int lda, size_t zA_, const void* B_, int ldb, size_t zB_, int M, int N, int nZ_, int G_, int c_) {
        nM = M / BM; nN = N / BM; nZ = nZ_; per = nM * nN; G = G_; c = c_; A = (const char*)A_; B = (const char*)B_; sA = (size_t)BM * lda * 2; sB = (size_t)BM * ldb * 2; zA = zA_; zB = zB_; }
    __device__ __forceinline__ bool next(int i, Unit& u) const {
        const long L = (long)i * G + c; if (L >= (long)per * nZ) return false;
        const int z = (int)(L / per); int wgid = (int)(L % per);
        { const int q = per / NXCD, r = per % NXCD, xcd = wgid % NXCD, off = wgid / NXCD; wgid = (xcd < r ? xcd * (q + 1) : r * (q + 1) + (xcd - r) * q) + off; }
        const int nig = WGM * nN, gid = wgid / nig, fm = gid * WGM, gsz = (nM - fm) < WGM ? (nM - fm) : WGM;
        u.pm = fm + ((wgid % nig) % gsz); u.pn = (wgid % nig) / gsz; u.z = z;
        u.a = A + (size_t)z * zA + (size_t)u.pm * sA; u.b = B + (size_t)z * zB + (size_t)u.pn * sB; return true;
    }
};
__device__ __forceinline__ unsigned cvt_pk_bf16(float lo, float hi) { unsigned r; asm volatile("v_cvt_pk_bf16_f32 %0, %1, %2" : "=v"(r) : "v"(lo), "v"(hi)); return r; }
__device__ __forceinline__ u32x4 pack_acc(const f32x4 v0, const f32x4 v1) { u32x4 w; w.x = cvt_pk_bf16(v0[0], v0[1]); w.y = cvt_pk_bf16(v0[2], v0[3]); w.z = cvt_pk_bf16(v1[0], v1[1]); w.w = cvt_pk_bf16(v1[2], v1[3]); return w; }

template <class Epi>
__device__ __forceinline__ void gemm_phase(LAS unsigned char* lds, const int K, const int lda, const int ldb, const Sched& S, const Epi& E) {
    int tid = threadIdx.x; asm volatile("" : "+v"(tid));
    const int wid = __builtin_amdgcn_readfirstlane(tid >> 6), lane = tid & 63, wr = wid >> 2, wc = wid & 3, fr = lane & 15, fq = lane >> 4;
    const int nt = K / BK;
    unsigned voffA[2], voffB[2];
#pragma unroll
    for (int i = 0; i < 2; ++i) { int R_, C_; stage_rc(tid * 16 + i * 8192, R_, C_); const int Rb = (R_ & ~31) + perm32(R_ & 31);
        voffA[i] = (unsigned)(R_ * lda + C_) * 2u; voffB[i] = (unsigned)(Rb * ldb + C_) * 2u; }
    const size_t kstep = (size_t)(BK * 2);
    const size_t hstepA = (size_t)HALF * lda * 2, hstepB = (size_t)HALF * ldb * 2;
    const unsigned ldsw = (unsigned)wid * 1024u;
    const int aoff = lds_byte(wr * 64 + fr, fq * 8), boff = lds_byte(wc * 32 + fr, fq * 8);
#define PG8_SA(b, h) (((b) * 2 + (h)) * HTB)
#define PG8_SB(b, h) ((4 + (b) * 2 + (h)) * HTB)
#define PG8_STAGE(bufoff, gbase, voff) do { _Pragma("unroll") for (int _i = 0; _i < 2; ++_i) \
        __builtin_amdgcn_global_load_lds((const unsigned*)((const char*)(gbase) + (voff)[_i]), (LAS unsigned*)(lds + (bufoff) + ldsw + _i * 8192), 16, 0, 0); } while (0)
#define PG8_LDA(dst, b, h) do { _Pragma("unroll") for (int m = 0; m < 4; ++m) _Pragma("unroll") for (int k = 0; k < 2; ++k) dst[m][k] = *(const LAS bf16x8*)(lds + PG8_SA(b, h) + aoff + m * 2048 + k * 1024); } while (0)
#define PG8_LDB(dst, b, h) do { _Pragma("unroll") for (int n = 0; n < 2; ++n) _Pragma("unroll") for (int k = 0; k < 2; ++k) dst[n][k] = *(const LAS bf16x8*)(lds + PG8_SB(b, h) + boff + n * 2048 + k * 1024); } while (0)
#define PG8_MMA(ai, bj, At, Bt) do { __builtin_amdgcn_s_setprio(1); _Pragma("unroll") for (int m = 0; m < 4; ++m) _Pragma("unroll") for (int n = 0; n < 2; ++n) _Pragma("unroll") for (int k = 0; k < 2; ++k) \
        acc[ai][bj][m][n] = __builtin_amdgcn_mfma_f32_16x16x32_bf16(Bt[n][k], At[m][k], acc[ai][bj][m][n], 0, 0, 0); __builtin_amdgcn_s_setprio(0); } while (0)
#define PG8_WAIT_V(n) asm volatile("s_waitcnt vmcnt(" #n ")" ::: "memory")
#define PG8_WAIT_L(n) asm volatile("s_waitcnt lgkmcnt(" #n ")" ::: "memory")
#define PG8_BAR __builtin_amdgcn_s_barrier()
#define PG8_SCHED __builtin_amdgcn_sched_barrier(0)
    Unit cur, nxt; int ui = 0;
    if (!S.next(0, cur)) return;
    f32x4 acc[2][2][4][2];
#pragma unroll
    for (int a = 0; a < 2; ++a)
#pragma unroll
        for (int b = 0; b < 2; ++b)
#pragma unroll
            for (int m = 0; m < 4; ++m)
#pragma unroll
                for (int n = 0; n < 2; ++n) acc[a][b][m][n] = (f32x4){0.f, 0.f, 0.f, 0.f};
    bf16x8 At[4][2], B0[2][2], B1[2][2];
    const char* cA = cur.a; const char* cB = cur.b;
    PG8_STAGE(PG8_SB(0, 0), cB, voffB); PG8_STAGE(PG8_SB(0, 1), cB + hstepB, voffB); PG8_STAGE(PG8_SA(0, 0), cA, voffA); PG8_STAGE(PG8_SA(0, 1), cA + hstepA, voffA);
    if (wr == 1) PG8_BAR;
    PG8_WAIT_V(2); PG8_BAR;
    PG8_STAGE(PG8_SB(1, 0), cB + kstep, voffB); PG8_STAGE(PG8_SA(1, 0), cA + kstep, voffA); PG8_STAGE(PG8_SB(1, 1), cB + hstepB + kstep, voffB);
    PG8_WAIT_V(6); PG8_BAR;
    for (;;) {
        const bool has_next = S.next(ui + 1, nxt);
        const char* nA = has_next ? nxt.a : cA; const char* nB = has_next ? nxt.b : cB;
#pragma unroll 1
        for (int t = 0; t < nt; t += 2) {
            const bool last = (t == nt - 2);
            const char* a1 = cA + (size_t)(t + 1) * kstep;
            const char* a2 = last ? nA : cA + (size_t)(t + 2) * kstep; const char* b2 = last ? nB : cB + (size_t)(t + 2) * kstep;
            const char* a3 = a2 + kstep; const char* b3 = b2 + kstep;
            PG8_LDB(B0, 0, 0); PG8_LDB(B1, 0, 1); PG8_SCHED; PG8_LDA(At, 0, 0); PG8_STAGE(PG8_SA(1, 1), a1 + hstepA, voffA);
            PG8_WAIT_V(8); PG8_WAIT_L(0); PG8_BAR; PG8_MMA(0, 0, At, B0); PG8_MMA(0, 1, At, B1); PG8_BAR; PG8_SCHED;
            PG8_LDA(At, 0, 1); PG8_STAGE(PG8_SB(0, 0), b2, voffB); PG8_STAGE(PG8_SB(0, 1), b2 + hstepB, voffB); PG8_STAGE(PG8_SA(0, 0), a2, voffA);
            PG8_WAIT_V(8); PG8_WAIT_L(0); PG8_BAR; PG8_MMA(1, 0, At, B0); PG8_MMA(1, 1, At, B1); PG8_BAR; PG8_SCHED;
            PG8_LDB(B0, 1, 0); PG8_LDB(B1, 1, 1); PG8_SCHED; PG8_LDA(At, 1, 0); PG8_STAGE(PG8_SA(0, 1), a2 + hstepA, voffA);
            PG8_WAIT_V(8); PG8_WAIT_L(0); PG8_BAR; PG8_MMA(0, 0, At, B0); PG8_MMA(0, 1, At, B1); PG8_BAR; PG8_SCHED;
            PG8_LDA(At, 1, 1); PG8_STAGE(PG8_SB(1, 0), b3, voffB); PG8_STAGE(PG8_SB(1, 1), b3 + hstepB, voffB); PG8_STAGE(PG8_SA(1, 0), a3, voffA);
            PG8_WAIT_V(8); PG8_WAIT_L(0); PG8_BAR; PG8_MMA(1, 0, At, B0); PG8_MMA(1, 1, At, B1); PG8_BAR; PG8_SCHED;
        }
        if (wr == 0) PG8_BAR;
        E(acc, cur, wr, wc, fr, fq);
        if (!has_next) break;
        { float zz = 0.f; asm volatile("" : "+v"(zz));
#pragma unroll
        for (int a = 0; a < 2; ++a)
#pragma unroll
            for (int b = 0; b < 2; ++b)
#pragma unroll
                for (int m = 0; m < 4; ++m)
#pragma unroll
                    for (int n = 0; n < 2; ++n) acc[a][b][m][n] = (f32x4){zz, zz, zz, zz}; }
        cur = nxt; cA = nA; cB = nB; ++ui;
        if (wr == 1) PG8_BAR;
    }
    PG8_WAIT_V(0);
    PG8_BAR;
#undef PG8_SA
#undef PG8_SB
#undef PG8_STAGE
#undef PG8_LDA
#undef PG8_LDB
#undef PG8_MMA
#undef PG8_WAIT_V
#undef PG8_WAIT_L
#undef PG8_BAR
#undef PG8_SCHED
}

struct EpiInProj {
    bf16_t* P; float* small;
    __device__ __forceinline__ void operator()(const f32x4 (&acc)[2][2][4][2], const Unit& u, int wr, int wc, int fr, int fq) const {
        const int row0 = u.pm * BM + wr * 64 + fr;
        if (u.pn < 56) {
            const int col0 = u.pn * BM + wc * 32 + 8 * fq;
#pragma unroll
            for (int ai = 0; ai < 2; ++ai)
#pragma unroll
                for (int m = 0; m < 4; ++m) { bf16_t* rowp = P + (size_t)(row0 + ai * HALF + m * 16) * NP + col0;
#pragma unroll
                    for (int bj = 0; bj < 2; ++bj) *(u32x4*)(rowp + bj * HALF) = pack_acc(acc[ai][bj][m][0], acc[ai][bj][m][1]); }
        } else if (wc < 2) {
            const int col0 = wc * 32 + 8 * fq;
#pragma unroll
            for (int ai = 0; ai < 2; ++ai)
#pragma unroll
                for (int m = 0; m < 4; ++m) { float* rowp = small + (size_t)(row0 + ai * HALF + m * 16) * 64 + col0;
                    *(f32x4*)rowp = acc[ai][0][m][0]; *(f32x4*)(rowp + 4) = acc[ai][0][m][1]; }
        }
    }
};
struct EpiBf16 {
    bf16_t* O; int ldc;
    __device__ __forceinline__ void operator()(const f32x4 (&acc)[2][2][4][2], const Unit& u, int wr, int wc, int fr, int fq) const {
        const int row0 = u.pm * BM + wr * 64 + fr, col0 = u.pn * BM + wc * 32 + 8 * fq;
#pragma unroll
        for (int ai = 0; ai < 2; ++ai)
#pragma unroll
            for (int m = 0; m < 4; ++m) { bf16_t* rowp = O + (size_t)(row0 + ai * HALF + m * 16) * ldc + col0;
#pragma unroll
                for (int bj = 0; bj < 2; ++bj) *(u32x4*)(rowp + bj * HALF) = pack_acc(acc[ai][bj][m][0], acc[ai][bj][m][1]); }
    }
};
struct EpiPool {
    bf16_t* O; const float* scale;
    __device__ __forceinline__ void operator()(const f32x4 (&acc)[2][2][4][2], const Unit& u, int wr, int wc, int fr, int fq) const {
        const int row0 = u.pm * BM + wr * 64 + fr, col0 = u.z * 256 + wc * 32 + 8 * fq;
        f32x4 sv[2][2];
#pragma unroll
        for (int bj = 0; bj < 2; ++bj) { sv[bj][0] = *(const f32x4*)(scale + col0 + bj * HALF); sv[bj][1] = *(const f32x4*)(scale + col0 + bj * HALF + 4); }
#pragma unroll
        for (int ai = 0; ai < 2; ++ai)
#pragma unroll
            for (int m = 0; m < 4; ++m) { bf16_t* rowp = O + (size_t)(row0 + ai * HALF + m * 16) * 1024 + col0;
#pragma unroll
                for (int bj = 0; bj < 2; ++bj) *(u32x4*)(rowp + bj * HALF) = pack_acc(acc[ai][bj][m][0] * sv[bj][0], acc[ai][bj][m][1] * sv[bj][1]); }
    }
};
template <int PASS> struct EpiBranch {
    const bf16_t* P; float* m32; bf16_t* mbf;
    __device__ __forceinline__ void operator()(const f32x4 (&acc)[2][2][4][2], const Unit& u, int wr, int wc, int fr, int fq) const {
        const int row0 = u.pm * BM + wr * 64 + fr, col0 = u.pn * BM + wc * 32 + 8 * fq;
#pragma unroll
        for (int ai = 0; ai < 2; ++ai)
#pragma unroll
            for (int m = 0; m < 4; ++m) { const size_t row = (size_t)(row0 + ai * HALF + m * 16);
#pragma unroll
                for (int bj = 0; bj < 2; ++bj) { const int col = col0 + bj * HALF;
                    const u32x4 gw = *(const u32x4*)(P + row * NP + PC_GATE + PASS * 2048 + col); float g[8]; unpack8(gw, g);
                    f32x4 v0 = acc[ai][bj][m][0], v1 = acc[ai][bj][m][1];
#pragma unroll
                    for (int j = 0; j < 4; ++j) { v0[j] *= sigmoidf_(g[j]); v1[j] *= sigmoidf_(g[4 + j]); }
                    float* mp = m32 + row * D + col;
                    if (PASS > 0) { v0 += *(const f32x4*)mp; v1 += *(const f32x4*)(mp + 4); }
                    if (PASS < 2) { *(f32x4*)mp = v0; *(f32x4*)(mp + 4) = v1; }
                    else *(u32x4*)(mbf + row * D + col) = pack_acc(v0, v1); } }
    }
};
struct EpiResid {
    float* X; const float* gates;
    __device__ __forceinline__ void operator()(const f32x4 (&acc)[2][2][4][2], const Unit& u, int wr, int wc, int fr, int fq) const {
        const int row0 = u.pm * BM + wr * 64 + fr, col0 = u.pn * BM + wc * 32 + 8 * fq;
        const int j = u.pm < 64 ? (u.pm >> 3) : 8;
        const float* gp = gates + (size_t)j * 12288 + col0;
        f32x4 gv[2][2];
#pragma unroll
        for (int bj = 0; bj < 2; ++bj) { gv[bj][0] = *(const f32x4*)(gp + bj * HALF); gv[bj][1] = *(const f32x4*)(gp + bj * HALF + 4); }
#pragma unroll
        for (int ai = 0; ai < 2; ++ai)
#pragma unroll
            for (int m = 0; m < 4; ++m) { float* rowp = X + (size_t)(row0 + ai * HALF + m * 16) * D + col0;
#pragma unroll
                for (int bj = 0; bj < 2; ++bj) { float* xp = rowp + bj * HALF;
                    const f32x4 x0 = *(const f32x4*)xp, x1 = *(const f32x4*)(xp + 4);
                    *(f32x4*)xp = x0 + gv[bj][0] * acc[ai][bj][m][0]; *(f32x4*)(xp + 4) = x1 + gv[bj][1] * acc[ai][bj][m][1]; } }
    }
};
}

struct Args { const float* in[26]; float* out; unsigned char* ws; };
struct Frame {
    LAS unsigned char* lds; unsigned char* ws; const float* const* in; float* out;
    int tid, lane, wave, G, bx;
};
enum { I_X = 0, I_C, I_CTX, I_CCTX, I_ADAW, I_ADAB, I_N1W, I_N2W, I_WIN, I_LRW2, I_LRB, I_GLANW, I_CONVW, I_ALOG, I_DTB, I_GDNNW, I_POOLW, I_POOLS, I_WBRGLA, I_WBRGDN, I_WBRPOOL, I_WOUT, I_FFNUP, I_FFNCONV, I_FFNDOWN, I_FINALW };

__device__ __forceinline__ void phase_mods(const Frame& F) {
    int tid = F.tid; asm volatile("" : "+v"(tid));
    size_t wz_ = 0; asm volatile("" : "+s"(wz_)); unsigned char* wsl = F.ws + wz_;
    int bxl = F.bx; asm volatile("" : "+s"(bxl)); (void)bxl;
    const int lane = tid & 63, wave = __builtin_amdgcn_readfirstlane(tid >> 6); (void)lane; (void)wave;
    LAS float* sc = (LAS float*)F.lds;
    const float* c = F.in[I_C]; const float* cc = F.in[I_CCTX]; const float* aw = F.in[I_ADAW];
    float* part = (float*)(wsl + WS_MODP);
    for (int u = bxl; u < DEPTH * 24 * 8; u += F.G) {
        const int ks = u % 8, cb = (u / 8) % 24, l = u / 192;
        __syncthreads();
        for (int i = tid; i < 9 * 256; i += NTHR) { const int j = i / 256, k = i % 256; const float cv = (j < 8) ? c[j * D + ks * 256 + k] : cc[ks * 256 + k]; sc[i] = siluf_(cv); }
        __syncthreads();
        const int col = cb * 512 + tid;
        const float* w = aw + ((size_t)l * D + ks * 256) * 12288 + col;
        float acc[9];
#pragma unroll
        for (int j = 0; j < 9; ++j) acc[j] = 0.f;
#pragma unroll 8
        for (int k = 0; k < 256; ++k) { const float wv = w[(size_t)k * 12288];
#pragma unroll
            for (int j = 0; j < 9; ++j) acc[j] += sc[j * 256 + k] * wv; }
#pragma unroll
        for (int j = 0; j < 9; ++j) part[(size_t)ks * (DEPTH * 9 * 12288) + ((size_t)l * 9 + j) * 12288 + col] = acc[j];
    }
    __syncthreads();
}
__device__ __forceinline__ void phase_mods_reduce(const Frame& F) {
    int tid = F.tid; asm volatile("" : "+v"(tid));
    size_t wz_ = 0; asm volatile("" : "+s"(wz_)); unsigned char* wsl = F.ws + wz_;
    int bxl = F.bx; asm volatile("" : "+s"(bxl));
    const float* part = (const float*)(wsl + WS_MODP); float* mods = (float*)(wsl + WS_MODS); const float* ab = F.in[I_ADAB];
    for (int i = bxl * NTHR + tid; i < DEPTH * 9 * 12288; i += F.G * NTHR) {
        const int l = i / (9 * 12288), col = i % 12288;
        float s = ab[l * 12288 + col];
#pragma unroll
        for (int ks = 0; ks < 8; ++ks) s += part[(size_t)ks * (DEPTH * 9 * 12288) + i];
        mods[i] = s; }
}

__device__ __forceinline__ int map_in_col(int n) {
    if (n < 3072) return n;
    if (n < 3104) return NP + (n - 3072);
    if (n < 6176) return n - 32;
    if (n < 6192) return NP + 32 + (n - 6176);
    if (n < 6208) return NP + 48 + (n - 6192);
    return n - 64;
}
__device__ __forceinline__ void wtile(const Frame& F, const float* src, int N, bf16_t* dst, int K, int kt, int ntl, bool perm_in) {
    int tid = F.tid; asm volatile("" : "+v"(tid));
    size_t wz_ = 0; asm volatile("" : "+s"(wz_)); unsigned char* wsl = F.ws + wz_;
    int bxl = F.bx; asm volatile("" : "+s"(bxl)); (void)bxl;
    const int lane = tid & 63, wave = __builtin_amdgcn_readfirstlane(tid >> 6); (void)lane; (void)wave;
    LAS float* t = (LAS float*)F.lds;
    const int kk = tid >> 3, seg = (tid & 7) * 8;
    const float* s = src + (size_t)(kt * 64 + kk) * N + ntl * 64 + seg;
    const f32x4 v0 = *(const f32x4*)s, v1 = *(const f32x4*)(s + 4);
    __syncthreads();
#pragma unroll
    for (int i = 0; i < 4; ++i) { t[kk * 65 + seg + i] = v0[i]; t[kk * 65 + seg + 4 + i] = v1[i]; }
    __syncthreads();
    const int nn = tid >> 3, kseg = (tid & 7) * 8;
    float f[8];
#pragma unroll
    for (int i = 0; i < 8; ++i) f[i] = t[(kseg + i) * 65 + nn];
    const int n = ntl * 64 + nn, np = perm_in ? map_in_col(n) : n;
    *(u32x4*)(dst + (size_t)np * K + kt * 64 + kseg) = pack8(f);
}
__device__ __forceinline__ void phase_weights(const Frame& F, int l) {
    int tid = F.tid; asm volatile("" : "+v"(tid));
    size_t wz_ = 0; asm volatile("" : "+s"(wz_)); unsigned char* wsl = F.ws + wz_;
    int bxl = F.bx; asm volatile("" : "+s"(bxl)); (void)bxl;
    const int lane = tid & 63, wave = __builtin_amdgcn_readfirstlane(tid >> 6); (void)lane; (void)wave;
    bf16_t* Win = (bf16_t*)(wsl + WS_WIN); bf16_t* Wbr = (bf16_t*)(wsl + WS_WBR); bf16_t* Wout = (bf16_t*)(wsl + WS_WOUT);
    bf16_t* Wup = (bf16_t*)(wsl + WS_WUP); bf16_t* Wdn = (bf16_t*)(wsl + WS_WDN); bf16_t* Wpool = (bf16_t*)(wsl + WS_WPOOL);
    constexpr int T_IN = 32 * 225, T_BR = 16 * 32, T_OUT = 32 * 32, T_UP = 32 * 176, T_DN = 88 * 32, T_PL = 4 * 4;
    constexpr int O_BR = T_IN, O_OUT = O_BR + 3 * T_BR, O_UP = O_OUT + T_OUT, O_DN = O_UP + T_UP, O_PL = O_DN + T_DN, T_ALL = O_PL + 4 * T_PL;
    for (int u = bxl; u < T_ALL; u += F.G) {
        if (u < O_BR) { wtile(F, F.in[I_WIN] + (size_t)l * D * NIN_ORIG, NIN_ORIG, Win, D, u / 225, u % 225, true); }
        else if (u < O_OUT) { const int v = u - O_BR, br = v / T_BR, w = v % T_BR; wtile(F, F.in[I_WBRGLA + br] + (size_t)l * 1024 * D, D, Wbr + (size_t)br * D * 1024, 1024, w / 32, w % 32, false); }
        else if (u < O_UP) { const int v = u - O_OUT; wtile(F, F.in[I_WOUT] + (size_t)l * D * D, D, Wout, D, v / 32, v % 32, false); }
        else if (u < O_DN) { const int v = u - O_UP; wtile(F, F.in[I_FFNUP] + (size_t)l * D * NAV, NAV, Wup, D, v / 176, v % 176, false); }
        else if (u < O_PL) { const int v = u - O_DN; wtile(F, F.in[I_FFNDOWN] + (size_t)l * DFF * D, D, Wdn, DFF, v / 32, v % 32, false); }
        else { const int v = u - O_PL, g = v / T_PL, w = v % T_PL; wtile(F, F.in[I_POOLW] + ((size_t)l * 4 + g) * 65536, 256, Wpool + (size_t)g * 65536, 256, w / 4, w % 4, false); }
    }
    { u32x4* z = (u32x4*)(Win + (size_t)NIN_ORIG * D); const int n16 = (NIN - NIN_ORIG) * D * 2 / 16;
      for (int i = bxl * NTHR + tid; i < n16; i += F.G * NTHR) z[i] = (u32x4){0u, 0u, 0u, 0u}; }
    __syncthreads();
}

__device__ __forceinline__ void phase_norm(const Frame& F, const float* xl, const float* xc, float* xcopy, const float* nw, const float* mods_l, int sh, bf16_t* out, int nrows) {
    int tid = F.tid; asm volatile("" : "+v"(tid));
    size_t wz_ = 0; asm volatile("" : "+s"(wz_)); unsigned char* wsl = F.ws + wz_;
    int bxl = F.bx; asm volatile("" : "+s"(bxl)); (void)bxl;
    const int lane = tid & 63, wave = __builtin_amdgcn_readfirstlane(tid >> 6); (void)lane; (void)wave;
    for (int r = bxl * 8 + wave; r < nrows; r += F.G * 8) {
        const float* xr = (r < RL) ? xl + (size_t)r * D : xc + (size_t)(r - RL) * D;
        const int j = (r < RL) ? (r >> 11) : 8;
        const float* shp = mods_l + (size_t)j * 12288 + sh * D; const float* scp = shp + D;
        f32x4 v[8]; float ss = 0.f;
#pragma unroll
        for (int i = 0; i < 8; ++i) { v[i] = *(const f32x4*)(xr + i * 256 + lane * 4); ss += v[i][0] * v[i][0] + v[i][1] * v[i][1] + v[i][2] * v[i][2] + v[i][3] * v[i][3]; }
#pragma unroll
        for (int o = 32; o >= 1; o >>= 1) ss += shx(ss, o, lane);
        const float rs = rsqrtf(ss * (1.0f / D) + EPS);
#pragma unroll
        for (int i = 0; i < 8; ++i) { const int c = i * 256 + lane * 4;
            if (xcopy) *(f32x4*)(xcopy + (size_t)r * D + c) = v[i];
            const f32x4 w = *(const f32x4*)(nw + c), s1 = *(const f32x4*)(scp + c), s0 = *(const f32x4*)(shp + c);
            float y[4];
#pragma unroll
            for (int q = 0; q < 4; ++q) y[q] = v[i][q] * rs * w[q] * (1.0f + s1[q]) + s0[q];
            u32x2 p; p.x = pk2(y[0], y[1]); p.y = pk2(y[2], y[3]);
            *(u32x2*)(out + (size_t)r * D + c) = p; }
    }
}
__device__ __forceinline__ void phase_final_norm(const Frame& F, const float* x, const float* nw, float* out) {
    int tid = F.tid; asm volatile("" : "+v"(tid));
    size_t wz_ = 0; asm volatile("" : "+s"(wz_)); unsigned char* wsl = F.ws + wz_;
    int bxl = F.bx; asm volatile("" : "+s"(bxl)); (void)bxl;
    const int lane = tid & 63, wave = __builtin_amdgcn_readfirstlane(tid >> 6); (void)lane; (void)wave;
    for (int r = bxl * 8 + wave; r < RL; r += F.G * 8) {
        const float* xr = x + (size_t)r * D;
        f32x4 v[8]; float ss = 0.f;
#pragma unroll
        for (int i = 0; i < 8; ++i) { v[i] = *(const f32x4*)(xr + i * 256 + lane * 4); ss += v[i][0] * v[i][0] + v[i][1] * v[i][1] + v[i][2] * v[i][2] + v[i][3] * v[i][3]; }
#pragma unroll
        for (int o = 32; o >= 1; o >>= 1) ss += shx(ss, o, lane);
        const float rs = rsqrtf(ss * (1.0f / D) + EPS);
#pragma unroll
        for (int i = 0; i < 8; ++i) { const int c = i * 256 + lane * 4; const f32x4 w = *(const f32x4*)(nw + c);
            *(f32x4*)(out + (size_t)r * D + c) = v[i] * rs * w; }
    }
}

__device__ __forceinline__ int chunk_rowbase(int b, int ch) { return ch < 4 ? RL + b * CTXL + ch * 64 : b * SEQ + (ch - 4) * 64; }
__device__ __forceinline__ int step_chunk(int d, int i) { return d == 0 ? i : (i < 4 ? 3 - i : 39 - i); }

__device__ __forceinline__ void gla_prep_unit(const Frame& F, int l, int b, int ch, int h, int d) {
    int tid = F.tid; asm volatile("" : "+v"(tid));
    size_t wz_ = 0; asm volatile("" : "+s"(wz_)); unsigned char* wsl = F.ws + wz_;
    int bxl = F.bx; asm volatile("" : "+s"(bxl)); (void)bxl;
    const int lane = tid & 63, w = __builtin_amdgcn_readfirstlane(tid >> 6), fr = lane & 15, fq = lane >> 4;
    LAS bf16_t* qd = (LAS bf16_t*)(F.lds + 0);
    LAS bf16_t* kn = (LAS bf16_t*)(F.lds + 17408);
    LAS bf16_t* vT = (LAS bf16_t*)(F.lds + 34816);
    LAS bf16_t* sc = (LAS bf16_t*)(F.lds + 71680);
    LAS float* bc = (LAS float*)(F.lds + 80896);
    LAS float* lr = (LAS float*)(F.lds + 113920);
    LAS float* w2 = (LAS float*)(F.lds + 118016);
    LAS float* bs = (LAS float*)(F.lds + 126208);
    const bf16_t* P = (const bf16_t*)(wsl + WS_P); const float* small = (const float*)(wsl + WS_SMALL);
    const int rowbase = chunk_rowbase(b, ch);
    unsigned char* ub = wsl + WS_GLAPREP + (size_t)(((b * NCH + ch) * 4 + h) * 2 + d) * GLA_UNIT;
    bf16_t* g_qd = (bf16_t*)ub; bf16_t* g_keT = (bf16_t*)(ub + 16384); bf16_t* g_vT = (bf16_t*)(ub + 32768); float* g_dec = (float*)(ub + 65536);
    bf16_t* og = (bf16_t*)(wsl + WS_OGLA) + (size_t)d * R * 1024;
    if (tid < 256) { const int p = tid >> 2, r4 = (tid & 3) * 4, tok = d ? 63 - p : p;
        *(LAS f32x4*)(lr + p * 16 + r4) = *(const f32x4*)(small + (size_t)(rowbase + tok) * 64 + d * 16 + r4); }
    { const int idx = tid * 4, r = idx >> 7, k = idx & 127;
        *(LAS f32x4*)(w2 + idx) = *(const f32x4*)(F.in[I_LRW2] + ((size_t)(l * 2 + d) * 16 + r) * 512 + h * 128 + k); }
    if (tid < 128) bs[tid] = F.in[I_LRB][(size_t)(l * 2 + d) * 512 + h * 128 + tid];
    __syncthreads();
    const int p = tid >> 3, k0 = (tid & 7) * 16, tok = d ? 63 - p : p;
    { float z[16];
#pragma unroll
        for (int i = 0; i < 16; ++i) z[i] = bs[k0 + i];
#pragma unroll
        for (int r = 0; r < 16; ++r) { const float lv = lr[p * 16 + r];
#pragma unroll
            for (int i = 0; i < 16; ++i) z[i] += lv * w2[r * 128 + k0 + i]; }
#pragma unroll
        for (int i = 0; i < 16; ++i) bc[p * 129 + k0 + i] = logsigf_(z[i]) * (1.0f / 16.0f); }
    __syncthreads();
    if (tid < 128) { float run = 0.f;
#pragma unroll 8
        for (int q = 0; q < 64; ++q) { run += bc[q * 129 + tid]; bc[q * 129 + tid] = run; } }
    __syncthreads();
    { const bf16_t* qp = P + (size_t)(rowbase + tok) * NP + PC_GLA_Q + h * 128 + k0; const bf16_t* kp = P + (size_t)(rowbase + tok) * NP + PC_GLA_K + h * 128 + k0;
        float qf[16], kf[16];
        { float t8[8]; unpack8(*(const u32x4*)qp, t8);
#pragma unroll
            for (int i = 0; i < 8; ++i) qf[i] = t8[i];
            unpack8(*(const u32x4*)(qp + 8), t8);
#pragma unroll
            for (int i = 0; i < 8; ++i) qf[8 + i] = t8[i];
            unpack8(*(const u32x4*)kp, t8);
#pragma unroll
            for (int i = 0; i < 8; ++i) kf[i] = t8[i];
            unpack8(*(const u32x4*)(kp + 8), t8);
#pragma unroll
            for (int i = 0; i < 8; ++i) kf[8 + i] = t8[i]; }
        float qo[16], ko[16];
#pragma unroll
        for (int i = 0; i < 16; ++i) { const float bb = bc[p * 129 + k0 + i], bl = bc[63 * 129 + k0 + i];
            qo[i] = qf[i] * 0.08838834764831845f * __expf(bb); ko[i] = kf[i] * __expf(-bb);
            g_keT[(k0 + i) * 64 + p] = f2bf(kf[i] * __expf(bl - bb));
            if (p == 63) g_dec[k0 + i] = __expf(bl); }
        u32x4 q0, q1, k0v, k1v;
        { float t8[8];
#pragma unroll
            for (int i = 0; i < 8; ++i) t8[i] = qo[i];
            q0 = pack8(t8);
#pragma unroll
            for (int i = 0; i < 8; ++i) t8[i] = qo[8 + i];
            q1 = pack8(t8);
#pragma unroll
            for (int i = 0; i < 8; ++i) t8[i] = ko[i];
            k0v = pack8(t8);
#pragma unroll
            for (int i = 0; i < 8; ++i) t8[i] = ko[8 + i];
            k1v = pack8(t8); }
        *(LAS u32x4*)(qd + p * 136 + k0) = q0; *(LAS u32x4*)(qd + p * 136 + k0 + 8) = q1;
        *(LAS u32x4*)(kn + p * 136 + k0) = k0v; *(LAS u32x4*)(kn + p * 136 + k0 + 8) = k1v;
        *(u32x4*)(g_qd + p * 128 + k0) = q0; *(u32x4*)(g_qd + p * 128 + k0 + 8) = q1; }
    { const int v0 = (tid & 7) * 32; const bf16_t* vp = P + (size_t)(rowbase + tok) * NP + PC_GLA_V + h * 256 + v0;
#pragma unroll
        for (int j = 0; j < 4; ++j) { const u32x4 wv = *(const u32x4*)(vp + j * 8);
            const unsigned ws_[4] = {wv.x, wv.y, wv.z, wv.w};
#pragma unroll
            for (int q = 0; q < 4; ++q) { vT[(v0 + j * 8 + 2 * q) * 72 + p] = (bf16_t)(ws_[q] & 0xFFFFu); vT[(v0 + j * 8 + 2 * q + 1) * 72 + p] = (bf16_t)(ws_[q] >> 16); } } }
    __syncthreads();
    { const int row = tid >> 1, half = tid & 1;
#pragma unroll
        for (int j = 0; j < 4; ++j) *(u32x4*)(g_vT + row * 64 + half * 32 + j * 8) = *(const LAS u32x4*)(vT + row * 72 + half * 32 + j * 8); }
    { const int rb = w >> 1;
#pragma unroll
        for (int j = 0; j < 2; ++j) { const int cb = (w & 1) * 2 + j; f32x4 acc = (f32x4){0.f, 0.f, 0.f, 0.f};
#pragma unroll
            for (int ks = 0; ks < 4; ++ks) { const bf16x8 a = *(const LAS bf16x8*)(qd + (rb * 16 + fr) * 136 + ks * 32 + fq * 8); const bf16x8 bt = *(const LAS bf16x8*)(kn + (cb * 16 + fr) * 136 + ks * 32 + fq * 8);
                acc = MFMA16(bt, a, acc); }
            const int pr = rb * 16 + fr, s0 = cb * 16 + 4 * fq;
            u32x2 o; o.x = pk2(s0 + 0 <= pr ? acc[0] : 0.f, s0 + 1 <= pr ? acc[1] : 0.f); o.y = pk2(s0 + 2 <= pr ? acc[2] : 0.f, s0 + 3 <= pr ? acc[3] : 0.f);
            *(LAS u32x2*)(sc + pr * 72 + s0) = o; } }
    __syncthreads();
    { bf16x8 af[4][2];
#pragma unroll
        for (int rb = 0; rb < 4; ++rb)
#pragma unroll
            for (int ks = 0; ks < 2; ++ks) af[rb][ks] = *(const LAS bf16x8*)(sc + (rb * 16 + fr) * 72 + ks * 32 + fq * 8);
#pragma unroll
        for (int j = 0; j < 2; ++j) { const int cb = w * 2 + j; bf16x8 bf[2];
#pragma unroll
            for (int ks = 0; ks < 2; ++ks) bf[ks] = *(const LAS bf16x8*)(vT + (cb * 16 + fr) * 72 + ks * 32 + fq * 8);
#pragma unroll
            for (int rb = 0; rb < 4; ++rb) { f32x4 acc = (f32x4){0.f, 0.f, 0.f, 0.f};
#pragma unroll
                for (int ks = 0; ks < 2; ++ks) acc = MFMA16(bf[ks], af[rb][ks], acc);
                const int pr = rb * 16 + fr, tk = d ? 63 - pr : pr;
                u32x2 o; o.x = pk2(acc[0], acc[1]); o.y = pk2(acc[2], acc[3]);
                *(u32x2*)(og + (size_t)(rowbase + tk) * 1024 + h * 256 + cb * 16 + 4 * fq) = o; } } }
    __syncthreads();
}

__device__ __forceinline__ void gla_scan_unit(const Frame& F, int b, int h, int d, int vs) {
    int tid = F.tid; asm volatile("" : "+v"(tid));
    size_t wz_ = 0; asm volatile("" : "+s"(wz_)); unsigned char* wsl = F.ws + wz_;
    int bxl = F.bx; asm volatile("" : "+s"(bxl)); (void)bxl;
    const int lane = tid & 63, w = __builtin_amdgcn_readfirstlane(tid >> 6), fr = lane & 15, fq = lane >> 4;
    LAS bf16_t* ST = (LAS bf16_t*)(F.lds);
    const int pb = w >> 1, vvb0 = (w & 1) * 2, vb = w >> 1, kb0 = (w & 1) * 4;
    bf16_t* og = (bf16_t*)(wsl + WS_OGLA) + (size_t)d * R * 1024;
    f32x4 Sacc[4];
#pragma unroll
    for (int j = 0; j < 4; ++j) Sacc[j] = (f32x4){0.f, 0.f, 0.f, 0.f};
    __syncthreads();
    for (int i = tid; i < 64 * 136 / 2; i += NTHR) ((LAS unsigned*)ST)[i] = 0u;
    __syncthreads();
    int cur = 0;
    for (int step = 0; step < NCH; ++step) {
        const int ch = step_chunk(d, step), rowbase = chunk_rowbase(b, ch);
        const unsigned char* ub = wsl + WS_GLAPREP + (size_t)(((b * NCH + ch) * 4 + h) * 2 + d) * GLA_UNIT;
        const bf16_t* g_qd = (const bf16_t*)ub; const bf16_t* g_keT = (const bf16_t*)(ub + 16384); const bf16_t* g_vT = (const bf16_t*)(ub + 32768); const float* g_dec = (const float*)(ub + 65536);
        LAS const bf16_t* Sc = ST + cur * (64 * 136); LAS bf16_t* Sn = ST + (cur ^ 1) * (64 * 136);
        bf16x8 qa[4];
#pragma unroll
        for (int ks = 0; ks < 4; ++ks) qa[ks] = *(const bf16x8*)(g_qd + (pb * 16 + fr) * 128 + ks * 32 + fq * 8);
#pragma unroll
        for (int j = 0; j < 2; ++j) { const int vvb = vvb0 + j; f32x4 acc = (f32x4){0.f, 0.f, 0.f, 0.f};
#pragma unroll
            for (int ks = 0; ks < 4; ++ks) { const bf16x8 bt = *(const LAS bf16x8*)(Sc + (vvb * 16 + fr) * 136 + ks * 32 + fq * 8); acc = MFMA16(bt, qa[ks], acc); }
            const int pr = pb * 16 + fr, tk = d ? 63 - pr : pr;
            bf16_t* op = og + (size_t)(rowbase + tk) * 1024 + h * 256 + vs * 64 + vvb * 16 + 4 * fq;
            const u32x2 old = *(const u32x2*)op;
            u32x2 o; o.x = pk2(lo16(old.x) + acc[0], hi16(old.x) + acc[1]); o.y = pk2(lo16(old.y) + acc[2], hi16(old.y) + acc[3]);
            *(u32x2*)op = o; }
        bf16x8 va[2];
#pragma unroll
        for (int ks = 0; ks < 2; ++ks) va[ks] = *(const bf16x8*)(g_vT + (vs * 64 + vb * 16 + fr) * 64 + ks * 32 + fq * 8);
#pragma unroll
        for (int j = 0; j < 4; ++j) { const int kb = kb0 + j; const f32x4 dc = *(const f32x4*)(g_dec + kb * 16 + 4 * fq);
            f32x4 acc = Sacc[j] * dc;
#pragma unroll
            for (int ks = 0; ks < 2; ++ks) { const bf16x8 bt = *(const bf16x8*)(g_keT + (kb * 16 + fr) * 64 + ks * 32 + fq * 8); acc = MFMA16(bt, va[ks], acc); }
            Sacc[j] = acc;
            u32x2 o; o.x = pk2(acc[0], acc[1]); o.y = pk2(acc[2], acc[3]);
            *(LAS u32x2*)(Sn + (vb * 16 + fr) * 136 + kb * 16 + 4 * fq) = o; }
        __syncthreads();
        cur ^= 1;
    }
}

__device__ __forceinline__ void gdn_prep_unit(const Frame& F, int l, int b, int ch, int h, int d) {
    int tid = F.tid; asm volatile("" : "+v"(tid));
    size_t wz_ = 0; asm volatile("" : "+s"(wz_)); unsigned char* wsl = F.ws + wz_;
    int bxl = F.bx; asm volatile("" : "+s"(bxl)); (void)bxl;
    const int lane = tid & 63, w = __builtin_amdgcn_readfirstlane(tid >> 6), fr = lane & 15, fq = lane >> 4;
    LAS float* Lm = (LAS float*)(F.lds + 0);
    LAS float* gb = (LAS float*)(F.lds + 17408);
    LAS float* bt = (LAS float*)(F.lds + 17664);
    LAS bf16_t* qh = (LAS bf16_t*)(F.lds + 17920);
    LAS bf16_t* kh = (LAS bf16_t*)(F.lds + 35328);
    LAS float* kf = (LAS float*)(F.lds + 52736);
    LAS float* vf = (LAS float*)(F.lds + 85760);
    const bf16_t* P = (const bf16_t*)(wsl + WS_P); const float* small = (const float*)(wsl + WS_SMALL);
    const int rowbase = chunk_rowbase(b, ch);
    const int T = ch < 4 ? CTXL : SEQ, chl = ch < 4 ? ch : ch - 4;
    unsigned char* ub = wsl + WS_GDNPREP + (size_t)(((b * NCH + ch) * 8 + h) * 2 + d) * GDN_UNIT;
    bf16_t* g_nw = (bf16_t*)ub; bf16_t* g_uT = (bf16_t*)(ub + 16384); bf16_t* g_at = (bf16_t*)(ub + 32768); bf16_t* g_qd = (bf16_t*)(ub + 40960); bf16_t* g_kdT = (bf16_t*)(ub + 57344); float* g_cd = (float*)(ub + 73728);
    if (w == 0) { const int tok = d ? 63 - lane : lane;
        const float av = small[(size_t)(rowbase + tok) * 64 + 32 + d * 8 + h], bv = small[(size_t)(rowbase + tok) * 64 + 48 + d * 8 + h];
        float g = -__expf(F.in[I_ALOG][(l * 2 + d) * 8 + h]) * softplusf_(av + F.in[I_DTB][(l * 2 + d) * 8 + h]);
#pragma unroll
        for (int o = 1; o < 64; o <<= 1) { const float t = shup(g, o, lane); if (lane >= o) g += t; }
        gb[lane] = g; bt[lane] = sigmoidf_(bv);
        if (lane == 63) g_cd[0] = __expf(g); }
    __syncthreads();
    { const int p = tid >> 3, c0 = (tid & 7) * 16, tok = d ? 63 - p : p, ts = chl * 64 + tok;
        const float* cw = F.in[I_CONVW] + (size_t)l * 3 * 3072;
        float y[3][16];
#pragma unroll
        for (int part = 0; part < 3; ++part) {
            const bf16_t* xp = P + (size_t)(rowbase + tok) * NP + PC_GDN_Q + part * 1024 + h * 128 + c0;
            const int wc = part * 1024 + h * 128 + c0;
            float x0[16], x1[16], x2[16];
            { float t8[8];
                if (ts - 1 >= 0) { unpack8(*(const u32x4*)(xp - NP), t8);
#pragma unroll
                    for (int i = 0; i < 8; ++i) x0[i] = t8[i];
                    unpack8(*(const u32x4*)(xp - NP + 8), t8);
#pragma unroll
                    for (int i = 0; i < 8; ++i) x0[8 + i] = t8[i]; }
                else {
#pragma unroll
                    for (int i = 0; i < 16; ++i) x0[i] = 0.f; }
                unpack8(*(const u32x4*)xp, t8);
#pragma unroll
                for (int i = 0; i < 8; ++i) x1[i] = t8[i];
                unpack8(*(const u32x4*)(xp + 8), t8);
#pragma unroll
                for (int i = 0; i < 8; ++i) x1[8 + i] = t8[i];
                if (ts + 1 < T) { unpack8(*(const u32x4*)(xp + NP), t8);
#pragma unroll
                    for (int i = 0; i < 8; ++i) x2[i] = t8[i];
                    unpack8(*(const u32x4*)(xp + NP + 8), t8);
#pragma unroll
                    for (int i = 0; i < 8; ++i) x2[8 + i] = t8[i]; }
                else {
#pragma unroll
                    for (int i = 0; i < 16; ++i) x2[i] = 0.f; } }
#pragma unroll
            for (int i = 0; i < 16; ++i) { const float v = cw[wc + i] * x0[i] + cw[3072 + wc + i] * x1[i] + cw[6144 + wc + i] * x2[i]; y[part][i] = siluf_(v); }
        }
        float sq = 0.f, sk = 0.f;
#pragma unroll
        for (int i = 0; i < 16; ++i) { sq += y[0][i] * y[0][i]; sk += y[1][i] * y[1][i]; }
#pragma unroll
        for (int o = 1; o < 8; o <<= 1) { sq += shx(sq, o, lane); sk += shx(sk, o, lane); }
        const float rq = rsqrtf(sq + EPS) * 0.08838834764831845f, rk = rsqrtf(sk + EPS);
        const float bcp = gb[p], bl = gb[63], eq = __expf(bcp), ek = __expf(bl - bcp);
        float t8[8]; u32x4 w0, w1;
#pragma unroll
        for (int i = 0; i < 8; ++i) t8[i] = y[0][i] * rq;
        w0 = pack8(t8);
#pragma unroll
        for (int i = 0; i < 8; ++i) t8[i] = y[0][8 + i] * rq;
        w1 = pack8(t8);
        *(LAS u32x4*)(qh + p * 136 + c0) = w0; *(LAS u32x4*)(qh + p * 136 + c0 + 8) = w1;
#pragma unroll
        for (int i = 0; i < 8; ++i) t8[i] = y[0][i] * rq * eq;
        w0 = pack8(t8);
#pragma unroll
        for (int i = 0; i < 8; ++i) t8[i] = y[0][8 + i] * rq * eq;
        w1 = pack8(t8);
        *(u32x4*)(g_qd + p * 128 + c0) = w0; *(u32x4*)(g_qd + p * 128 + c0 + 8) = w1;
#pragma unroll
        for (int i = 0; i < 8; ++i) t8[i] = y[1][i] * rk;
        w0 = pack8(t8);
#pragma unroll
        for (int i = 0; i < 8; ++i) t8[i] = y[1][8 + i] * rk;
        w1 = pack8(t8);
        *(LAS u32x4*)(kh + p * 136 + c0) = w0; *(LAS u32x4*)(kh + p * 136 + c0 + 8) = w1;
#pragma unroll
        for (int i = 0; i < 16; ++i) { const float kv = y[1][i] * rk; kf[p * 129 + c0 + i] = kv; vf[p * 129 + c0 + i] = y[2][i]; g_kdT[(c0 + i) * 64 + p] = f2bf(kv * ek); }
    }
    __syncthreads();
    { const bool isq = w >= 4; const int rb = w & 3; LAS const bf16_t* Asrc = isq ? qh : kh;
        bf16x8 af[4];
#pragma unroll
        for (int ks = 0; ks < 4; ++ks) af[ks] = *(const LAS bf16x8*)(Asrc + (rb * 16 + fr) * 136 + ks * 32 + fq * 8);
        const int pr = rb * 16 + fr; const float bp = gb[pr], betap = bt[pr];
#pragma unroll
        for (int cb = 0; cb < 4; ++cb) { f32x4 acc = (f32x4){0.f, 0.f, 0.f, 0.f};
#pragma unroll
            for (int ks = 0; ks < 4; ++ks) { const bf16x8 bfr = *(const LAS bf16x8*)(kh + (cb * 16 + fr) * 136 + ks * 32 + fq * 8); acc = MFMA16(bfr, af[ks], acc); }
            const int s0 = cb * 16 + 4 * fq; float o[4];
#pragma unroll
            for (int i = 0; i < 4; ++i) { const int s = s0 + i; const bool keep = isq ? (s <= pr) : (s < pr);
                const float e = keep ? __expf(bp - gb[s]) : 0.f; o[i] = keep ? acc[i] * e * (isq ? 1.0f : betap) : 0.f; }
            if (isq) { u32x2 ov; ov.x = pk2(o[0], o[1]); ov.y = pk2(o[2], o[3]); *(u32x2*)(g_at + pr * 64 + s0) = ov; }
            else *(LAS f32x4*)(Lm + pr * 68 + s0) = (f32x4){o[0], o[1], o[2], o[3]}; } }
    __syncthreads();
    if (tid < 256) { const bool isw = tid < 128; const int j = isw ? tid : tid - 128; LAS const float* src = isw ? kf : vf;
        float x[64];
#pragma unroll
        for (int p = 0; p < 64; ++p) { const float sc = isw ? bt[p] * __expf(gb[p]) : bt[p]; x[p] = sc * src[p * 129 + j]; }
#pragma unroll
        for (int p = 1; p < 64; ++p) { float acc = x[p];
            asm volatile("" ::: "memory");
#pragma unroll
            for (int s = 0; s < p; ++s) acc -= Lm[p * 68 + s] * x[s];
            x[p] = acc; }
        if (isw) {
#pragma unroll
            for (int p = 0; p < 64; ++p) g_nw[p * 128 + j] = f2bf(-x[p]); }
        else {
#pragma unroll
            for (int q = 0; q < 8; ++q) { float t8[8];
#pragma unroll
                for (int i = 0; i < 8; ++i) t8[i] = x[q * 8 + i];
                *(u32x4*)(g_uT + j * 64 + q * 8) = pack8(t8); } } }
    __syncthreads();
}

__device__ __forceinline__ void gdn_scan_unit(const Frame& F, int b, int h, int d, int vs) {
    int tid = F.tid; asm volatile("" : "+v"(tid));
    size_t wz_ = 0; asm volatile("" : "+s"(wz_)); unsigned char* wsl = F.ws + wz_;
    int bxl = F.bx; asm volatile("" : "+s"(bxl)); (void)bxl;
    const int lane = tid & 63, w = __builtin_amdgcn_readfirstlane(tid >> 6), fr = lane & 15, fq = lane >> 4;
    LAS bf16_t* ST = (LAS bf16_t*)(F.lds);
    LAS bf16_t* VN = (LAS bf16_t*)(F.lds + 34816);
    const int pb = w >> 1, vvb0 = (w & 1) * 2, vb = w >> 1, kb0 = (w & 1) * 4;
    bf16_t* og = (bf16_t*)(wsl + WS_OGDN) + (size_t)d * R * 1024;
    f32x4 Sacc[4];
#pragma unroll
    for (int j = 0; j < 4; ++j) Sacc[j] = (f32x4){0.f, 0.f, 0.f, 0.f};
    __syncthreads();
    for (int i = tid; i < 64 * 136 / 2; i += NTHR) ((LAS unsigned*)ST)[i] = 0u;
    __syncthreads();
    int cur = 0;
    for (int step = 0; step < NCH; ++step) {
        const int ch = step_chunk(d, step), rowbase = chunk_rowbase(b, ch);
        const unsigned char* ub = wsl + WS_GDNPREP + (size_t)(((b * NCH + ch) * 8 + h) * 2 + d) * GDN_UNIT;
        const bf16_t* g_nw = (const bf16_t*)ub; const bf16_t* g_uT = (const bf16_t*)(ub + 16384); const bf16_t* g_at = (const bf16_t*)(ub + 32768); const bf16_t* g_qd = (const bf16_t*)(ub + 40960); const bf16_t* g_kdT = (const bf16_t*)(ub + 57344);
        const float cd = *(const float*)(ub + 73728);
        LAS const bf16_t* Sc = ST + cur * (64 * 136); LAS bf16_t* Sn = ST + (cur ^ 1) * (64 * 136);
        bf16x8 sb[2][4];
#pragma unroll
        for (int j = 0; j < 2; ++j)
#pragma unroll
            for (int ks = 0; ks < 4; ++ks) sb[j][ks] = *(const LAS bf16x8*)(Sc + ((vvb0 + j) * 16 + fr) * 136 + ks * 32 + fq * 8);
        { bf16x8 wa[4];
#pragma unroll
            for (int ks = 0; ks < 4; ++ks) wa[ks] = *(const bf16x8*)(g_nw + (pb * 16 + fr) * 128 + ks * 32 + fq * 8);
#pragma unroll
            for (int j = 0; j < 2; ++j) { const int vvb = vvb0 + j;
                const u32x2 uw = *(const u32x2*)(g_uT + (vs * 64 + vvb * 16 + fr) * 64 + pb * 16 + 4 * fq);
                f32x4 acc = (f32x4){lo16(uw.x), hi16(uw.x), lo16(uw.y), hi16(uw.y)};
#pragma unroll
                for (int ks = 0; ks < 4; ++ks) acc = MFMA16(wa[ks], sb[j][ks], acc);
                u32x2 o; o.x = pk2(acc[0], acc[1]); o.y = pk2(acc[2], acc[3]);
                *(LAS u32x2*)(VN + (vvb * 16 + fr) * 72 + pb * 16 + 4 * fq) = o; } }
        __syncthreads();
        { bf16x8 qa[4], aa[2];
#pragma unroll
            for (int ks = 0; ks < 4; ++ks) qa[ks] = *(const bf16x8*)(g_qd + (pb * 16 + fr) * 128 + ks * 32 + fq * 8);
#pragma unroll
            for (int ks = 0; ks < 2; ++ks) aa[ks] = *(const bf16x8*)(g_at + (pb * 16 + fr) * 64 + ks * 32 + fq * 8);
#pragma unroll
            for (int j = 0; j < 2; ++j) { const int vvb = vvb0 + j; f32x4 acc = (f32x4){0.f, 0.f, 0.f, 0.f};
#pragma unroll
                for (int ks = 0; ks < 4; ++ks) acc = MFMA16(sb[j][ks], qa[ks], acc);
#pragma unroll
                for (int ks = 0; ks < 2; ++ks) { const bf16x8 bv = *(const LAS bf16x8*)(VN + (vvb * 16 + fr) * 72 + ks * 32 + fq * 8); acc = MFMA16(bv, aa[ks], acc); }
                const int pr = pb * 16 + fr, tk = d ? 63 - pr : pr;
                u32x2 o; o.x = pk2(acc[0], acc[1]); o.y = pk2(acc[2], acc[3]);
                *(u32x2*)(og + (size_t)(rowbase + tk) * 1024 + h * 128 + vs * 64 + vvb * 16 + 4 * fq) = o; } }
        { bf16x8 va[2];
#pragma unroll
            for (int ks = 0; ks < 2; ++ks) va[ks] = *(const LAS bf16x8*)(VN + (vb * 16 + fr) * 72 + ks * 32 + fq * 8);
#pragma unroll
            for (int j = 0; j < 4; ++j) { const int kb = kb0 + j; f32x4 acc = Sacc[j] * cd;
#pragma unroll
                for (int ks = 0; ks < 2; ++ks) { const bf16x8 bt = *(const bf16x8*)(g_kdT + (kb * 16 + fr) * 64 + ks * 32 + fq * 8); acc = MFMA16(bt, va[ks], acc); }
                Sacc[j] = acc;
                u32x2 o; o.x = pk2(acc[0], acc[1]); o.y = pk2(acc[2], acc[3]);
                *(LAS u32x2*)(Sn + (vb * 16 + fr) * 136 + kb * 16 + 4 * fq) = o; } }
        __syncthreads();
        cur ^= 1;
    }
}

__device__ __forceinline__ void phase_merge_prep(const Frame& F, int l, int nrows) {
    int tid = F.tid; asm volatile("" : "+v"(tid));
    size_t wz_ = 0; asm volatile("" : "+s"(wz_)); unsigned char* wsl = F.ws + wz_;
    int bxl = F.bx; asm volatile("" : "+s"(bxl)); (void)bxl;
    const int lane = tid & 63, wave = __builtin_amdgcn_readfirstlane(tid >> 6); (void)lane; (void)wave;
    const bf16_t* P = (const bf16_t*)(wsl + WS_P);
    const bf16_t* oga = (const bf16_t*)(wsl + WS_OGLA); const bf16_t* ogd = (const bf16_t*)(wsl + WS_OGDN);
    bf16_t* yga = (bf16_t*)(wsl + WS_YGLA); bf16_t* ygd = (bf16_t*)(wsl + WS_YGDN); bf16_t* pld = (bf16_t*)(wsl + WS_PLD);
    const float* gnw = F.in[I_GLANW] + l * 256; const float* dnw = F.in[I_GDNNW] + l * 128;
    const int c0 = lane * 16;
    for (int r = bxl * 8 + wave; r < nrows; r += F.G * 8) {
        { float o[16], z[16], t8[8];
            const bf16_t* a0 = oga + (size_t)r * 1024 + c0; const bf16_t* a1 = a0 + (size_t)R * 1024;
            unpack8(*(const u32x4*)a0, t8);
#pragma unroll
            for (int i = 0; i < 8; ++i) o[i] = t8[i];
            unpack8(*(const u32x4*)(a0 + 8), t8);
#pragma unroll
            for (int i = 0; i < 8; ++i) o[8 + i] = t8[i];
            unpack8(*(const u32x4*)a1, t8);
#pragma unroll
            for (int i = 0; i < 8; ++i) o[i] += t8[i];
            unpack8(*(const u32x4*)(a1 + 8), t8);
#pragma unroll
            for (int i = 0; i < 8; ++i) o[8 + i] += t8[i];
            const bf16_t* zp = P + (size_t)r * NP + PC_GLA_Z + c0;
            unpack8(*(const u32x4*)zp, t8);
#pragma unroll
            for (int i = 0; i < 8; ++i) z[i] = t8[i];
            unpack8(*(const u32x4*)(zp + 8), t8);
#pragma unroll
            for (int i = 0; i < 8; ++i) z[8 + i] = t8[i];
            float ss = 0.f;
#pragma unroll
            for (int i = 0; i < 16; ++i) ss += o[i] * o[i];
#pragma unroll
            for (int q = 1; q < 16; q <<= 1) ss += shx(ss, q, lane);
            const float rs = rsqrtf(ss * (1.0f / 256.0f) + EPS); const int vv0 = (lane & 15) * 16;
            u32x4 w0, w1;
#pragma unroll
            for (int i = 0; i < 8; ++i) t8[i] = o[i] * rs * gnw[vv0 + i] * siluf_(z[i]);
            w0 = pack8(t8);
#pragma unroll
            for (int i = 0; i < 8; ++i) t8[i] = o[8 + i] * rs * gnw[vv0 + 8 + i] * siluf_(z[8 + i]);
            w1 = pack8(t8);
            *(u32x4*)(yga + (size_t)r * 1024 + c0) = w0; *(u32x4*)(yga + (size_t)r * 1024 + c0 + 8) = w1; }
        { float o[16], z[16], t8[8];
            const bf16_t* a0 = ogd + (size_t)r * 1024 + c0; const bf16_t* a1 = a0 + (size_t)R * 1024;
            unpack8(*(const u32x4*)a0, t8);
#pragma unroll
            for (int i = 0; i < 8; ++i) o[i] = t8[i];
            unpack8(*(const u32x4*)(a0 + 8), t8);
#pragma unroll
            for (int i = 0; i < 8; ++i) o[8 + i] = t8[i];
            unpack8(*(const u32x4*)a1, t8);
#pragma unroll
            for (int i = 0; i < 8; ++i) o[i] += t8[i];
            unpack8(*(const u32x4*)(a1 + 8), t8);
#pragma unroll
            for (int i = 0; i < 8; ++i) o[8 + i] += t8[i];
            const bf16_t* zp = P + (size_t)r * NP + PC_GDN_Z + c0;
            unpack8(*(const u32x4*)zp, t8);
#pragma unroll
            for (int i = 0; i < 8; ++i) z[i] = t8[i];
            unpack8(*(const u32x4*)(zp + 8), t8);
#pragma unroll
            for (int i = 0; i < 8; ++i) z[8 + i] = t8[i];
            float ss = 0.f;
#pragma unroll
            for (int i = 0; i < 16; ++i) ss += o[i] * o[i];
#pragma unroll
            for (int q = 1; q < 8; q <<= 1) ss += shx(ss, q, lane);
            const float rs = rsqrtf(ss * (1.0f / 128.0f) + EPS); const int vv0 = (lane & 7) * 16;
            u32x4 w0, w1;
#pragma unroll
            for (int i = 0; i < 8; ++i) t8[i] = o[i] * rs * dnw[vv0 + i] * siluf_(z[i]);
            w0 = pack8(t8);
#pragma unroll
            for (int i = 0; i < 8; ++i) t8[i] = o[8 + i] * rs * dnw[vv0 + 8 + i] * siluf_(z[8 + i]);
            w1 = pack8(t8);
            *(u32x4*)(ygd + (size_t)r * 1024 + c0) = w0; *(u32x4*)(ygd + (size_t)r * 1024 + c0 + 8) = w1; }
        { const int T = r < RL ? SEQ : CTXL, ts = r < RL ? (r & (SEQ - 1)) : ((r - RL) & (CTXL - 1)), segbase = r - ts;
            const int win = 2 << (lane >> 4), lo = max(ts - win / 2, 0), hi = min(ts - win / 2 + win, T);
            float s[16], t8[8];
#pragma unroll
            for (int i = 0; i < 16; ++i) s[i] = 0.f;
            for (int t = lo; t < hi; ++t) { const bf16_t* up = P + (size_t)(segbase + t) * NP + PC_POOL + c0;
                unpack8(*(const u32x4*)up, t8);
#pragma unroll
                for (int i = 0; i < 8; ++i) s[i] += t8[i];
                unpack8(*(const u32x4*)(up + 8), t8);
#pragma unroll
                for (int i = 0; i < 8; ++i) s[8 + i] += t8[i]; }
            const float inv = 1.0f / (float)(hi - lo);
            const bf16_t* up = P + (size_t)r * NP + PC_POOL + c0;
            u32x4 w0, w1;
            unpack8(*(const u32x4*)up, t8);
#pragma unroll
            for (int i = 0; i < 8; ++i) t8[i] = s[i] * inv - t8[i];
            w0 = pack8(t8);
            unpack8(*(const u32x4*)(up + 8), t8);
#pragma unroll
            for (int i = 0; i < 8; ++i) t8[i] = s[8 + i] * inv - t8[i];
            w1 = pack8(t8);
            *(u32x4*)(pld + (size_t)r * 1024 + c0) = w0; *(u32x4*)(pld + (size_t)r * 1024 + c0 + 8) = w1; }
    }
}

__device__ __forceinline__ void phase_convglu(const Frame& F, int l, int nrows) {
    int tid = F.tid; asm volatile("" : "+v"(tid));
    size_t wz_ = 0; asm volatile("" : "+s"(wz_)); unsigned char* wsl = F.ws + wz_;
    int bxl = F.bx; asm volatile("" : "+s"(bxl)); (void)bxl;
    const int lane = tid & 63, wave = __builtin_amdgcn_readfirstlane(tid >> 6); (void)lane; (void)wave;
    const bf16_t* av = (const bf16_t*)(wsl + WS_AV); bf16_t* gout = (bf16_t*)(wsl + WS_G);
    const float* cw = F.in[I_FFNCONV] + (size_t)l * 9 * DFF;
    constexpr int CG = DFF / 8;
    const long total = (long)nrows * CG;
    for (long idx = (long)bxl * NTHR + tid; idx < total; idx += (long)F.G * NTHR) {
        const int r = (int)(idx / CG), c = (int)(idx % CG) * 8;
        int gy, gx, H, W;
        if (r < RL) { const int t = r & (SEQ - 1); gy = t >> 6; gx = t & 63; H = 32; W = 64; } else { gy = 0; gx = (r - RL) & (CTXL - 1); H = 1; W = CTXL; }
        float acc[8], t8[8];
#pragma unroll
        for (int i = 0; i < 8; ++i) acc[i] = 0.f;
#pragma unroll
        for (int dy = -1; dy <= 1; ++dy)
#pragma unroll
            for (int dx = -1; dx <= 1; ++dx) { const int yy = gy + dy, xx = gx + dx;
                if (yy >= 0 && yy < H && xx >= 0 && xx < W) {
                    unpack8(*(const u32x4*)(av + (size_t)(r + dy * W + dx) * NAV + c), t8);
                    const float* wp = cw + ((dy + 1) * 3 + (dx + 1)) * DFF + c;
                    const f32x4 w0 = *(const f32x4*)wp, w1 = *(const f32x4*)(wp + 4);
#pragma unroll
                    for (int i = 0; i < 4; ++i) { acc[i] += t8[i] * w0[i]; acc[4 + i] += t8[4 + i] * w1[i]; } } }
        unpack8(*(const u32x4*)(av + (size_t)r * NAV + DFF + c), t8);
#pragma unroll
        for (int i = 0; i < 8; ++i) t8[i] = siluf_(acc[i]) * t8[i];
        *(u32x4*)(gout + (size_t)r * DFF + c) = pack8(t8);
    }
}

__global__ void __launch_bounds__(512, 2) fwd(Args args) {
    extern __shared__ __attribute__((aligned(16))) unsigned char lds_raw[];
    Frame F;
    F.lds = (LAS unsigned char*)lds_raw; F.ws = args.ws; F.in = args.in; F.out = args.out;
    F.tid = threadIdx.x; F.lane = F.tid & 63; F.wave = __builtin_amdgcn_readfirstlane(F.tid >> 6); F.G = gridDim.x; F.bx = blockIdx.x;
    volatile LAS unsigned* misc = (volatile LAS unsigned*)(F.lds + MISC_OFF);
    if (F.tid < 4) misc[F.tid] = 0u;
    __syncthreads();
    XcdBarrier bar = xcd_barrier_post((unsigned*)(F.ws + WS_CTL), misc);
    unsigned char* ws = F.ws; int bx = F.bx;
#define mods ((float*)(ws + WS_MODS))
#define xres ((float*)(ws + WS_XRES))
#define hA ((bf16_t*)(ws + WS_HA))
#define P ((bf16_t*)(ws + WS_P))
#define small ((float*)(ws + WS_SMALL))

#ifndef SK_MODS
    phase_mods(F);
#endif
    for (int l = 0; l < DEPTH; ++l) {
        const bool last = (l == DEPTH - 1);
        const int Mrows = last ? RL : R;
        const float* mods_l = mods + (size_t)l * 9 * 12288;
#ifndef SK_W
        phase_weights(F, l);
#endif
        if (l == 0) { xcd_barrier(bar); phase_mods_reduce(F); xcd_barrier(bar); }
        if (l == 0) phase_norm(F, F.in[I_X], F.in[I_CTX], xres, F.in[I_N1W] + l * D, mods_l, 0, hA, R);
        else phase_norm(F, xres, xres + (size_t)RL * D, nullptr, F.in[I_N1W] + l * D, mods_l, 0, hA, R);
        xcd_barrier(bar);
        { size_t wz_ = 0; asm volatile("" : "+s"(wz_)); ws = F.ws + wz_; } asm volatile("" : "+s"(bx));
        { pg8::Sched S; S.init(hA, D, 0, ws + WS_WIN, D, 0, R, NIN, 1, F.G, bx);
          pg8::EpiInProj E{P, small};
#if !defined(SK_GEMM) && !defined(SK_GEMM0)
          pg8::gemm_phase(F.lds, D, D, D, S, E);
#endif
          }
        xcd_barrier(bar);
        { size_t wz_ = 0; asm volatile("" : "+s"(wz_)); ws = F.ws + wz_; } asm volatile("" : "+s"(bx));
#ifndef SK_GLAPREP
        for (int u = bx; u < NB * NCH * 4 * 2; u += F.G) { const int d = u & 1, h = (u >> 1) & 3, ch = (u >> 3) % NCH, b = (u >> 3) / NCH; gla_prep_unit(F, l, b, ch, h, d); }
#endif
#ifndef SK_GDNPREP
        for (int u = bx; u < NB * NCH * 8 * 2; u += F.G) { const int d = u & 1, h = (u >> 1) & 7, ch = (u >> 4) % NCH, b = (u >> 4) / NCH; gdn_prep_unit(F, l, b, ch, h, d); }
#endif
        xcd_barrier(bar);
        { size_t wz_ = 0; asm volatile("" : "+s"(wz_)); ws = F.ws + wz_; } asm volatile("" : "+s"(bx));
#ifndef SK_GLASCAN
        for (int u = bx; u < NB * 4 * 2 * 4; u += F.G) { const int vs = u & 3, d = (u >> 2) & 1, h = (u >> 3) & 3, b = u >> 5; gla_scan_unit(F, b, h, d, vs); }
#endif
#ifndef SK_GDNSCAN
        for (int u = bx; u < NB * 8 * 2 * 2; u += F.G) { const int vs = u & 1, d = (u >> 1) & 1, h = (u >> 2) & 7, b = u >> 5; gdn_scan_unit(F, b, h, d, vs); }
#endif
        xcd_barrier(bar);
        { size_t wz_ = 0; asm volatile("" : "+s"(wz_)); ws = F.ws + wz_; } asm volatile("" : "+s"(bx));
#ifndef SK_MERGE
        phase_merge_prep(F, l, Mrows);
#endif
        xcd_barrier(bar);
        { size_t wz_ = 0; asm volatile("" : "+s"(wz_)); ws = F.ws + wz_; } asm volatile("" : "+s"(bx));
        { pg8::Sched S; S.init(ws + WS_PLD, 1024, 512, ws + WS_WPOOL, 256, 131072, Mrows, 256, 4, F.G, bx);
          pg8::EpiPool E{(bf16_t*)(ws + WS_YPOOL), F.in[I_POOLS] + l * 1024};
#if !defined(SK_GEMM) && !defined(SK_GEMM1)
          pg8::gemm_phase(F.lds, 256, 1024, 256, S, E);
#endif
          }
        { pg8::Sched S; S.init(ws + WS_YGLA, 1024, 0, ws + WS_WBR, 1024, 0, Mrows, D, 1, F.G, bx);
          pg8::EpiBranch<0> E{P, (float*)(ws + WS_M32), hA};
#if !defined(SK_GEMM) && !defined(SK_GEMM2)
          pg8::gemm_phase(F.lds, 1024, 1024, 1024, S, E);
#endif
          }
        xcd_barrier(bar);
        { size_t wz_ = 0; asm volatile("" : "+s"(wz_)); ws = F.ws + wz_; } asm volatile("" : "+s"(bx));
        { pg8::Sched S; S.init(ws + WS_YGDN, 1024, 0, ws + WS_WBR + (size_t)D * 1024 * 2, 1024, 0, Mrows, D, 1, F.G, bx);
          pg8::EpiBranch<1> E{P, (float*)(ws + WS_M32), hA};
#if !defined(SK_GEMM) && !defined(SK_GEMM3)
          pg8::gemm_phase(F.lds, 1024, 1024, 1024, S, E);
#endif
          }
        xcd_barrier(bar);
        { size_t wz_ = 0; asm volatile("" : "+s"(wz_)); ws = F.ws + wz_; } asm volatile("" : "+s"(bx));
        { pg8::Sched S; S.init(ws + WS_YPOOL, 1024, 0, ws + WS_WBR + (size_t)2 * D * 1024 * 2, 1024, 0, Mrows, D, 1, F.G, bx);
          pg8::EpiBranch<2> E{P, (float*)(ws + WS_M32), hA};
#if !defined(SK_GEMM) && !defined(SK_GEMM4)
          pg8::gemm_phase(F.lds, 1024, 1024, 1024, S, E);
#endif
          }
        xcd_barrier(bar);
        { size_t wz_ = 0; asm volatile("" : "+s"(wz_)); ws = F.ws + wz_; } asm volatile("" : "+s"(bx));
        { pg8::Sched S; S.init(hA, D, 0, ws + WS_WOUT, D, 0, Mrows, D, 1, F.G, bx);
          pg8::EpiResid E{xres, mods_l + 2 * D};
#if !defined(SK_GEMM) && !defined(SK_GEMM5)
          pg8::gemm_phase(F.lds, D, D, D, S, E);
#endif
          }
        xcd_barrier(bar);
        { size_t wz_ = 0; asm volatile("" : "+s"(wz_)); ws = F.ws + wz_; } asm volatile("" : "+s"(bx));
        phase_norm(F, xres, xres + (size_t)RL * D, nullptr, F.in[I_N2W] + l * D, mods_l, 3, hA, Mrows);
        xcd_barrier(bar);
        { size_t wz_ = 0; asm volatile("" : "+s"(wz_)); ws = F.ws + wz_; } asm volatile("" : "+s"(bx));
        { pg8::Sched S; S.init(hA, D, 0, ws + WS_WUP, D, 0, Mrows, NAV, 1, F.G, bx);
          pg8::EpiBf16 E{(bf16_t*)(ws + WS_AV), NAV};
#if !defined(SK_GEMM) && !defined(SK_GEMM6)
          pg8::gemm_phase(F.lds, D, D, D, S, E);
#endif
          }
        xcd_barrier(bar);
        { size_t wz_ = 0; asm volatile("" : "+s"(wz_)); ws = F.ws + wz_; } asm volatile("" : "+s"(bx));
#ifndef SK_CONV
        phase_convglu(F, l, Mrows);
#endif
        xcd_barrier(bar);
        { size_t wz_ = 0; asm volatile("" : "+s"(wz_)); ws = F.ws + wz_; } asm volatile("" : "+s"(bx));
        { pg8::Sched S; S.init(ws + WS_G, DFF, 0, ws + WS_WDN, DFF, 0, Mrows, D, 1, F.G, bx);
          pg8::EpiResid E{xres, mods_l + 5 * D};
#if !defined(SK_GEMM) && !defined(SK_GEMM7)
          pg8::gemm_phase(F.lds, DFF, DFF, DFF, S, E);
#endif
          }
        xcd_barrier(bar);
        { size_t wz_ = 0; asm volatile("" : "+s"(wz_)); ws = F.ws + wz_; } asm volatile("" : "+s"(bx));
    }
    phase_final_norm(F, xres, F.in[I_FINALW], F.out);
#undef mods
#undef xres
#undef hA
#undef P
#undef small
}

extern "C" void kernel_launch(void* const* d_in, const int* in_sizes, int n_in, void* d_out, int out_size, void* d_ws, size_t ws_size, hipStream_t stream) {
    static int grid = 0;
    if (grid == 0) {
        if (n_in != 26 || in_sizes[0] != RL * D || out_size != RL * D || ws_size < WS_END) { fprintf(stderr, "kernel_launch: unexpected shapes / workspace (%zu needed, %zu given)\n", (size_t)WS_END, ws_size); grid = -1; return; }
        int dev = 0, cus = 0, per_cu = 0;
        if (hipGetDevice(&dev) != hipSuccess || hipDeviceGetAttribute(&cus, hipDeviceAttributeMultiprocessorCount, dev) != hipSuccess) { grid = -1; return; }
        if (hipFuncSetAttribute((const void*)fwd, hipFuncAttributeMaxDynamicSharedMemorySize, LDS_BYTES) != hipSuccess) { fprintf(stderr, "kernel_launch: hipFuncSetAttribute failed\n"); grid = -1; return; }
        if (hipOccupancyMaxActiveBlocksPerMultiprocessor(&per_cu, (const void*)fwd, NTHR, LDS_BYTES) != hipSuccess || per_cu < 1) { fprintf(stderr, "kernel_launch: occupancy query says %d\n", per_cu); (void)hipGetLastError(); grid = -1; return; }
        grid = cus;
    }
    if (grid < 0) return;
    if (hipMemsetAsync((char*)d_ws + WS_CTL, 0, ZERO_BYTES, stream) != hipSuccess) return;
    Args a{};
    for (int i = 0; i < 26; ++i) a.in[i] = (const float*)d_in[i];
    a.out = (float*)d_out; a.ws = (unsigned char*)d_ws;
    hipLaunchKernelGGL(fwd, dim3(grid), dim3(NTHR), LDS_BYTES, stream, a);
}
```

```cpp
#include <hip/hip_runtime.h>
#include <cstdio>
#include <cstdint>

#define LAS __attribute__((address_space(3)))
#ifndef PROBE_GDN
#define PROBE_GDN 0
#endif
typedef unsigned short bf16_t;
typedef short bf16x8 __attribute__((ext_vector_type(8)));
typedef float f32x4 __attribute__((ext_vector_type(4)));
typedef unsigned u32x4 __attribute__((ext_vector_type(4)));
typedef unsigned u32x2 __attribute__((ext_vector_type(2)));

constexpr int D = 2048, NB = 8, SEQ = 2048, CTXL = 256, DEPTH = 4;
constexpr int RL = NB * SEQ, RC = NB * CTXL, R = RL + RC;
constexpr int NP = 14336, NIN = 14592, NIN_ORIG = 14400;
constexpr int DFF = 5632, NAV = 2 * DFF;
constexpr int PC_GLA_Q = 0, PC_GLA_K = 512, PC_GLA_V = 1024, PC_GLA_Z = 2048, PC_GDN_Q = 3072, PC_GDN_K = 4096, PC_GDN_V = 5120, PC_GDN_Z = 6144, PC_POOL = 7168, PC_GATE = 8192;
constexpr int NCH = 36;
constexpr float EPS = 1e-6f;
constexpr int NTHR = 512;

constexpr size_t al256(size_t x) { return (x + 255) & ~(size_t)255; }
constexpr size_t WS_CTL = 0;
constexpr size_t CTL_BYTES = 65536;
constexpr size_t WS_MODS = WS_CTL + CTL_BYTES;
constexpr size_t MODS_BYTES = (size_t)DEPTH * 9 * 12288 * 4;
constexpr size_t ZERO_BYTES = CTL_BYTES;
constexpr size_t WS_SMALL = al256(WS_MODS + MODS_BYTES);
constexpr size_t WS_XRES = al256(WS_SMALL + (size_t)R * 64 * 4);
constexpr size_t WS_HA = al256(WS_XRES + (size_t)R * D * 4);
constexpr size_t WS_WIN = al256(WS_HA + (size_t)R * D * 2);
constexpr size_t WS_WBR = al256(WS_WIN + (size_t)NIN * D * 2);
constexpr size_t WS_WOUT = al256(WS_WBR + (size_t)3 * D * 1024 * 2);
constexpr size_t WS_WUP = al256(WS_WOUT + (size_t)D * D * 2);
constexpr size_t WS_WDN = al256(WS_WUP + (size_t)NAV * D * 2);
constexpr size_t WS_WPOOL = al256(WS_WDN + (size_t)D * DFF * 2);
constexpr size_t WS_BIG = al256(WS_WPOOL + (size_t)4 * 256 * 256 * 2);
constexpr size_t WS_P = WS_BIG;
constexpr size_t WS_MODP = WS_BIG;
constexpr size_t GLA_UNIT = 66048, GDN_UNIT = 73984;
constexpr size_t WS_GLAPREP = al256(WS_P + (size_t)R * NP * 2);
constexpr size_t WS_GDNPREP = al256(WS_GLAPREP + (size_t)NB * NCH * 4 * 2 * GLA_UNIT);
constexpr size_t GDNPREP_BYTES = (size_t)NB * NCH * 8 * 2 * GDN_UNIT;
constexpr size_t WS_OGLA = al256(WS_GDNPREP + GDNPREP_BYTES);
constexpr size_t WS_OGDN = al256(WS_OGLA + (size_t)2 * R * 1024 * 2);
constexpr size_t WS_MIX_END = al256(WS_OGDN + (size_t)2 * R * 1024 * 2);
constexpr size_t WS_Y3 = WS_GDNPREP;
constexpr size_t WS_PLD = WS_Y3 + (size_t)R * 3072 * 2;
static_assert(WS_PLD + (size_t)R * 1024 * 2 <= WS_GDNPREP + GDNPREP_BYTES, "overlay");
constexpr size_t WS_AV = WS_BIG;
constexpr size_t WS_G = al256(WS_AV + (size_t)R * NAV * 2);
static_assert(WS_G + (size_t)R * DFF * 2 <= WS_MIX_END, "ffn overlay");
constexpr size_t WS_END = WS_MIX_END;

constexpr int LDS_BYTES = 131072 + 1024;
constexpr int MISC_OFF = 131072;

__device__ __forceinline__ float bf2f(bf16_t b) { return __uint_as_float(((unsigned)b) << 16); }
typedef float f32x2_t __attribute__((ext_vector_type(2)));
typedef __bf16 bf16x2_t __attribute__((ext_vector_type(2)));
__device__ __forceinline__ unsigned pk2(float lo, float hi) { const f32x2_t v = {lo, hi}; const bf16x2_t b = __builtin_convertvector(v, bf16x2_t); return __builtin_bit_cast(unsigned, b); }
__device__ __forceinline__ bf16_t f2bf(float f) { return (bf16_t)(pk2(f, 0.f) & 0xFFFFu); }
__device__ __forceinline__ float lo16(unsigned w) { return __uint_as_float(w << 16); }
__device__ __forceinline__ float hi16(unsigned w) { return __uint_as_float(w & 0xFFFF0000u); }
__device__ __forceinline__ float sigmoidf_(float x) { return __builtin_amdgcn_rcpf(1.0f + __expf(-x)); }
__device__ __forceinline__ float siluf_(float x) { return x * __builtin_amdgcn_rcpf(1.0f + __expf(-x)); }
__device__ __forceinline__ float softplusf_(float x) { return x > 20.f ? x : __logf(1.0f + __expf(x)); }
__device__ __forceinline__ float logsigf_(float z) { return fminf(z, 0.f) - __logf(1.0f + __expf(-fabsf(z))); }
__device__ __forceinline__ void unpack8(const u32x4 w, float (&f)[8]) { f[0] = lo16(w.x); f[1] = hi16(w.x); f[2] = lo16(w.y); f[3] = hi16(w.y); f[4] = lo16(w.z); f[5] = hi16(w.z); f[6] = lo16(w.w); f[7] = hi16(w.w); }
__device__ __forceinline__ u32x4 pack8(const float (&f)[8]) { u32x4 w; w.x = pk2(f[0], f[1]); w.y = pk2(f[2], f[3]); w.z = pk2(f[4], f[5]); w.w = pk2(f[6], f[7]); return w; }
typedef _Float16 h16x8_t __attribute__((ext_vector_type(8)));
typedef float f32x8_t __attribute__((ext_vector_type(8)));
__device__ __forceinline__ void unpack8h(const u32x4 w, float (&f)[8]) { const f32x8_t v = __builtin_convertvector(__builtin_bit_cast(h16x8_t, w), f32x8_t);
#pragma unroll
    for (int i = 0; i < 8; ++i) f[i] = v[i]; }
__device__ __forceinline__ u32x4 pack8h(const float (&f)[8]) { f32x8_t v;
#pragma unroll
    for (int i = 0; i < 8; ++i) v[i] = f[i];
    return __builtin_bit_cast(u32x4, __builtin_convertvector(v, h16x8_t)); }
__device__ __forceinline__ float shx(float v, int o, int lane) { return __int_as_float(__builtin_amdgcn_ds_bpermute((lane ^ o) << 2, __float_as_int(v))); }
__device__ __forceinline__ float shup(float v, int o, int lane) { return __int_as_float(__builtin_amdgcn_ds_bpermute((lane - o) << 2, __float_as_int(v))); }
__device__ __forceinline__ int frag_off(int row, int k, int KT) { return ((((row >> 4) * KT + (k >> 5)) << 9) + ((((k >> 3) & 3) << 4) + (row & 15)) * 8 + (k & 7)); }
__device__ __forceinline__ int frag_tile(int rb, int ks, int KT, int lane) { return (((rb * KT + ks) << 9) + lane * 8); }
#define MFMA16(a, b, c) __builtin_amdgcn_mfma_f32_16x16x32_bf16((a), (b), (c), 0, 0, 0)

#define XB_TMO      128
#define XB_XCNT(j)  (256  + 64 * (j))
#define XB_XSUB(j)  (1280 + 64 * (j))
#define XB_XGEN(j)  (2304 + 64 * (j))
#define XB_TOP      3328
#define XB_TOPGEN   3392
#define XCD_BAR_WORDS 3456
#define XB_SPIN_CAP (1u << 22)
__device__ __forceinline__ unsigned xb_ld(unsigned* p)              { return __hip_atomic_load(p, __ATOMIC_RELAXED, __HIP_MEMORY_SCOPE_AGENT); }
__device__ __forceinline__ unsigned xb_add(unsigned* p, unsigned v) { return __hip_atomic_fetch_add(p, v, __ATOMIC_RELAXED, __HIP_MEMORY_SCOPE_AGENT); }
__device__ __forceinline__ unsigned xb_xcc_id() { return (unsigned)__builtin_amdgcn_s_getreg((3 << 11) | 20) & 0xFu; }
#define XB_SPIN(cond, bar) do { unsigned _sp = 0; while (cond) { __builtin_amdgcn_s_sleep(1); \
    if ((++_sp & 255u) == 0u) { if (xb_ld(&(bar)[XB_TMO])) break; if (_sp > XB_SPIN_CAP) { atomicAdd(&(bar)[XB_TMO], 1u); break; } } } } while (0)
struct XcdBarrier { unsigned* bar; unsigned x; volatile LAS unsigned* st; };
__device__ __forceinline__ XcdBarrier xcd_barrier_post(unsigned* bar, volatile LAS unsigned* st) {
    XcdBarrier b; b.bar = bar; b.x = xb_xcc_id(); b.st = st;
    if (threadIdx.x == 0) (void)xb_add(&bar[XB_XCNT(b.x)], 1u);
    return b;
}
__device__ __forceinline__ void xcd_barrier_complete(unsigned* bar, unsigned x, unsigned& nloc, unsigned& nx) {
    const unsigned G = gridDim.x * gridDim.y * gridDim.z;
    unsigned sum, cnt, mine, sp = 0u;
    for (;;) {
        sum = 0u; cnt = 0u; mine = 0u;
#pragma unroll
        for (unsigned j = 0; j < 16; ++j) { const unsigned c = xb_ld(&bar[XB_XCNT(j)]); sum += c; cnt += (c > 0u) ? 1u : 0u; }
        mine = xb_ld(&bar[XB_XCNT(x)]);
        if (sum == G) break;
        __builtin_amdgcn_s_sleep(1);
        if ((++sp & 255u) == 0u) { if (xb_ld(&bar[XB_TMO])) break; if (sp > XB_SPIN_CAP) { atomicAdd(&bar[XB_TMO], 1u); break; } }
    }
    nloc = mine > 0u ? mine : 1u; nx = cnt > 0u ? cnt : 1u;
}
__device__ __forceinline__ void xcd_barrier(const XcdBarrier& b) {
    asm volatile("s_waitcnt vmcnt(0)" ::: "memory");
    __syncthreads();
    if (threadIdx.x == 0) {
        unsigned bz_ = 0; asm volatile("" : "+s"(bz_)); unsigned* bar = b.bar + bz_;
        __builtin_amdgcn_s_waitcnt(0);
        unsigned nloc = b.st[0], nx = b.st[1];
        if (nloc == 0u) { xcd_barrier_complete(bar, b.x, nloc, nx); b.st[0] = nloc; b.st[1] = nx; }
        const unsigned old = xb_add(&bar[XB_XSUB(b.x)], 1u);
        const unsigned gen = old / nloc;
        if (old + 1u == (gen + 1u) * nloc) {
            __builtin_amdgcn_fence(__ATOMIC_RELEASE, "agent");
            asm volatile("s_waitcnt vmcnt(0)" ::: "memory");
            const unsigned og = xb_add(&bar[XB_TOP], 1u);
            const unsigned tg = og / nx;
            if (og + 1u == (tg + 1u) * nx) xb_add(&bar[XB_TOPGEN], 1u);
            else XB_SPIN(xb_ld(&bar[XB_TOPGEN]) == tg, bar);
            __builtin_amdgcn_fence(__ATOMIC_ACQUIRE, "agent");
            xb_add(&bar[XB_XGEN(b.x)], 1u);
            asm volatile("s_waitcnt vmcnt(0)" ::: "memory");
        } else {
            XB_SPIN(xb_ld(&bar[XB_XGEN(b.x)]) == gen, bar);
            __builtin_amdgcn_fence(__ATOMIC_ACQUIRE, "agent");
            asm volatile("s_waitcnt vmcnt(0)" ::: "memory");
        }
    }
    __syncthreads();
}

namespace pg8 {
constexpr int BM = 256, BK = 64, HALF = 128, HTB = HALF * BK * 2, STAGE_BYTES = 8 * HTB, NXCD = 8, WGM = 8;
__device__ __forceinline__ int lds_byte(int r, int c) { const int st = (r >> 4) * 2 + (c >> 5), rr = r & 15, cc = c & 31, ob = rr * 64 + cc * 2; return st * 1024 + (ob ^ (((ob >> 9) & 1) << 5)); }
__device__ __forceinline__ void stage_rc(int b, int& R_, int& C_) { const int st = b / 1024, sb = b % 1024, swz = sb ^ (((sb >> 9) & 1) << 5); R_ = (st >> 1) * 16 + swz / 64; C_ = (st & 1) * 32 + (swz % 64) / 2; }
__device__ __forceinline__ int perm32(int rho) { const int n = rho >> 4, i = rho & 15; return 8 * (i >> 2) + 4 * n + (i & 3); }
struct Unit { int pm, pn, z; const char* a; const char* b; };
struct Sched {
    int nM, nN, nZ, per, G, c, xtra, xpm0; const char* A; const char* B; size_t sA, sB, zA, zB;
    __device__ __forceinline__ void init(const void* A_, int lda, size_t zA_, const void* B_, int ldb, size_t zB_, int M, int N, int nZ_, int G_, int c_, int bm = BM) {
        nM = M / bm; nN = N / BM; nZ = nZ_; per = nM * nN; G = G_; c = c_; xtra = 0; xpm0 = 0; A = (const char*)A_; B = (const char*)B_; sA = (size_t)bm * lda * 2; sB = (size_t)BM * ldb * 2; zA = zA_; zB = zB_; }
    __device__ __forceinline__ bool next(int i, Unit& u) const {
        const long L = (long)i * G + c; if (L >= (long)per * nZ + xtra) return false;
        if (L >= (long)per * nZ) { const int e = (int)(L - (long)per * nZ), idx = e % 15;
            u.pm = xpm0 + e / 15; u.pn = idx < 6 ? 2 + idx : (idx < 14 ? 10 + idx : 56); u.z = 0;
            u.a = A + (size_t)u.pm * sA; u.b = B + (size_t)u.pn * sB; return true; }
        const int z = (int)(L / per); int wgid = (int)(L % per);
        { const int q = per / NXCD, r = per % NXCD, xcd = wgid % NXCD, off = wgid / NXCD; wgid = (xcd < r ? xcd * (q + 1) : r * (q + 1) + (xcd - r) * q) + off; }
        const int nig = WGM * nN, gid = wgid / nig, fm = gid * WGM, gsz = (nM - fm) < WGM ? (nM - fm) : WGM;
        u.pm = fm + ((wgid % nig) % gsz); u.pn = (wgid % nig) / gsz; u.z = z;
        u.a = A + (size_t)z * zA + (size_t)u.pm * sA; u.b = B + (size_t)z * zB + (size_t)u.pn * sB; return true;
    }
};
__device__ __forceinline__ unsigned cvt_pk_bf16(float lo, float hi) { return pk2(lo, hi); }
__device__ __forceinline__ u32x4 pack_acc(const f32x4 v0, const f32x4 v1) { u32x4 w; w.x = cvt_pk_bf16(v0[0], v0[1]); w.y = cvt_pk_bf16(v0[2], v0[3]); w.z = cvt_pk_bf16(v1[0], v1[1]); w.w = cvt_pk_bf16(v1[2], v1[3]); return w; }

template <class E, class = void> struct has_rescale { static constexpr bool value = false; };
template <class E> struct has_rescale<E, decltype((void)E::HAS_RESCALE)> { static constexpr bool value = true; };
template <class Epi, int MT>
__device__ __forceinline__ void gemm_phase(LAS unsigned char* lds, const int K, const int lda, const int ldb, const Sched& S, const Epi& E) {
    int tid = threadIdx.x; asm volatile("" : "+v"(tid));
    const int wid = __builtin_amdgcn_readfirstlane(tid >> 6), lane = tid & 63, wr = wid >> 2, wc = wid & 3, fr = lane & 15, fq = lane >> 4;
    const int nt = K / BK; constexpr int HA = MT * 32;
    unsigned voffA[2], voffB[2];
#pragma unroll
    for (int i = 0; i < 2; ++i) { int R_, C_; stage_rc(tid * 16 + i * 8192, R_, C_); const int Rb = (R_ & ~31) + perm32(R_ & 31);
        const int Ra = R_ < HA ? R_ : HA - 1;
        voffA[i] = (unsigned)(Ra * lda + C_) * 2u; voffB[i] = (unsigned)(Rb * ldb + C_) * 2u; }
    const size_t kstep = (size_t)(BK * 2);
    const size_t hstepA = (size_t)HA * lda * 2, hstepB = (size_t)HALF * ldb * 2;
    const unsigned ldsw = (unsigned)wid * 1024u;
    const int aoff = lds_byte(wr * (MT * 16) + fr, fq * 8), boff = lds_byte(wc * 32 + fr, fq * 8);
#define PG8_SA(b, h) (((b) * 2 + (h)) * HTB)
#define PG8_SB(b, h) ((4 + (b) * 2 + (h)) * HTB)
#define PG8_STAGE(bufoff, gbase, voff) do { _Pragma("unroll") for (int _i = 0; _i < 2; ++_i) \
        __builtin_amdgcn_global_load_lds((const unsigned*)((const char*)(gbase) + (voff)[_i]), (LAS unsigned*)(lds + (bufoff) + ldsw + _i * 8192), 16, 0, 0); } while (0)
#define PG8_STAGE_A(bufoff, gbase) do { __builtin_amdgcn_global_load_lds((const unsigned*)((const char*)(gbase) + voffA[0]), (LAS unsigned*)(lds + (bufoff) + ldsw), 16, 0, 0); \
        if (!(MT == 3 && wr == 1)) __builtin_amdgcn_global_load_lds((const unsigned*)((const char*)(gbase) + voffA[1]), (LAS unsigned*)(lds + (bufoff) + ldsw + 8192), 16, 0, 0); } while (0)
#define PG8_WAIT_VX(full, half) do { if (MT == 3 && wr == 1) asm volatile("s_waitcnt vmcnt(" #half ")" ::: "memory"); else asm volatile("s_waitcnt vmcnt(" #full ")" ::: "memory"); } while (0)
#define PG8_LDA(dst, b, h) do { _Pragma("unroll") for (int m = 0; m < MT; ++m) _Pragma("unroll") for (int k = 0; k < 2; ++k) dst[m][k] = *(const LAS bf16x8*)(lds + PG8_SA(b, h) + aoff + m * 2048 + k * 1024); } while (0)
#define PG8_LDB(dst, b, h) do { _Pragma("unroll") for (int n = 0; n < 2; ++n) _Pragma("unroll") for (int k = 0; k < 2; ++k) dst[n][k] = *(const LAS bf16x8*)(lds + PG8_SB(b, h) + boff + n * 2048 + k * 1024); } while (0)
#define PG8_MMA(ai, bj, At, Bt) do { __builtin_amdgcn_s_setprio(1); _Pragma("unroll") for (int m = 0; m < MT; ++m) _Pragma("unroll") for (int n = 0; n < 2; ++n) _Pragma("unroll") for (int k = 0; k < 2; ++k) \
        acc[ai][bj][m][n] = __builtin_amdgcn_mfma_f32_16x16x32_bf16(Bt[n][k], At[m][k], acc[ai][bj][m][n], 0, 0, 0); __builtin_amdgcn_s_setprio(0); } while (0)
#define PG8_WAIT_V(n) asm volatile("s_waitcnt vmcnt(" #n ")" ::: "memory")
#define PG8_WAIT_L(n) asm volatile("s_waitcnt lgkmcnt(" #n ")" ::: "memory")
#define PG8_BAR __builtin_amdgcn_s_barrier()
#define PG8_SCHED __builtin_amdgcn_sched_barrier(0)
    Unit cur, nxt; int ui = 0;
    if (!S.next(0, cur)) return;
    f32x4 acc[2][2][MT][2];
#pragma unroll
    for (int a = 0; a < 2; ++a)
#pragma unroll
        for (int b = 0; b < 2; ++b)
#pragma unroll
            for (int m = 0; m < MT; ++m)
#pragma unroll
                for (int n = 0; n < 2; ++n) acc[a][b][m][n] = (f32x4){0.f, 0.f, 0.f, 0.f};
    bf16x8 At[MT][2], B0[2][2], B1[2][2];
    const char* cA = cur.a; const char* cB = cur.b;
    PG8_STAGE(PG8_SB(0, 0), cB, voffB); PG8_STAGE(PG8_SB(0, 1), cB + hstepB, voffB); PG8_STAGE_A(PG8_SA(0, 0), cA); PG8_STAGE_A(PG8_SA(0, 1), cA + hstepA);
    if (wr == 1) PG8_BAR;
    PG8_WAIT_VX(2, 1); PG8_BAR;
    PG8_STAGE(PG8_SB(1, 0), cB + kstep, voffB); PG8_STAGE_A(PG8_SA(1, 0), cA + kstep); PG8_STAGE(PG8_SB(1, 1), cB + hstepB + kstep, voffB);
    PG8_WAIT_VX(6, 5); PG8_BAR;
    for (;;) {
        const bool has_next = S.next(ui + 1, nxt);
        const char* nA = has_next ? nxt.a : cA; const char* nB = has_next ? nxt.b : cB;
#pragma unroll 1
        for (int t = 0; t < nt; t += 2) {
            const bool last = (t == nt - 2);
            if constexpr (has_rescale<Epi>::value) { if (t == 16 || t == 32) E.rescale(acc, cur, wr, wc, fr, fq, (t >> 4) - 1); }
            const char* a1 = cA + (size_t)(t + 1) * kstep;
            const char* a2 = last ? nA : cA + (size_t)(t + 2) * kstep; const char* b2 = last ? nB : cB + (size_t)(t + 2) * kstep;
            const char* a3 = a2 + kstep; const char* b3 = b2 + kstep;
            PG8_LDB(B0, 0, 0); PG8_LDB(B1, 0, 1); PG8_SCHED; PG8_LDA(At, 0, 0); PG8_STAGE_A(PG8_SA(1, 1), a1 + hstepA);
            PG8_WAIT_VX(8, 6); PG8_WAIT_L(0); PG8_BAR; PG8_MMA(0, 0, At, B0); PG8_MMA(0, 1, At, B1); PG8_BAR; PG8_SCHED;
            PG8_LDA(At, 0, 1); PG8_STAGE(PG8_SB(0, 0), b2, voffB); PG8_STAGE(PG8_SB(0, 1), b2 + hstepB, voffB); PG8_STAGE_A(PG8_SA(0, 0), a2);
            PG8_WAIT_VX(8, 6); PG8_WAIT_L(0); PG8_BAR; PG8_MMA(1, 0, At, B0); PG8_MMA(1, 1, At, B1); PG8_BAR; PG8_SCHED;
            PG8_LDB(B0, 1, 0); PG8_LDB(B1, 1, 1); PG8_SCHED; PG8_LDA(At, 1, 0); PG8_STAGE_A(PG8_SA(0, 1), a2 + hstepA);
            PG8_WAIT_VX(8, 6); PG8_WAIT_L(0); PG8_BAR; PG8_MMA(0, 0, At, B0); PG8_MMA(0, 1, At, B1); PG8_BAR; PG8_SCHED;
            PG8_LDA(At, 1, 1); PG8_STAGE(PG8_SB(1, 0), b3, voffB); PG8_STAGE(PG8_SB(1, 1), b3 + hstepB, voffB); PG8_STAGE_A(PG8_SA(1, 0), a3);
            PG8_WAIT_VX(8, 6); PG8_WAIT_L(0); PG8_BAR; PG8_MMA(1, 0, At, B0); PG8_MMA(1, 1, At, B1); PG8_BAR; PG8_SCHED;
        }
        if (wr == 0) PG8_BAR;
        E(acc, cur, wr, wc, fr, fq);
        if (!has_next) break;
        { float zz = 0.f; asm volatile("" : "+v"(zz));
#pragma unroll
        for (int a = 0; a < 2; ++a)
#pragma unroll
            for (int b = 0; b < 2; ++b)
#pragma unroll
                for (int m = 0; m < MT; ++m)
#pragma unroll
                    for (int n = 0; n < 2; ++n) acc[a][b][m][n] = (f32x4){zz, zz, zz, zz}; }
        cur = nxt; cA = nA; cB = nB; ++ui;
        if (wr == 1) PG8_BAR;
    }
    PG8_WAIT_V(0);
    PG8_BAR;
#undef PG8_SA
#undef PG8_SB
#undef PG8_STAGE
#undef PG8_STAGE_A
#undef PG8_WAIT_VX
#undef PG8_LDA
#undef PG8_LDB
#undef PG8_MMA
#undef PG8_WAIT_V
#undef PG8_WAIT_L
#undef PG8_BAR
#undef PG8_SCHED
}

struct EpiInProj {
    bf16_t* P; float* small;
    __device__ __forceinline__ void operator()(const f32x4 (&acc)[2][2][4][2], const Unit& u, int wr, int wc, int fr, int fq) const {
        const int row0 = u.pm * BM + wr * 64 + fr;
        if (u.pn < 56) {
            const int col0 = u.pn * BM + wc * 32 + 8 * fq;
#pragma unroll
            for (int ai = 0; ai < 2; ++ai)
#pragma unroll
                for (int m = 0; m < 4; ++m) { bf16_t* rowp = P + (size_t)(row0 + ai * HALF + m * 16) * NP + col0;
#pragma unroll
                    for (int bj = 0; bj < 2; ++bj) *(u32x4*)(rowp + bj * HALF) = pack_acc(acc[ai][bj][m][0], acc[ai][bj][m][1]); }
        } else if (wc < 2) {
            const int col0 = wc * 32 + 8 * fq;
#pragma unroll
            for (int ai = 0; ai < 2; ++ai)
#pragma unroll
                for (int m = 0; m < 4; ++m) { float* rowp = small + (size_t)(row0 + ai * HALF + m * 16) * 64 + col0;
                    *(f32x4*)rowp = acc[ai][0][m][0]; *(f32x4*)(rowp + 4) = acc[ai][0][m][1]; }
        }
    }
};
struct EpiBf16 {
    bf16_t* O; int ldc;
    __device__ __forceinline__ void operator()(const f32x4 (&acc)[2][2][4][2], const Unit& u, int wr, int wc, int fr, int fq) const {
        const int row0 = u.pm * BM + wr * 64 + fr, col0 = u.pn * BM + wc * 32 + 8 * fq;
#pragma unroll
        for (int ai = 0; ai < 2; ++ai)
#pragma unroll
            for (int m = 0; m < 4; ++m) { bf16_t* rowp = O + (size_t)(row0 + ai * HALF + m * 16) * ldc + col0;
#pragma unroll
                for (int bj = 0; bj < 2; ++bj) *(u32x4*)(rowp + bj * HALF) = pack_acc(acc[ai][bj][m][0], acc[ai][bj][m][1]); }
    }
};
struct EpiPool {
    bf16_t* O; const float* scale;
    __device__ __forceinline__ void operator()(const f32x4 (&acc)[2][2][4][2], const Unit& u, int wr, int wc, int fr, int fq) const {
        const int row0 = u.pm * BM + wr * 64 + fr, col0 = u.z * 256 + wc * 32 + 8 * fq;
        f32x4 sv[2][2];
#pragma unroll
        for (int bj = 0; bj < 2; ++bj) { sv[bj][0] = *(const f32x4*)(scale + col0 + bj * HALF); sv[bj][1] = *(const f32x4*)(scale + col0 + bj * HALF + 4); }
#pragma unroll
        for (int ai = 0; ai < 2; ++ai)
#pragma unroll
            for (int m = 0; m < 4; ++m) { bf16_t* rowp = O + (size_t)(row0 + ai * HALF + m * 16) * 3072 + col0;
#pragma unroll
                for (int bj = 0; bj < 2; ++bj) *(u32x4*)(rowp + bj * HALF) = pack_acc(acc[ai][bj][m][0] * sv[bj][0], acc[ai][bj][m][1] * sv[bj][1]); }
    }
};
template <int MT> struct EpiBranch {
    static constexpr bool HAS_RESCALE = true;
    const bf16_t* P; bf16_t* mbf;
    __device__ __forceinline__ void rescale(f32x4 (&acc)[2][2][MT][2], const Unit& u, int wr, int wc, int fr, int fq, int seg) const {
        int row0 = u.pm * (MT * 64) + wr * (MT * 16) + fr, col0 = u.pn * BM + wc * 32 + 8 * fq;
        asm volatile("" : "+v"(row0), "+v"(col0));
#pragma unroll
        for (int ai = 0; ai < 2; ++ai) {
            u32x4 ra[MT][2], rb[MT][2];
#pragma unroll
            for (int m = 0; m < MT; ++m)
#pragma unroll
                for (int bj = 0; bj < 2; ++bj) { const bf16_t* gp = P + (size_t)(row0 + ai * (MT * 32) + m * 16) * NP + PC_GATE + seg * 2048 + col0 + bj * HALF;
                    ra[m][bj] = *(const u32x4*)gp; rb[m][bj] = *(const u32x4*)(gp + 2048); }
            __builtin_amdgcn_sched_barrier(0);
#pragma unroll
            for (int m = 0; m < MT; ++m)
#pragma unroll
                for (int bj = 0; bj < 2; ++bj) { float ga[8], gb[8]; unpack8(ra[m][bj], ga); unpack8(rb[m][bj], gb);
#pragma unroll
                    for (int j = 0; j < 4; ++j) { acc[ai][bj][m][0][j] *= (1.0f + __expf(-gb[j])) * __builtin_amdgcn_rcpf(1.0f + __expf(-ga[j]));
                        acc[ai][bj][m][1][j] *= (1.0f + __expf(-gb[4 + j])) * __builtin_amdgcn_rcpf(1.0f + __expf(-ga[4 + j])); } }
            __builtin_amdgcn_sched_barrier(0); }
    }
    __device__ __forceinline__ void operator()(const f32x4 (&acc)[2][2][MT][2], const Unit& u, int wr, int wc, int fr, int fq) const {
        const int row0 = u.pm * (MT * 64) + wr * (MT * 16) + fr, col0 = u.pn * BM + wc * 32 + 8 * fq;
#pragma unroll
        for (int ai = 0; ai < 2; ++ai) {
            u32x4 gr[MT][2];
#pragma unroll
            for (int m = 0; m < MT; ++m)
#pragma unroll
                for (int bj = 0; bj < 2; ++bj) gr[m][bj] = *(const u32x4*)(P + (size_t)(row0 + ai * (MT * 32) + m * 16) * NP + PC_GATE + 2 * 2048 + col0 + bj * HALF);
            __builtin_amdgcn_sched_barrier(0);
#pragma unroll
            for (int m = 0; m < MT; ++m) { const size_t row = (size_t)(row0 + ai * (MT * 32) + m * 16);
#pragma unroll
                for (int bj = 0; bj < 2; ++bj) { const int col = col0 + bj * HALF;
                    float g[8]; unpack8(gr[m][bj], g);
                    f32x4 v0 = acc[ai][bj][m][0], v1 = acc[ai][bj][m][1];
#pragma unroll
                    for (int j = 0; j < 4; ++j) { v0[j] *= sigmoidf_(g[j]); v1[j] *= sigmoidf_(g[4 + j]); }
                    *(u32x4*)(mbf + row * D + col) = pack_acc(v0, v1); } }
            __builtin_amdgcn_sched_barrier(0); }
    }
};
template <int MT> struct EpiResid {
    bf16_t* X; const float* gates;
    __device__ __forceinline__ void operator()(const f32x4 (&acc)[2][2][MT][2], const Unit& u, int wr, int wc, int fr, int fq) const {
        const int row0 = u.pm * (MT * 64) + wr * (MT * 16) + fr, col0 = u.pn * BM + wc * 32 + 8 * fq;
#pragma unroll
        for (int ai = 0; ai < 2; ++ai)
#pragma unroll
            for (int mp = 0; mp < MT; mp += 2) {
                u32x4 xv[2][2]; f32x4 gv[2][2][2];
#pragma unroll
                for (int q = 0; q < 2; ++q) if (mp + q < MT) { const int row = row0 + ai * (MT * 32) + (mp + q) * 16; const int j = row < RL ? (row >> 11) : 8;
                    const float* gp = gates + (size_t)j * 12288 + col0; const bf16_t* rowp = X + (size_t)row * D + col0;
#pragma unroll
                    for (int bj = 0; bj < 2; ++bj) { xv[q][bj] = *(const u32x4*)(rowp + bj * HALF);
                        gv[q][bj][0] = *(const f32x4*)(gp + bj * HALF); gv[q][bj][1] = *(const f32x4*)(gp + bj * HALF + 4); } }
                __builtin_amdgcn_sched_barrier(0);
#pragma unroll
                for (int q = 0; q < 2; ++q) if (mp + q < MT) { const int row = row0 + ai * (MT * 32) + (mp + q) * 16; bf16_t* rowp = X + (size_t)row * D + col0;
#pragma unroll
                    for (int bj = 0; bj < 2; ++bj) { float xf[8]; unpack8h(xv[q][bj], xf);
#pragma unroll
                        for (int e = 0; e < 4; ++e) { xf[e] += gv[q][bj][0][e] * acc[ai][bj][mp + q][0][e]; xf[4 + e] += gv[q][bj][1][e] * acc[ai][bj][mp + q][1][e]; }
                        *(u32x4*)(rowp + bj * HALF) = pack8h(xf); } }
                __builtin_amdgcn_sched_barrier(0); }
    }
};
}

struct Args { const float* in[26]; float* out; unsigned char* ws; };
struct Frame {
    LAS unsigned char* lds; unsigned char* ws; const float* const* in; float* out;
    int tid, lane, wave, G, bx;
};
enum { I_X = 0, I_C, I_CTX, I_CCTX, I_ADAW, I_ADAB, I_N1W, I_N2W, I_WIN, I_LRW2, I_LRB, I_GLANW, I_CONVW, I_ALOG, I_DTB, I_GDNNW, I_POOLW, I_POOLS, I_WBRGLA, I_WBRGDN, I_WBRPOOL, I_WOUT, I_FFNUP, I_FFNCONV, I_FFNDOWN, I_FINALW };

__device__ __forceinline__ void phase_mods(const Frame& F) {
    int tid = F.tid; asm volatile("" : "+v"(tid));
    size_t wz_ = 0; asm volatile("" : "+s"(wz_)); unsigned char* wsl = F.ws + wz_;
    int bxl = F.bx; asm volatile("" : "+s"(bxl)); (void)bxl;
    const int lane = tid & 63, wave = __builtin_amdgcn_readfirstlane(tid >> 6); (void)lane; (void)wave;
    LAS float* sc = (LAS float*)F.lds;
    const float* c = F.in[I_C]; const float* cc = F.in[I_CCTX]; const float* aw = F.in[I_ADAW];
    float* part = (float*)(wsl + WS_MODP);
    for (int u = bxl; u < DEPTH * 24 * 8; u += F.G) {
        const int ks = u % 8, cb = (u / 8) % 24, l = u / 192;
        __syncthreads();
        for (int i = tid; i < 9 * 256; i += NTHR) { const int j = i / 256, k = i % 256; const float cv = (j < 8) ? c[j * D + ks * 256 + k] : cc[ks * 256 + k]; sc[i] = siluf_(cv); }
        __syncthreads();
        const int c4 = (tid & 127) * 4, kq = tid >> 7;
        const float* w = aw + ((size_t)l * D + ks * 256 + kq * 64) * 12288 + cb * 512 + c4;
        f32x4 acc[9];
#pragma unroll
        for (int j = 0; j < 9; ++j) acc[j] = (f32x4){0.f, 0.f, 0.f, 0.f};
#pragma unroll 1
        for (int k0 = 0; k0 < 64; k0 += 8) { f32x4 wv[8];
#pragma unroll
            for (int q = 0; q < 8; ++q) wv[q] = *(const f32x4*)(w + (size_t)(k0 + q) * 12288);
#pragma unroll
            for (int j = 0; j < 9; ++j) { const f32x4 s0 = *(const LAS f32x4*)(sc + j * 256 + kq * 64 + k0), s1 = *(const LAS f32x4*)(sc + j * 256 + kq * 64 + k0 + 4);
#pragma unroll
                for (int q = 0; q < 4; ++q) { acc[j] += wv[q] * s0[q]; acc[j] += wv[4 + q] * s1[q]; } } }
        LAS float* red = (LAS float*)(F.lds + 16384);
#pragma unroll
        for (int j = 0; j < 9; ++j) *(LAS f32x4*)(red + (kq * 9 + j) * 512 + c4) = acc[j];
        __syncthreads();
#pragma unroll
        for (int j = 0; j < 9; ++j) { const float v = (red[(0 * 9 + j) * 512 + tid] + red[(1 * 9 + j) * 512 + tid]) + (red[(2 * 9 + j) * 512 + tid] + red[(3 * 9 + j) * 512 + tid]);
            part[(size_t)ks * (DEPTH * 9 * 12288) + ((size_t)l * 9 + j) * 12288 + cb * 512 + tid] = v; }
    }
    __syncthreads();
}
__device__ __forceinline__ void phase_mods_reduce(const Frame& F) {
    int tid = F.tid; asm volatile("" : "+v"(tid));
    size_t wz_ = 0; asm volatile("" : "+s"(wz_)); unsigned char* wsl = F.ws + wz_;
    int bxl = F.bx; asm volatile("" : "+s"(bxl));
    const float* part = (const float*)(wsl + WS_MODP); float* mods = (float*)(wsl + WS_MODS); const float* ab = F.in[I_ADAB];
    for (int i = bxl * NTHR + tid; i < DEPTH * 9 * 12288; i += F.G * NTHR) {
        const int l = i / (9 * 12288), col = i % 12288;
        float pv[8];
#pragma unroll
        for (int ks = 0; ks < 8; ++ks) pv[ks] = part[(size_t)ks * (DEPTH * 9 * 12288) + i];
        float s = ab[l * 12288 + col];
        __builtin_amdgcn_sched_barrier(0);
#pragma unroll
        for (int ks = 0; ks < 8; ++ks) s += pv[ks];
        mods[i] = s; }
}

__device__ __forceinline__ int map_in_col(int n) {
    if (n < 3072) return n;
    if (n < 3104) return NP + (n - 3072);
    if (n < 6176) return n - 32;
    if (n < 6192) return NP + 32 + (n - 6176);
    if (n < 6208) return NP + 48 + (n - 6192);
    return n - 64;
}
__device__ __forceinline__ void wtile4(const Frame& F, const float* src, int N, bf16_t* dst, int K, int kt, int nt0, int cnt, bool perm_in) {
    int tid = F.tid; asm volatile("" : "+v"(tid));
    LAS float* t = (LAS float*)F.lds;
    const int kk = tid >> 3, seg = (tid & 7) * 8;
    const float* s0 = src + (size_t)(kt * 64 + kk) * N + nt0 * 64 + seg;
    f32x4 v0[4], v1[4];
#pragma unroll
    for (int q = 0; q < 4; ++q) if (q < cnt) { v0[q] = *(const f32x4*)(s0 + q * 64); v1[q] = *(const f32x4*)(s0 + q * 64 + 4); }
    __syncthreads();
#pragma unroll
    for (int q = 0; q < 4; ++q) if (q < cnt) {
#pragma unroll
        for (int i = 0; i < 4; ++i) { t[q * 4160 + kk * 65 + seg + i] = v0[q][i]; t[q * 4160 + kk * 65 + seg + 4 + i] = v1[q][i]; } }
    __syncthreads();
    const int nn = tid >> 3, kseg = (tid & 7) * 8;
#pragma unroll
    for (int q = 0; q < 4; ++q) if (q < cnt) { float f[8];
#pragma unroll
        for (int i = 0; i < 8; ++i) f[i] = t[q * 4160 + (kseg + i) * 65 + nn];
        const int n = (nt0 + q) * 64 + nn, np = perm_in ? map_in_col(n) : n;
        *(u32x4*)(dst + (size_t)np * K + kt * 64 + kseg) = pack8(f); }
}
__device__ __forceinline__ void wfold_pool(const Frame& F, int l, int g, int nt, bf16_t* Wbr) {
    int tid = F.tid; asm volatile("" : "+v"(tid));
    const int lane = tid & 63, w = __builtin_amdgcn_readfirstlane(tid >> 6), fr = lane & 15, fq = lane >> 4;
    LAS bf16_t* Bt = (LAS bf16_t*)F.lds;
    const float* wp = F.in[I_WBRPOOL] + (size_t)l * 1024 * D + (size_t)(g * 256) * D + nt * 64;
    const float* pw = F.in[I_POOLW] + ((size_t)l * 4 + g) * 65536;
    const int d = tid >> 1, hf = (tid & 1) * 32;
    f32x4 v[8];
#pragma unroll
    for (int q = 0; q < 8; ++q) v[q] = *(const f32x4*)(wp + (size_t)d * D + hf + q * 4);
    const float sc = F.in[I_POOLS][l * 1024 + g * 256 + d];
    __syncthreads();
#pragma unroll
    for (int q = 0; q < 8; ++q)
#pragma unroll
        for (int i = 0; i < 4; ++i) Bt[(hf + q * 4 + i) * 264 + d] = f2bf(v[q][i] * sc);
    __syncthreads();
#pragma unroll 1
    for (int cbi = 0; cbi < 2; ++cbi) { const int cb = w * 2 + cbi;
        f32x4 a0[8], a1[8];
#pragma unroll
        for (int ks = 0; ks < 8; ++ks) { const float* ap = pw + (size_t)(cb * 16 + fr) * 256 + ks * 32 + fq * 8; a0[ks] = *(const f32x4*)ap; a1[ks] = *(const f32x4*)(ap + 4); }
        bf16x8 af[8];
#pragma unroll
        for (int ks = 0; ks < 8; ++ks) { u32x4 pk; pk.x = pk2(a0[ks][0], a0[ks][1]); pk.y = pk2(a0[ks][2], a0[ks][3]); pk.z = pk2(a1[ks][0], a1[ks][1]); pk.w = pk2(a1[ks][2], a1[ks][3]); af[ks] = __builtin_bit_cast(bf16x8, pk); }
#pragma unroll
        for (int nb = 0; nb < 4; ++nb) { f32x4 acc = (f32x4){0.f, 0.f, 0.f, 0.f};
#pragma unroll
            for (int ks = 0; ks < 8; ++ks) { const bf16x8 bfr = *(const LAS bf16x8*)(Bt + (nb * 16 + fr) * 264 + ks * 32 + fq * 8); acc = MFMA16(af[ks], bfr, acc); }
            u32x2 ov; ov.x = pk2(acc[0], acc[1]); ov.y = pk2(acc[2], acc[3]);
            *(u32x2*)(Wbr + (size_t)(nt * 64 + nb * 16 + fr) * 3072 + 2048 + g * 256 + cb * 16 + 4 * fq) = ov; } }
}
__device__ __forceinline__ void phase_weights(const Frame& F, int l, int set, int r, int n) {
    int tid = F.tid; asm volatile("" : "+v"(tid));
    size_t wz_ = 0; asm volatile("" : "+s"(wz_)); unsigned char* wsl = F.ws + wz_;
    asm volatile("" : "+s"(r));
    bf16_t* Win = (bf16_t*)(wsl + WS_WIN); bf16_t* Wbr = (bf16_t*)(wsl + WS_WBR); bf16_t* Wout = (bf16_t*)(wsl + WS_WOUT);
    bf16_t* Wup = (bf16_t*)(wsl + WS_WUP); bf16_t* Wdn = (bf16_t*)(wsl + WS_WDN);
    constexpr int G_IN = 32 * 57, G_BR = 16 * 8, G_OUT = 32 * 8, G_UP = 32 * 44, G_DN = 88 * 8;
    constexpr int O_BR = G_IN, O_OUT = O_BR + 3 * G_BR, O_UP = O_OUT + G_OUT, O_DN = O_UP + G_UP, G_ALL = O_DN + G_DN;
    const int lo = set ? O_UP : 0, hi = set ? G_ALL : O_UP;
    for (int u = lo + r; u < hi; u += n) {
        if (u < O_BR) { const int kt = u / 57, g4 = u % 57; wtile4(F, F.in[I_WIN] + (size_t)l * D * NIN_ORIG, NIN_ORIG, Win, D, kt, g4 * 4, g4 < 56 ? 4 : 1, true); }
        else if (u < O_BR + 2 * G_BR) { const int v = u - O_BR, br = v / G_BR, w = v % G_BR; wtile4(F, F.in[I_WBRGLA + br] + (size_t)l * 1024 * D, D, Wbr + br * 1024, 3072, w / 8, (w % 8) * 4, 4, false); }
        else if (u < O_OUT) { const int v = u - O_BR - 2 * G_BR; wfold_pool(F, l, v >> 5, v & 31, Wbr); }
        else if (u < O_UP) { const int v = u - O_OUT; wtile4(F, F.in[I_WOUT] + (size_t)l * D * D, D, Wout, D, v / 8, (v % 8) * 4, 4, false); }
        else if (u < O_DN) { const int v = u - O_UP; wtile4(F, F.in[I_FFNUP] + (size_t)l * D * NAV, NAV, Wup, D, v / 44, (v % 44) * 4, 4, false); }
        else { const int v = u - O_DN; wtile4(F, F.in[I_FFNDOWN] + (size_t)l * DFF * D, D, Wdn, DFF, v / 8, (v % 8) * 4, 4, false); }
    }
    if (set == 0) {
      u32x4* z = (u32x4*)(Win + (size_t)NIN_ORIG * D); const int n16 = (NIN - NIN_ORIG) * D * 2 / 16;
      unsigned zz = 0u; asm volatile("" : "+v"(zz));
      for (int i = r * NTHR + tid; i < n16; i += n * NTHR) z[i] = (u32x4){zz, zz, zz, zz}; }
    __syncthreads();
}

template <bool IN32> __device__ __forceinline__ void phase_norm(const Frame& F, const void* xl_, const void* xc_, bf16_t* xcopy, const float* nw, const float* mods_l, int sh, bf16_t* out, int nrows) {
    int tid = F.tid; asm volatile("" : "+v"(tid));
    size_t wz_ = 0; asm volatile("" : "+s"(wz_)); unsigned char* wsl = F.ws + wz_;
    int bxl = F.bx; asm volatile("" : "+s"(bxl)); (void)bxl; (void)wsl;
    const int lane = tid & 63, wave = __builtin_amdgcn_readfirstlane(tid >> 6);
    f32x4 wv[8];
#pragma unroll
    for (int i = 0; i < 8; ++i) wv[i] = *(const f32x4*)(nw + (i >> 1) * 512 + lane * 8 + (i & 1) * 4);
    for (int r = bxl * 8 + wave; r < nrows; r += F.G * 8) {
        const int j = (r < RL) ? (r >> 11) : 8;
        const float* shp = mods_l + (size_t)j * 12288 + sh * D; const float* scp = shp + D;
        f32x4 v[8], s1v[8], s0v[8]; float ss = 0.f;
        if constexpr (IN32) { const float* xr = (r < RL) ? (const float*)xl_ + (size_t)r * D : (const float*)xc_ + (size_t)(r - RL) * D;
#pragma unroll
            for (int i = 0; i < 8; ++i) v[i] = *(const f32x4*)(xr + (i >> 1) * 512 + lane * 8 + (i & 1) * 4);
        } else { const bf16_t* xr = (r < RL) ? (const bf16_t*)xl_ + (size_t)r * D : (const bf16_t*)xc_ + (size_t)(r - RL) * D;
            u32x4 rw[4];
#pragma unroll
            for (int k = 0; k < 4; ++k) rw[k] = *(const u32x4*)(xr + k * 512 + lane * 8);
#pragma unroll
            for (int k = 0; k < 4; ++k) { float f8[8]; unpack8h(rw[k], f8); v[2 * k] = (f32x4){f8[0], f8[1], f8[2], f8[3]}; v[2 * k + 1] = (f32x4){f8[4], f8[5], f8[6], f8[7]}; } }
#pragma unroll
        for (int i = 0; i < 8; ++i) { const int c = (i >> 1) * 512 + lane * 8 + (i & 1) * 4; s1v[i] = *(const f32x4*)(scp + c); s0v[i] = *(const f32x4*)(shp + c); }
        __builtin_amdgcn_sched_barrier(0);
#pragma unroll
        for (int i = 0; i < 8; ++i) ss += v[i][0] * v[i][0] + v[i][1] * v[i][1] + v[i][2] * v[i][2] + v[i][3] * v[i][3];
#pragma unroll
        for (int o = 32; o >= 1; o >>= 1) ss += shx(ss, o, lane);
        const float rs = rsqrtf(ss * (1.0f / D) + EPS);
#pragma unroll
        for (int k = 0; k < 4; ++k) { const int c = k * 512 + lane * 8;
            if constexpr (IN32) { float f8[8];
#pragma unroll
                for (int q = 0; q < 4; ++q) { f8[q] = v[2 * k][q]; f8[4 + q] = v[2 * k + 1][q]; }
                *(u32x4*)(xcopy + (size_t)r * D + c) = pack8h(f8); }
            float y[8];
#pragma unroll
            for (int q = 0; q < 4; ++q) { y[q] = v[2 * k][q] * rs * wv[2 * k][q] * (1.0f + s1v[2 * k][q]) + s0v[2 * k][q]; y[4 + q] = v[2 * k + 1][q] * rs * wv[2 * k + 1][q] * (1.0f + s1v[2 * k + 1][q]) + s0v[2 * k + 1][q]; }
            *(u32x4*)(out + (size_t)r * D + c) = pack8(y); }
    }
}
__device__ __forceinline__ void phase_final_norm(const Frame& F, const bf16_t* x, const float* nw, float* out) {
    int tid = F.tid; asm volatile("" : "+v"(tid));
    size_t wz_ = 0; asm volatile("" : "+s"(wz_)); unsigned char* wsl = F.ws + wz_;
    int bxl = F.bx; asm volatile("" : "+s"(bxl)); (void)bxl; (void)wsl;
    const int lane = tid & 63, wave = __builtin_amdgcn_readfirstlane(tid >> 6);
    f32x4 wv[8];
#pragma unroll
    for (int i = 0; i < 8; ++i) wv[i] = *(const f32x4*)(nw + (i >> 1) * 512 + lane * 8 + (i & 1) * 4);
    for (int r = bxl * 8 + wave; r < RL; r += F.G * 8) {
        const bf16_t* xr = x + (size_t)r * D;
        f32x4 v[8]; float ss = 0.f; u32x4 rw[4];
#pragma unroll
        for (int k = 0; k < 4; ++k) rw[k] = *(const u32x4*)(xr + k * 512 + lane * 8);
#pragma unroll
        for (int k = 0; k < 4; ++k) { float f8[8]; unpack8h(rw[k], f8); v[2 * k] = (f32x4){f8[0], f8[1], f8[2], f8[3]}; v[2 * k + 1] = (f32x4){f8[4], f8[5], f8[6], f8[7]}; }
#pragma unroll
        for (int i = 0; i < 8; ++i) ss += v[i][0] * v[i][0] + v[i][1] * v[i][1] + v[i][2] * v[i][2] + v[i][3] * v[i][3];
#pragma unroll
        for (int o = 32; o >= 1; o >>= 1) ss += shx(ss, o, lane);
        const float rs = rsqrtf(ss * (1.0f / D) + EPS);
#pragma unroll
        for (int i = 0; i < 8; ++i) { const int c = (i >> 1) * 512 + lane * 8 + (i & 1) * 4;
            *(f32x4*)(out + (size_t)r * D + c) = v[i] * rs * wv[i]; }
    }
}

__device__ __forceinline__ int chunk_rowbase(int b, int ch) { return ch < 4 ? RL + b * CTXL + ch * 64 : b * SEQ + (ch - 4) * 64; }
__device__ __forceinline__ int step_chunk(int d, int i) { return d == 0 ? i : (i < 4 ? 3 - i : 39 - i); }

__device__ __forceinline__ void gla_prep_unit(const Frame& F, int l, int b, int ch, int h, int d) {
    int tid = F.tid; asm volatile("" : "+v"(tid));
    size_t wz_ = 0; asm volatile("" : "+s"(wz_)); unsigned char* wsl = F.ws + wz_;
    int bxl = F.bx; asm volatile("" : "+s"(bxl)); (void)bxl;
    const int lane = tid & 63, w = __builtin_amdgcn_readfirstlane(tid >> 6), fr = lane & 15, fq = lane >> 4;
    LAS bf16_t* qd = (LAS bf16_t*)(F.lds + 0);
    LAS bf16_t* kn = (LAS bf16_t*)(F.lds + 17408);
    LAS bf16_t* vT = (LAS bf16_t*)(F.lds + 34816);
    LAS bf16_t* sc = (LAS bf16_t*)(F.lds + 71680);
    LAS float* bc = (LAS float*)(F.lds + 80896);
    LAS float* lr = (LAS float*)(F.lds + 113920);
    LAS float* w2 = (LAS float*)(F.lds + 118016);
    LAS float* bs = (LAS float*)(F.lds + 126208);
    const bf16_t* P = (const bf16_t*)(wsl + WS_P); const float* small = (const float*)(wsl + WS_SMALL);
    const int rowbase = chunk_rowbase(b, ch);
    unsigned char* ub = wsl + WS_GLAPREP + (size_t)(((b * NCH + ch) * 4 + h) * 2 + d) * GLA_UNIT;
    bf16_t* g_qd = (bf16_t*)ub; bf16_t* g_keT = (bf16_t*)(ub + 16384); bf16_t* g_vT = (bf16_t*)(ub + 32768); float* g_dec = (float*)(ub + 65536);
    bf16_t* og = (bf16_t*)(wsl + WS_OGLA) + (size_t)d * R * 1024;
    const int p = tid >> 3, k0 = (tid & 7) * 16, tok = d ? 63 - p : p;
    f32x4 lrv = (f32x4){0.f, 0.f, 0.f, 0.f}, w2v; float bsv = 0.f; u32x4 qraw[2], kraw[2], vraw[4];
    if (tid < 256) { const int p1 = tid >> 2, r4 = (tid & 3) * 4, tok1 = d ? 63 - p1 : p1; lrv = *(const f32x4*)(small + (size_t)(rowbase + tok1) * 64 + d * 16 + r4); }
    { const int idx = tid * 4, r = idx >> 7, k = idx & 127; w2v = *(const f32x4*)(F.in[I_LRW2] + ((size_t)(l * 2 + d) * 16 + r) * 512 + h * 128 + k); }
    if (tid < 128) bsv = F.in[I_LRB][(size_t)(l * 2 + d) * 512 + h * 128 + tid];
    { const bf16_t* qp = P + (size_t)(rowbase + tok) * NP + PC_GLA_Q + h * 128 + k0; const bf16_t* kp = P + (size_t)(rowbase + tok) * NP + PC_GLA_K + h * 128 + k0;
        const bf16_t* vp = P + (size_t)(rowbase + tok) * NP + PC_GLA_V + h * 256 + (tid & 7) * 32;
        qraw[0] = *(const u32x4*)qp; qraw[1] = *(const u32x4*)(qp + 8); kraw[0] = *(const u32x4*)kp; kraw[1] = *(const u32x4*)(kp + 8);
#pragma unroll
        for (int j = 0; j < 4; ++j) vraw[j] = *(const u32x4*)(vp + j * 8); }
    __builtin_amdgcn_sched_barrier(0);
    if (tid < 256) { const int p1 = tid >> 2, r4 = (tid & 3) * 4; *(LAS f32x4*)(lr + p1 * 16 + r4) = lrv; }
    *(LAS f32x4*)(w2 + tid * 4) = w2v;
    if (tid < 128) bs[tid] = bsv;
    __syncthreads();
    { float z[16];
#pragma unroll
        for (int i = 0; i < 16; ++i) z[i] = bs[k0 + i];
#pragma unroll
        for (int r = 0; r < 16; ++r) { const float lv = lr[p * 16 + r];
#pragma unroll
            for (int i = 0; i < 16; ++i) z[i] += lv * w2[r * 128 + k0 + i]; }
#pragma unroll
        for (int i = 0; i < 16; ++i) bc[p * 129 + k0 + i] = logsigf_(z[i]) * (1.0f / 16.0f); }
    __syncthreads();
    { float cv[16]; const int kk = tid >> 2, sg = tid & 3;
#pragma unroll
        for (int q = 0; q < 16; ++q) cv[q] = bc[(sg * 16 + q) * 129 + kk];
#pragma unroll
        for (int q = 1; q < 16; ++q) cv[q] += cv[q - 1];
        const float t1 = shup(cv[15], 1, lane), t2 = shup(cv[15], 2, lane), t3 = shup(cv[15], 3, lane);
        const float off = (sg >= 1 ? t1 : 0.f) + (sg >= 2 ? t2 : 0.f) + (sg >= 3 ? t3 : 0.f);
#pragma unroll
        for (int q = 0; q < 16; ++q) bc[(sg * 16 + q) * 129 + kk] = cv[q] + off; }
    __syncthreads();
    {
        float qf[16], kf[16];
        { float t8[8]; unpack8(qraw[0], t8);
#pragma unroll
            for (int i = 0; i < 8; ++i) qf[i] = t8[i];
            unpack8(qraw[1], t8);
#pragma unroll
            for (int i = 0; i < 8; ++i) qf[8 + i] = t8[i];
            unpack8(kraw[0], t8);
#pragma unroll
            for (int i = 0; i < 8; ++i) kf[i] = t8[i];
            unpack8(kraw[1], t8);
#pragma unroll
            for (int i = 0; i < 8; ++i) kf[8 + i] = t8[i]; }
        float qo[16], ko[16];
#pragma unroll
        for (int i = 0; i < 16; ++i) { const float bb = bc[p * 129 + k0 + i], bl = bc[63 * 129 + k0 + i];
            qo[i] = qf[i] * 0.08838834764831845f * __expf(bb); ko[i] = kf[i] * __expf(-bb);
            g_keT[frag_off(k0 + i, p, 2)] = f2bf(kf[i] * __expf(bl - bb));
            if (p == 63) g_dec[k0 + i] = __expf(bl); }
        u32x4 q0, q1, k0v, k1v;
        { float t8[8];
#pragma unroll
            for (int i = 0; i < 8; ++i) t8[i] = qo[i];
            q0 = pack8(t8);
#pragma unroll
            for (int i = 0; i < 8; ++i) t8[i] = qo[8 + i];
            q1 = pack8(t8);
#pragma unroll
            for (int i = 0; i < 8; ++i) t8[i] = ko[i];
            k0v = pack8(t8);
#pragma unroll
            for (int i = 0; i < 8; ++i) t8[i] = ko[8 + i];
            k1v = pack8(t8); }
        *(LAS u32x4*)(qd + p * 136 + k0) = q0; *(LAS u32x4*)(qd + p * 136 + k0 + 8) = q1;
        *(LAS u32x4*)(kn + p * 136 + k0) = k0v; *(LAS u32x4*)(kn + p * 136 + k0 + 8) = k1v;
        *(u32x4*)(g_qd + frag_off(p, k0, 4)) = q0; *(u32x4*)(g_qd + frag_off(p, k0 + 8, 4)) = q1; }
    { const int v0 = (tid & 7) * 32;
#pragma unroll
        for (int j = 0; j < 4; ++j) { const u32x4 wv = vraw[j];
            const unsigned ws_[4] = {wv.x, wv.y, wv.z, wv.w};
#pragma unroll
            for (int q = 0; q < 4; ++q) { vT[(v0 + j * 8 + 2 * q) * 72 + p] = (bf16_t)(ws_[q] & 0xFFFFu); vT[(v0 + j * 8 + 2 * q + 1) * 72 + p] = (bf16_t)(ws_[q] >> 16); } } }
    __syncthreads();
    { const int row = tid >> 1, half = tid & 1;
#pragma unroll
        for (int j = 0; j < 4; ++j) *(u32x4*)(g_vT + frag_off(row, half * 32 + j * 8, 2)) = *(const LAS u32x4*)(vT + row * 72 + half * 32 + j * 8); }
    { const int rb = w >> 1;
#pragma unroll
        for (int j = 0; j < 2; ++j) { const int cb = (w & 1) * 2 + j; f32x4 acc = (f32x4){0.f, 0.f, 0.f, 0.f};
#pragma unroll
            for (int ks = 0; ks < 4; ++ks) { const bf16x8 a = *(const LAS bf16x8*)(qd + (rb * 16 + fr) * 136 + ks * 32 + fq * 8); const bf16x8 bt = *(const LAS bf16x8*)(kn + (cb * 16 + fr) * 136 + ks * 32 + fq * 8);
                acc = MFMA16(bt, a, acc); }
            const int pr = rb * 16 + fr, s0 = cb * 16 + 4 * fq;
            u32x2 o; o.x = pk2(s0 + 0 <= pr ? acc[0] : 0.f, s0 + 1 <= pr ? acc[1] : 0.f); o.y = pk2(s0 + 2 <= pr ? acc[2] : 0.f, s0 + 3 <= pr ? acc[3] : 0.f);
            *(LAS u32x2*)(sc + pr * 72 + s0) = o; } }
    __syncthreads();
    { bf16x8 af[4][2];
#pragma unroll
        for (int rb = 0; rb < 4; ++rb)
#pragma unroll
            for (int ks = 0; ks < 2; ++ks) af[rb][ks] = *(const LAS bf16x8*)(sc + (rb * 16 + fr) * 72 + ks * 32 + fq * 8);
#pragma unroll
        for (int j = 0; j < 2; ++j) { const int cb = w * 2 + j; bf16x8 bf[2];
#pragma unroll
            for (int ks = 0; ks < 2; ++ks) bf[ks] = *(const LAS bf16x8*)(vT + (cb * 16 + fr) * 72 + ks * 32 + fq * 8);
#pragma unroll
            for (int rb = 0; rb < 4; ++rb) { f32x4 acc = (f32x4){0.f, 0.f, 0.f, 0.f};
#pragma unroll
                for (int ks = 0; ks < 2; ++ks) acc = MFMA16(bf[ks], af[rb][ks], acc);
                const int pr = rb * 16 + fr, tk = d ? 63 - pr : pr;
                u32x2 o; o.x = pk2(acc[0], acc[1]); o.y = pk2(acc[2], acc[3]);
                *(u32x2*)(og + (size_t)(rowbase + tk) * 1024 + h * 256 + cb * 16 + 4 * fq) = o; } } }
    __syncthreads();
}

struct GlaOps { bf16x8 qa[4]; bf16x8 va[2][2]; bf16x8 ke[2][2]; f32x4 dc[2]; };
__device__ __forceinline__ void gla_ops_load(GlaOps& o, unsigned char* wsl, int b, int h, int d, int vs, int step, int fr, int fq, int pb, int vvb0, int vb, int kb0) {
    const int ch = step_chunk(d, step);
    const unsigned char* ub = wsl + WS_GLAPREP + (size_t)(((b * NCH + ch) * 4 + h) * 2 + d) * GLA_UNIT;
    const bf16_t* g_qd = (const bf16_t*)ub; const bf16_t* g_keT = (const bf16_t*)(ub + 16384); const bf16_t* g_vT = (const bf16_t*)(ub + 32768); const float* g_dec = (const float*)(ub + 65536);
#pragma unroll
    for (int ks = 0; ks < 4; ++ks) o.qa[ks] = *(const bf16x8*)(g_qd + frag_tile(pb, ks, 4, fq * 16 + fr));
#pragma unroll
    for (int j = 0; j < 2; ++j) { o.dc[j] = *(const f32x4*)(g_dec + (kb0 + j) * 16 + 4 * fq);
#pragma unroll
        for (int ks = 0; ks < 2; ++ks) { o.va[j][ks] = *(const bf16x8*)(g_vT + frag_tile(vs * 4 + vb + j, ks, 2, fq * 16 + fr)); o.ke[j][ks] = *(const bf16x8*)(g_keT + frag_tile(kb0 + j, ks, 2, fq * 16 + fr)); } }
}
__device__ __forceinline__ void gla_flush(LAS const bf16_t* OTp, unsigned char* wsl, int b, int h, int d, int vs, int step, int tid, const u32x4 oldv) {
    const int ch = step_chunk(d, step), rowbase = chunk_rowbase(b, ch), p = tid >> 3, c8 = (tid & 7) * 8, tk = d ? 63 - p : p;
    bf16_t* op = (bf16_t*)(wsl + WS_OGLA) + (size_t)d * R * 1024 + (size_t)(rowbase + tk) * 1024 + h * 256 + vs * 64 + c8;
    float a[8], o8[8]; unpack8(*(const LAS u32x4*)(OTp + p * 72 + c8), a); unpack8(oldv, o8);
#pragma unroll
    for (int i = 0; i < 8; ++i) a[i] += o8[i];
    *(u32x4*)op = pack8(a);
}
__device__ __forceinline__ u32x4 gla_old(unsigned char* wsl, int b, int h, int d, int vs, int step, int tid) {
    const int ch = step_chunk(d, step), rowbase = chunk_rowbase(b, ch), p = tid >> 3, c8 = (tid & 7) * 8, tk = d ? 63 - p : p;
    return *(const u32x4*)((const bf16_t*)(wsl + WS_OGLA) + (size_t)d * R * 1024 + (size_t)(rowbase + tk) * 1024 + h * 256 + vs * 64 + c8);
}
__device__ __forceinline__ void gla_step(const GlaOps& o, f32x4 (&Sacc)[4], LAS const bf16_t* Sc, LAS bf16_t* Sn, LAS bf16_t* OT, unsigned char* wsl, int b, int h, int d, int vs, int step, int tid, int fr, int fq, int pb, int vvb0, int vb, int kb0, const u32x4 oldv) {
    LAS bf16_t* OTc = OT + (step & 1) * (64 * 72);
#pragma unroll
    for (int j = 0; j < 2; ++j) { const int vvb = vvb0 + j; f32x4 acc = (f32x4){0.f, 0.f, 0.f, 0.f};
#pragma unroll
        for (int ks = 0; ks < 4; ++ks) { const bf16x8 bt = *(const LAS bf16x8*)(Sc + (vvb * 16 + fr) * 136 + ks * 32 + fq * 8); acc = MFMA16(bt, o.qa[ks], acc); }
        u32x2 w; w.x = pk2(acc[0], acc[1]); w.y = pk2(acc[2], acc[3]);
        *(LAS u32x2*)(OTc + (pb * 16 + fr) * 72 + vvb * 16 + 4 * fq) = w; }
#pragma unroll
    for (int j = 0; j < 4; ++j) { const int kj = j & 1, vj = j >> 1; f32x4 acc = Sacc[j] * o.dc[kj];
#pragma unroll
        for (int ks = 0; ks < 2; ++ks) acc = MFMA16(o.ke[kj][ks], o.va[vj][ks], acc);
        Sacc[j] = acc;
        u32x2 w; w.x = pk2(acc[0], acc[1]); w.y = pk2(acc[2], acc[3]);
        *(LAS u32x2*)(Sn + ((vb + vj) * 16 + fr) * 136 + (kb0 + kj) * 16 + 4 * fq) = w; }
    gla_flush(OT + ((step - 1) & 1) * (64 * 72), wsl, b, h, d, vs, step > 0 ? step - 1 : 0, tid, oldv);
}
__device__ __forceinline__ void gla_scan_unit(const Frame& F, int b, int h, int d, int vs) {
    int tid = F.tid; asm volatile("" : "+v"(tid));
    size_t wz_ = 0; asm volatile("" : "+s"(wz_)); unsigned char* wsl = F.ws + wz_;
    const int lane = tid & 63, w = __builtin_amdgcn_readfirstlane(tid >> 6), fr = lane & 15, fq = lane >> 4;
    LAS bf16_t* ST = (LAS bf16_t*)(F.lds);
    LAS bf16_t* OT = (LAS bf16_t*)(F.lds + 34816);
    const int pb = w >> 1, vvb0 = (w & 1) * 2, vb = w >> 1, kb0 = (w & 1) * 4;
    f32x4 Sacc[4];
#pragma unroll
    for (int j = 0; j < 4; ++j) Sacc[j] = (f32x4){0.f, 0.f, 0.f, 0.f};
    GlaOps A, B;
    gla_ops_load(A, wsl, b, h, d, vs, 0, fr, fq, pb, vvb0, vb, kb0);
    __syncthreads();
    for (int i = tid; i < 64 * 136 / 2; i += NTHR) ((LAS unsigned*)ST)[i] = 0u;
    __syncthreads();
    LAS bf16_t* S0 = ST; LAS bf16_t* S1 = ST + 64 * 136;
#pragma unroll 1
    for (int step = 0; step < NCH; step += 2) {
        gla_ops_load(B, wsl, b, h, d, vs, step + 1, fr, fq, pb, vvb0, vb, kb0);
        __builtin_amdgcn_sched_barrier(0);
        gla_step(A, Sacc, S0, S1, OT, wsl, b, h, d, vs, step, tid, fr, fq, pb, vvb0, vb, kb0, step > 0 ? gla_old(wsl, b, h, d, vs, step - 1, tid) : (u32x4){0u, 0u, 0u, 0u});
        __syncthreads();
        if (step + 2 < NCH) gla_ops_load(A, wsl, b, h, d, vs, step + 2, fr, fq, pb, vvb0, vb, kb0);
        __builtin_amdgcn_sched_barrier(0);
        gla_step(B, Sacc, S1, S0, OT, wsl, b, h, d, vs, step + 1, tid, fr, fq, pb, vvb0, vb, kb0, gla_old(wsl, b, h, d, vs, step, tid));
        __syncthreads();
    }
    gla_flush(OT + ((NCH - 1) & 1) * (64 * 72), wsl, b, h, d, vs, NCH - 1, tid, gla_old(wsl, b, h, d, vs, NCH - 1, tid));
}

__device__ __forceinline__ void ld16(const bf16_t* p, float (&x)[16]) { float t8[8]; unpack8(*(const u32x4*)p, t8);
#pragma unroll
    for (int i = 0; i < 8; ++i) x[i] = t8[i];
    unpack8(*(const u32x4*)(p + 8), t8);
#pragma unroll
    for (int i = 0; i < 8; ++i) x[8 + i] = t8[i]; }
template <int BI> __device__ __forceinline__ void tinv_row(LAS float* Ti, LAS const float* Nx, int tid) {
    for (int e = tid; e < BI * 256; e += NTHR) { const int bj = e >> 8, a = (e >> 4) & 15, c = e & 15; float acc = 0.f;
#pragma unroll
        for (int sx = 0; sx < BI * 16; ++sx) acc -= Nx[((BI - 1) * 16 + a) * 52 + sx] * Ti[sx * 68 + bj * 16 + c];
        Ti[(BI * 16 + a) * 68 + bj * 16 + c] = acc; }
}
__device__ __forceinline__ unsigned long long gdn_prep_unit(const Frame& F, int l, int b, int ch, int h, bool load_cw) {
    unsigned long long tacc = 0, tl_ = 0; if (PROBE_GDN) tl_ = wall_clock64();
#define GST(id) do { if (PROBE_GDN) { const unsigned long long tn_ = wall_clock64(); if (PROBE_GDN == (id)) tacc += tn_ - tl_; tl_ = tn_; } } while (0)
    int tid = F.tid; asm volatile("" : "+v"(tid));
    size_t wz_ = 0; asm volatile("" : "+s"(wz_)); unsigned char* wsl = F.ws + wz_;
    const int lane = tid & 63, w = __builtin_amdgcn_readfirstlane(tid >> 6), fr = lane & 15, fq = lane >> 4;
    LAS float* Lm = (LAS float*)(F.lds + 0);
    LAS bf16_t* TH = (LAS bf16_t*)(F.lds + 0);
    LAS bf16_t* TL = (LAS bf16_t*)(F.lds + 9216);
    LAS float* Ti = (LAS float*)(F.lds + 17408);
    LAS float* Nx = (LAS float*)(F.lds + 34816);
    LAS float* gb = (LAS float*)(F.lds + 44800);
    LAS float* bt = (LAS float*)(F.lds + 45312);
    LAS bf16_t* qh = (LAS bf16_t*)(F.lds + 45824);
    LAS bf16_t* kh = (LAS bf16_t*)(F.lds + 63232);
    LAS bf16_t* kbT = (LAS bf16_t*)(F.lds + 80640);
    LAS bf16_t* vbT = (LAS bf16_t*)(F.lds + 99072);
    LAS float* cwL = (LAS float*)(F.lds + 117504);
    const bf16_t* P = (const bf16_t*)(wsl + WS_P); const float* small = (const float*)(wsl + WS_SMALL);
    const int rowbase = chunk_rowbase(b, ch);
    const int T = ch < 4 ? CTXL : SEQ, chl = ch < 4 ? ch : ch - 4;
    unsigned char* ub0 = wsl + WS_GDNPREP + (size_t)(((b * NCH + ch) * 8 + h) * 2) * GDN_UNIT;
    const int t = tid >> 3, c0 = (tid & 7) * 16;
    u32x4 raw[3][3][2];
    { const int ts = chl * 64 + t; const u32x4 z4 = (u32x4){0u, 0u, 0u, 0u};
#pragma unroll
        for (int part = 0; part < 3; ++part) { const bf16_t* xp = P + (size_t)(rowbase + t) * NP + PC_GDN_Q + part * 1024 + h * 128 + c0;
            raw[part][0][0] = (ts - 1 >= 0) ? *(const u32x4*)(xp - NP) : z4; raw[part][0][1] = (ts - 1 >= 0) ? *(const u32x4*)(xp - NP + 8) : z4;
            raw[part][1][0] = *(const u32x4*)xp; raw[part][1][1] = *(const u32x4*)(xp + 8);
            raw[part][2][0] = (ts + 1 < T) ? *(const u32x4*)(xp + NP) : z4; raw[part][2][1] = (ts + 1 < T) ? *(const u32x4*)(xp + NP + 8) : z4; } }
    f32x4 cwv = (f32x4){0.f, 0.f, 0.f, 0.f};
    if (load_cw && tid < 288) { const int tap = tid / 96, rem = tid % 96, part = rem >> 5, c4 = (rem & 31) * 4;
        cwv = *(const f32x4*)(F.in[I_CONVW] + (size_t)l * 3 * 3072 + tap * 3072 + part * 1024 + h * 128 + c4); }
    float g0a = 0.f, g0b = 0.f, g0l = 0.f, g0t = 0.f;
    if (w < 2) { const int d = w, tok = d ? 63 - lane : lane;
        g0a = small[(size_t)(rowbase + tok) * 64 + 32 + d * 8 + h]; g0b = small[(size_t)(rowbase + tok) * 64 + 48 + d * 8 + h];
        g0l = F.in[I_ALOG][(l * 2 + d) * 8 + h]; g0t = F.in[I_DTB][(l * 2 + d) * 8 + h]; }
    __builtin_amdgcn_sched_barrier(0);
    if (load_cw) {
        if (tid < 288) { const int tap = tid / 96, rem = tid % 96; *(LAS f32x4*)(cwL + tap * 384 + rem * 4) = cwv; }
        __syncthreads(); }
    float qn[16], kn[16], vv[16];
    {
#pragma unroll
        for (int part = 0; part < 3; ++part) {
            const int wc = part * 128 + c0;
            float x0[16], x1[16], x2[16], t8[8];
            unpack8(raw[part][0][0], t8);
#pragma unroll
            for (int i = 0; i < 8; ++i) x0[i] = t8[i];
            unpack8(raw[part][0][1], t8);
#pragma unroll
            for (int i = 0; i < 8; ++i) x0[8 + i] = t8[i];
            unpack8(raw[part][1][0], t8);
#pragma unroll
            for (int i = 0; i < 8; ++i) x1[i] = t8[i];
            unpack8(raw[part][1][1], t8);
#pragma unroll
            for (int i = 0; i < 8; ++i) x1[8 + i] = t8[i];
            unpack8(raw[part][2][0], t8);
#pragma unroll
            for (int i = 0; i < 8; ++i) x2[i] = t8[i];
            unpack8(raw[part][2][1], t8);
#pragma unroll
            for (int i = 0; i < 8; ++i) x2[8 + i] = t8[i];
#pragma unroll
            for (int i = 0; i < 16; ++i) { const float v = siluf_(cwL[wc + i] * x0[i] + cwL[384 + wc + i] * x1[i] + cwL[768 + wc + i] * x2[i]);
                if (part == 0) qn[i] = v; else if (part == 1) kn[i] = v; else vv[i] = v; }
        }
        float sq = 0.f, sk = 0.f;
#pragma unroll
        for (int i = 0; i < 16; ++i) { sq += qn[i] * qn[i]; sk += kn[i] * kn[i]; }
#pragma unroll
        for (int o = 1; o < 8; o <<= 1) { sq += shx(sq, o, lane); sk += shx(sk, o, lane); }
        const float rq = rsqrtf(sq + EPS) * 0.08838834764831845f, rk = rsqrtf(sk + EPS);
#pragma unroll
        for (int i = 0; i < 16; ++i) { qn[i] *= rq; kn[i] *= rk; }
        float t8[8];
#pragma unroll
        for (int i = 0; i < 8; ++i) t8[i] = qn[i];
        *(LAS u32x4*)(qh + t * 136 + c0) = pack8(t8);
#pragma unroll
        for (int i = 0; i < 8; ++i) t8[i] = qn[8 + i];
        *(LAS u32x4*)(qh + t * 136 + c0 + 8) = pack8(t8);
#pragma unroll
        for (int i = 0; i < 8; ++i) t8[i] = kn[i];
        *(LAS u32x4*)(kh + t * 136 + c0) = pack8(t8);
#pragma unroll
        for (int i = 0; i < 8; ++i) t8[i] = kn[8 + i];
        *(LAS u32x4*)(kh + t * 136 + c0 + 8) = pack8(t8); }
    if (w < 2) { const int d = w;
        float g = -__expf(g0l) * softplusf_(g0a + g0t);
#pragma unroll
        for (int o = 1; o < 64; o <<= 1) { const float tt = shup(g, o, lane); if (lane >= o) g += tt; }
        gb[d * 64 + lane] = g; bt[d * 64 + lane] = sigmoidf_(g0b);
        if (lane == 63) *(float*)(ub0 + (size_t)d * GDN_UNIT + 73728) = __expf(g); }
    __syncthreads();
    GST(1);
#pragma unroll 1
    for (int d = 0; d < 2; ++d) {
        unsigned char* ub = ub0 + (size_t)d * GDN_UNIT;
        bf16_t* g_nw = (bf16_t*)ub; bf16_t* g_uT = (bf16_t*)(ub + 16384); bf16_t* g_at = (bf16_t*)(ub + 32768); bf16_t* g_qd = (bf16_t*)(ub + 40960); bf16_t* g_kdT = (bf16_t*)(ub + 57344);
        LAS const float* gbd = gb + d * 64; LAS const float* btd = bt + d * 64;
        { const int p = d ? 63 - t : t; const float bcp = gbd[p], bl = gbd[63], beta = btd[p], eq = __expf(bcp), ek = __expf(bl - bcp), sk = beta * eq;
            float t8[8];
#pragma unroll
            for (int i = 0; i < 8; ++i) t8[i] = qn[i] * eq;
            *(u32x4*)(g_qd + frag_off(p, c0, 4)) = pack8(t8);
#pragma unroll
            for (int i = 0; i < 8; ++i) t8[i] = qn[8 + i] * eq;
            *(u32x4*)(g_qd + frag_off(p, c0 + 8, 4)) = pack8(t8);
#pragma unroll
            for (int i = 0; i < 16; ++i) { g_kdT[frag_off(c0 + i, p, 2)] = f2bf(kn[i] * ek); kbT[(c0 + i) * 72 + p] = f2bf(kn[i] * sk); vbT[(c0 + i) * 72 + p] = f2bf(vv[i] * beta); } }
        __syncthreads();
        GST(2);
        { const bool isq = w >= 4; const int rb = w & 3; LAS const bf16_t* Asrc = isq ? qh : kh;
            const int pr = rb * 16 + fr, tr = d ? 63 - pr : pr;
            bf16x8 af[4];
#pragma unroll
            for (int ks = 0; ks < 4; ++ks) af[ks] = *(const LAS bf16x8*)(Asrc + tr * 136 + ks * 32 + fq * 8);
            const float bp = gbd[pr], betap = btd[pr];
#pragma unroll
            for (int cb = 0; cb < 4; ++cb) { f32x4 acc = (f32x4){0.f, 0.f, 0.f, 0.f}; const int sr = cb * 16 + fr, tsr = d ? 63 - sr : sr;
#pragma unroll
                for (int ks = 0; ks < 4; ++ks) { const bf16x8 bfr = *(const LAS bf16x8*)(kh + tsr * 136 + ks * 32 + fq * 8); acc = MFMA16(bfr, af[ks], acc); }
                const int s0 = cb * 16 + 4 * fq; float o[4];
#pragma unroll
                for (int i = 0; i < 4; ++i) { const int sx = s0 + i; const bool keep = isq ? (sx <= pr) : (sx < pr);
                    const float e = keep ? __expf(bp - gbd[sx]) : 0.f; o[i] = keep ? acc[i] * e * (isq ? 1.0f : betap) : 0.f; }
                if (isq) { u32x2 ov; ov.x = pk2(o[0], o[1]); ov.y = pk2(o[2], o[3]); *(u32x2*)(g_at + frag_off(pr, s0, 2)) = ov; }
                else *(LAS f32x4*)(Lm + pr * 68 + s0) = (f32x4){o[0], o[1], o[2], o[3]}; } }
        __syncthreads();
        GST(3);
        if (w < 4) { const int jb = w, a = lane & 15, g = lane >> 4;
            float bn[4][3][4];
#pragma unroll
            for (int bi = 1; bi < 4; ++bi)
#pragma unroll
                for (int bk = 0; bk < bi; ++bk) if (bk >= jb) {
#pragma unroll
                    for (int ks = 0; ks < 4; ++ks) bn[bi][bk][ks] = Lm[(bi * 16 + ks * 4 + g) * 68 + bk * 16 + a]; }
            { LAS const float* Lb = Lm + (g * 16) * 68 + g * 16; float x[16];
#pragma unroll
                for (int r = 0; r < 16; ++r) { float acc = (r == a) ? 1.0f : 0.0f;
#pragma unroll
                    for (int sx = 0; sx < r; ++sx) acc -= Lb[r * 68 + sx] * x[sx];
                    x[r] = acc; }
#pragma unroll
                for (int r = 0; r < 16; ++r) Ti[(g * 16 + r) * 68 + g * 16 + a] = x[r]; }
            float an[4][4];
#pragma unroll
            for (int bi = 1; bi < 4; ++bi) if (bi > jb) {
#pragma unroll
                for (int ks = 0; ks < 4; ++ks) an[bi][ks] = Ti[(bi * 16 + a) * 68 + bi * 16 + ks * 4 + g]; }
#pragma unroll
            for (int bi = 1; bi < 4; ++bi)
#pragma unroll
                for (int bk = 0; bk < bi; ++bk) if (bk >= jb) { f32x4 acc = (f32x4){0.f, 0.f, 0.f, 0.f};
#pragma unroll
                    for (int ks = 0; ks < 4; ++ks) acc = __builtin_amdgcn_mfma_f32_16x16x4f32(an[bi][ks], bn[bi][bk][ks], acc, 0, 0, 0);
#pragma unroll
                    for (int q = 0; q < 4; ++q) Nx[((bi - 1) * 16 + 4 * g + q) * 52 + bk * 16 + a] = acc[q]; }
#pragma unroll
            for (int bi = 1; bi < 4; ++bi) if (bi > jb) { float la[3][4], lb[3][4];
#pragma unroll
                for (int bk = 0; bk < bi; ++bk) if (bk >= jb) {
#pragma unroll
                    for (int ks = 0; ks < 4; ++ks) { la[bk][ks] = Nx[((bi - 1) * 16 + a) * 52 + bk * 16 + ks * 4 + g]; lb[bk][ks] = Ti[(bk * 16 + ks * 4 + g) * 68 + jb * 16 + a]; } }
                f32x4 acc = (f32x4){0.f, 0.f, 0.f, 0.f};
#pragma unroll
                for (int bk = 0; bk < bi; ++bk) if (bk >= jb) {
#pragma unroll
                    for (int ks = 0; ks < 4; ++ks) acc = __builtin_amdgcn_mfma_f32_16x16x4f32(la[bk][ks], lb[bk][ks], acc, 0, 0, 0); }
#pragma unroll
                for (int q = 0; q < 4; ++q) Ti[(bi * 16 + 4 * g + q) * 68 + jb * 16 + a] = -acc[q]; } }
        __syncthreads();
        GST(5);
        { const int p = tid >> 3, s0 = (tid & 7) * 8; float hi[8], lo[8];
#pragma unroll
            for (int i = 0; i < 8; ++i) { const float v = ((s0 >> 4) <= (p >> 4)) ? Ti[p * 68 + s0 + i] : 0.f; const float hf = bf2f(f2bf(v)); hi[i] = hf; lo[i] = v - hf; }
            *(LAS u32x4*)(TH + p * 72 + s0) = pack8(hi); *(LAS u32x4*)(TL + p * 72 + s0) = pack8(lo); }
        __syncthreads();
        { const bool isu = w >= 4; LAS const bf16_t* Bsrc = isu ? vbT : kbT;
            bf16x8 th[4][2], tl[4][2];
#pragma unroll
            for (int rb = 0; rb < 4; ++rb)
#pragma unroll
                for (int ks = 0; ks < 2; ++ks) { th[rb][ks] = *(const LAS bf16x8*)(TH + (rb * 16 + fr) * 72 + ks * 32 + fq * 8); tl[rb][ks] = *(const LAS bf16x8*)(TL + (rb * 16 + fr) * 72 + ks * 32 + fq * 8); }
#pragma unroll
            for (int jj = 0; jj < 2; ++jj) { const int cb = (w & 3) * 2 + jj;
                bf16x8 bf[2];
#pragma unroll
                for (int ks = 0; ks < 2; ++ks) bf[ks] = *(const LAS bf16x8*)(Bsrc + (cb * 16 + fr) * 72 + ks * 32 + fq * 8);
#pragma unroll
                for (int rb = 0; rb < 4; ++rb) { f32x4 acc = (f32x4){0.f, 0.f, 0.f, 0.f};
                    if (!isu) {
#pragma unroll
                        for (int ks = 0; ks < 2; ++ks) { acc = MFMA16(bf[ks], th[rb][ks], acc); acc = MFMA16(bf[ks], tl[rb][ks], acc); }
                        u32x2 ov; ov.x = pk2(-acc[0], -acc[1]); ov.y = pk2(-acc[2], -acc[3]);
                        *(u32x2*)(g_nw + frag_off(rb * 16 + fr, cb * 16 + 4 * fq, 4)) = ov;
                    } else {
#pragma unroll
                        for (int ks = 0; ks < 2; ++ks) { acc = MFMA16(th[rb][ks], bf[ks], acc); acc = MFMA16(tl[rb][ks], bf[ks], acc); }
                        u32x2 ov; ov.x = pk2(acc[0], acc[1]); ov.y = pk2(acc[2], acc[3]);
                        *(u32x2*)(g_uT + (((cb * 4 + rb) << 8) + (fq * 16 + fr) * 4)) = ov;
                    } } } }
        __syncthreads();
        GST(6);
    }
    return tacc;
#undef GST
}

struct GdnOps { bf16x8 wa[4]; u32x2 uw[2]; bf16x8 qa[4]; bf16x8 aa[2]; bf16x8 kd[2]; float cd; };
__device__ __forceinline__ void gdn_ops_load(GdnOps& o, unsigned char* wsl, int b, int h, int d, int vs, int step, int fr, int fq, int pb, int vvb0, int kb0) {
    const int ch = step_chunk(d, step);
    const unsigned char* ub = wsl + WS_GDNPREP + (size_t)(((b * NCH + ch) * 8 + h) * 2 + d) * GDN_UNIT;
    const bf16_t* g_nw = (const bf16_t*)ub; const bf16_t* g_uT = (const bf16_t*)(ub + 16384); const bf16_t* g_at = (const bf16_t*)(ub + 32768); const bf16_t* g_qd = (const bf16_t*)(ub + 40960); const bf16_t* g_kdT = (const bf16_t*)(ub + 57344);
#pragma unroll
    for (int ks = 0; ks < 4; ++ks) o.wa[ks] = *(const bf16x8*)(g_nw + frag_tile(pb, ks, 4, fq * 16 + fr));
#pragma unroll
    for (int j = 0; j < 2; ++j) o.uw[j] = *(const u32x2*)(g_uT + ((((vs * 4 + vvb0 + j) * 4 + pb) << 8) + (fq * 16 + fr) * 4));
#pragma unroll
    for (int ks = 0; ks < 4; ++ks) o.qa[ks] = *(const bf16x8*)(g_qd + frag_tile(pb, ks, 4, fq * 16 + fr));
#pragma unroll
    for (int ks = 0; ks < 2; ++ks) o.aa[ks] = *(const bf16x8*)(g_at + frag_tile(pb, ks, 2, fq * 16 + fr));
#pragma unroll
    for (int ks = 0; ks < 2; ++ks) o.kd[ks] = *(const bf16x8*)(g_kdT + frag_tile(pb * 2 + (kb0 >> 2), ks, 2, fq * 16 + fr));
    o.cd = *(const float*)(ub + 73728);
}
__device__ __forceinline__ void gdn_flush(LAS const bf16_t* OTp, unsigned char* wsl, int b, int h, int d, int vs, int step, int tid) {
    const int ch = step_chunk(d, step), rowbase = chunk_rowbase(b, ch), p = tid >> 3, c8 = (tid & 7) * 8, tk = d ? 63 - p : p;
    *(u32x4*)((bf16_t*)(wsl + WS_OGDN) + (size_t)d * R * 1024 + (size_t)(rowbase + tk) * 1024 + h * 128 + vs * 64 + c8) = *(const LAS u32x4*)(OTp + p * 72 + c8);
}
__device__ __forceinline__ void gdn_step(const GdnOps& o, f32x4 (&Sacc)[4], LAS const bf16_t* Sc, LAS bf16_t* Sn, LAS bf16_t* VN, LAS bf16_t* OT, unsigned char* wsl, int b, int h, int d, int vs, int step, int tid, int fr, int fq, int pb, int vvb0, int vb, int kb0) {
    LAS bf16_t* OTc = OT + (step & 1) * (64 * 72);
    gdn_flush(OT + ((step - 1) & 1) * (64 * 72), wsl, b, h, d, vs, step > 0 ? step - 1 : 0, tid);
    bf16x8 sb[2][4];
#pragma unroll
    for (int j = 0; j < 2; ++j)
#pragma unroll
        for (int ks = 0; ks < 4; ++ks) sb[j][ks] = *(const LAS bf16x8*)(Sc + ((vvb0 + j) * 16 + fr) * 136 + ks * 32 + fq * 8);
#pragma unroll
    for (int j = 0; j < 2; ++j) { const int vvb = vvb0 + j;
        f32x4 acc = (f32x4){lo16(o.uw[j].x), hi16(o.uw[j].x), lo16(o.uw[j].y), hi16(o.uw[j].y)};
#pragma unroll
        for (int ks = 0; ks < 4; ++ks) acc = MFMA16(o.wa[ks], sb[j][ks], acc);
        u32x2 w; w.x = pk2(acc[0], acc[1]); w.y = pk2(acc[2], acc[3]);
        *(LAS u32x2*)(VN + (vvb * 16 + fr) * 72 + pb * 16 + 4 * fq) = w; }
    __syncthreads();
#pragma unroll
    for (int j = 0; j < 2; ++j) { const int vvb = vvb0 + j; f32x4 acc = (f32x4){0.f, 0.f, 0.f, 0.f};
#pragma unroll
        for (int ks = 0; ks < 4; ++ks) { const bf16x8 sbr = *(const LAS bf16x8*)(Sc + (vvb * 16 + fr) * 136 + ks * 32 + fq * 8); acc = MFMA16(sbr, o.qa[ks], acc); }
#pragma unroll
        for (int ks = 0; ks < 2; ++ks) { const bf16x8 bv = *(const LAS bf16x8*)(VN + (vvb * 16 + fr) * 72 + ks * 32 + fq * 8); acc = MFMA16(bv, o.aa[ks], acc); }
        u32x2 w; w.x = pk2(acc[0], acc[1]); w.y = pk2(acc[2], acc[3]);
        *(LAS u32x2*)(OTc + (pb * 16 + fr) * 72 + vvb * 16 + 4 * fq) = w; }
    { const int kbw = pb * 2 + (kb0 >> 2);
#pragma unroll
        for (int j = 0; j < 4; ++j) { f32x4 acc = Sacc[j] * o.cd;
#pragma unroll
            for (int ks = 0; ks < 2; ++ks) { const bf16x8 va = *(const LAS bf16x8*)(VN + (j * 16 + fr) * 72 + ks * 32 + fq * 8); acc = MFMA16(o.kd[ks], va, acc); }
            Sacc[j] = acc;
            u32x2 w; w.x = pk2(acc[0], acc[1]); w.y = pk2(acc[2], acc[3]);
            *(LAS u32x2*)(Sn + (j * 16 + fr) * 136 + kbw * 16 + 4 * fq) = w; } }
}
__device__ __forceinline__ void gdn_scan_unit(const Frame& F, int b, int h, int d, int vs) {
    int tid = F.tid; asm volatile("" : "+v"(tid));
    size_t wz_ = 0; asm volatile("" : "+s"(wz_)); unsigned char* wsl = F.ws + wz_;
    const int lane = tid & 63, w = __builtin_amdgcn_readfirstlane(tid >> 6), fr = lane & 15, fq = lane >> 4;
    LAS bf16_t* ST = (LAS bf16_t*)(F.lds);
    LAS bf16_t* VN = (LAS bf16_t*)(F.lds + 34816);
    LAS bf16_t* OT = (LAS bf16_t*)(F.lds + 44032);
    const int pb = w >> 1, vvb0 = (w & 1) * 2, vb = w >> 1, kb0 = (w & 1) * 4;
    f32x4 Sacc[4];
#pragma unroll
    for (int j = 0; j < 4; ++j) Sacc[j] = (f32x4){0.f, 0.f, 0.f, 0.f};
    GdnOps A, B;
    gdn_ops_load(A, wsl, b, h, d, vs, 0, fr, fq, pb, vvb0, kb0);
    __syncthreads();
    for (int i = tid; i < 64 * 136 / 2; i += NTHR) ((LAS unsigned*)ST)[i] = 0u;
    __syncthreads();
    LAS bf16_t* S0 = ST; LAS bf16_t* S1 = ST + 64 * 136;
#pragma unroll 1
    for (int step = 0; step < NCH; step += 2) {
        gdn_ops_load(B, wsl, b, h, d, vs, step + 1, fr, fq, pb, vvb0, kb0);
        __builtin_amdgcn_sched_barrier(0);
        gdn_step(A, Sacc, S0, S1, VN, OT, wsl, b, h, d, vs, step, tid, fr, fq, pb, vvb0, vb, kb0);
        __syncthreads();
        if (step + 2 < NCH) gdn_ops_load(A, wsl, b, h, d, vs, step + 2, fr, fq, pb, vvb0, kb0);
        __builtin_amdgcn_sched_barrier(0);
        gdn_step(B, Sacc, S1, S0, VN, OT, wsl, b, h, d, vs, step + 1, tid, fr, fq, pb, vvb0, vb, kb0);
        __syncthreads();
    }
    gdn_flush(OT + ((NCH - 1) & 1) * (64 * 72), wsl, b, h, d, vs, NCH - 1, tid);
}

__device__ __forceinline__ void scan_pair_unit(const Frame& F, int ua, int ud) {
    int tid = F.tid; asm volatile("" : "+v"(tid));
    size_t wz_ = 0; asm volatile("" : "+s"(wz_)); unsigned char* wsl = F.ws + wz_;
    const int lane = tid & 63, w = __builtin_amdgcn_readfirstlane(tid >> 6), fr = lane & 15, fq = lane >> 4;
    const int vsA = ua & 3, dA = (ua >> 2) & 1, hAx = (ua >> 3) & 3, bA = ua >> 5;
    const int vsD = ud & 1, dD = (ud >> 1) & 1, hD = (ud >> 2) & 7, bD = ud >> 5;
    LAS bf16_t* STa = (LAS bf16_t*)(F.lds);
    LAS bf16_t* OTa = (LAS bf16_t*)(F.lds + 34816);
    LAS bf16_t* STd = (LAS bf16_t*)(F.lds + 53248);
    LAS bf16_t* VN = (LAS bf16_t*)(F.lds + 88064);
    LAS bf16_t* OTd = (LAS bf16_t*)(F.lds + 97280);
    const int pb = w >> 1, vvb0 = (w & 1) * 2, vb = w >> 1, kb0 = (w & 1) * 4, vbA = (w & 1) * 2, kbA = (w >> 1) * 2;
    f32x4 SaccA[4], SaccD[4];
#pragma unroll
    for (int j = 0; j < 4; ++j) { SaccA[j] = (f32x4){0.f, 0.f, 0.f, 0.f}; SaccD[j] = (f32x4){0.f, 0.f, 0.f, 0.f}; }
    GlaOps GA; GdnOps GD;
    gla_ops_load(GA, wsl, bA, hAx, dA, vsA, 0, fr, fq, pb, vvb0, vbA, kbA);
    u32x4 oldv = gla_old(wsl, bA, hAx, dA, vsA, 0, tid);
    __builtin_amdgcn_sched_barrier(0);
    gdn_ops_load(GD, wsl, bD, hD, dD, vsD, 0, fr, fq, pb, vvb0, kb0);
    __builtin_amdgcn_sched_barrier(0);
    __syncthreads();
    for (int i = tid; i < 64 * 136 / 2; i += NTHR) { ((LAS unsigned*)STa)[i] = 0u; ((LAS unsigned*)STd)[i] = 0u; }
    for (int i = tid; i < 64 * 72 / 2; i += NTHR) { ((LAS unsigned*)(OTa + 64 * 72))[i] = 0u; ((LAS unsigned*)(OTd + 64 * 72))[i] = 0u; }
    __syncthreads();
#pragma unroll 1
    for (int step = 0; step < NCH; ++step) {
        const int cur = step & 1;
        __builtin_amdgcn_sched_barrier(0);
        gla_step(GA, SaccA, STa + cur * (64 * 136), STa + (cur ^ 1) * (64 * 136), OTa, wsl, bA, hAx, dA, vsA, step, tid, fr, fq, pb, vvb0, vbA, kbA, oldv);
        __builtin_amdgcn_sched_barrier(0);
        __syncthreads();
        gla_ops_load(GA, wsl, bA, hAx, dA, vsA, step + 1 < NCH ? step + 1 : NCH - 1, fr, fq, pb, vvb0, vbA, kbA);
        __builtin_amdgcn_sched_barrier(0);
        gdn_step(GD, SaccD, STd + cur * (64 * 136), STd + (cur ^ 1) * (64 * 136), VN, OTd, wsl, bD, hD, dD, vsD, step, tid, fr, fq, pb, vvb0, vb, kb0);
        __syncthreads();
        oldv = gla_old(wsl, bA, hAx, dA, vsA, step, tid);
        __builtin_amdgcn_sched_barrier(0);
        gdn_ops_load(GD, wsl, bD, hD, dD, vsD, step + 1 < NCH ? step + 1 : NCH - 1, fr, fq, pb, vvb0, kb0);
        __builtin_amdgcn_sched_barrier(0);
    }
    gla_flush(OTa + ((NCH - 1) & 1) * (64 * 72), wsl, bA, hAx, dA, vsA, NCH - 1, tid, oldv);
    gdn_flush(OTd + ((NCH - 1) & 1) * (64 * 72), wsl, bD, hD, dD, vsD, NCH - 1, tid);
}

__device__ __forceinline__ void phase_merge_prep(const Frame& F, int l, int nrows) {
    int tid = F.tid; asm volatile("" : "+v"(tid));
    size_t wz_ = 0; asm volatile("" : "+s"(wz_)); unsigned char* wsl = F.ws + wz_;
    int bxl = F.bx; asm volatile("" : "+s"(bxl)); (void)bxl;
    const int lane = tid & 63, wave = __builtin_amdgcn_readfirstlane(tid >> 6); (void)lane; (void)wave;
    const bf16_t* __restrict__ P = (const bf16_t*)(wsl + WS_P);
    const bf16_t* __restrict__ oga = (const bf16_t*)(wsl + WS_OGLA); const bf16_t* __restrict__ ogd = (const bf16_t*)(wsl + WS_OGDN);
    bf16_t* __restrict__ yga = (bf16_t*)(wsl + WS_Y3); bf16_t* __restrict__ ygd = yga + 1024; bf16_t* __restrict__ pld = yga + 2048;
    const float* __restrict__ gnw = F.in[I_GLANW] + l * 256; const float* __restrict__ dnw = F.in[I_GDNNW] + l * 128;
    const int c0 = lane * 16;
#pragma unroll 2
    for (int r = bxl * 8 + wave; r < nrows; r += F.G * 8) {
        { float o[16], z[16], t8[8];
            const bf16_t* a0 = oga + (size_t)r * 1024 + c0; const bf16_t* a1 = a0 + (size_t)R * 1024;
            unpack8(*(const u32x4*)a0, t8);
#pragma unroll
            for (int i = 0; i < 8; ++i) o[i] = t8[i];
            unpack8(*(const u32x4*)(a0 + 8), t8);
#pragma unroll
            for (int i = 0; i < 8; ++i) o[8 + i] = t8[i];
            unpack8(*(const u32x4*)a1, t8);
#pragma unroll
            for (int i = 0; i < 8; ++i) o[i] += t8[i];
            unpack8(*(const u32x4*)(a1 + 8), t8);
#pragma unroll
            for (int i = 0; i < 8; ++i) o[8 + i] += t8[i];
            const bf16_t* zp = P + (size_t)r * NP + PC_GLA_Z + c0;
            unpack8(*(const u32x4*)zp, t8);
#pragma unroll
            for (int i = 0; i < 8; ++i) z[i] = t8[i];
            unpack8(*(const u32x4*)(zp + 8), t8);
#pragma unroll
            for (int i = 0; i < 8; ++i) z[8 + i] = t8[i];
            float ss = 0.f;
#pragma unroll
            for (int i = 0; i < 16; ++i) ss += o[i] * o[i];
#pragma unroll
            for (int q = 1; q < 16; q <<= 1) ss += shx(ss, q, lane);
            const float rs = rsqrtf(ss * (1.0f / 256.0f) + EPS); const int vv0 = (lane & 15) * 16;
            u32x4 w0, w1;
#pragma unroll
            for (int i = 0; i < 8; ++i) t8[i] = o[i] * rs * gnw[vv0 + i] * siluf_(z[i]);
            w0 = pack8(t8);
#pragma unroll
            for (int i = 0; i < 8; ++i) t8[i] = o[8 + i] * rs * gnw[vv0 + 8 + i] * siluf_(z[8 + i]);
            w1 = pack8(t8);
            *(u32x4*)(yga + (size_t)r * 3072 + c0) = w0; *(u32x4*)(yga + (size_t)r * 3072 + c0 + 8) = w1; }
        { float o[16], z[16], t8[8];
            const bf16_t* a0 = ogd + (size_t)r * 1024 + c0; const bf16_t* a1 = a0 + (size_t)R * 1024;
            unpack8(*(const u32x4*)a0, t8);
#pragma unroll
            for (int i = 0; i < 8; ++i) o[i] = t8[i];
            unpack8(*(const u32x4*)(a0 + 8), t8);
#pragma unroll
            for (int i = 0; i < 8; ++i) o[8 + i] = t8[i];
            unpack8(*(const u32x4*)a1, t8);
#pragma unroll
            for (int i = 0; i < 8; ++i) o[i] += t8[i];
            unpack8(*(const u32x4*)(a1 + 8), t8);
#pragma unroll
            for (int i = 0; i < 8; ++i) o[8 + i] += t8[i];
            const bf16_t* zp = P + (size_t)r * NP + PC_GDN_Z + c0;
            unpack8(*(const u32x4*)zp, t8);
#pragma unroll
            for (int i = 0; i < 8; ++i) z[i] = t8[i];
            unpack8(*(const u32x4*)(zp + 8), t8);
#pragma unroll
            for (int i = 0; i < 8; ++i) z[8 + i] = t8[i];
            float ss = 0.f;
#pragma unroll
            for (int i = 0; i < 16; ++i) ss += o[i] * o[i];
#pragma unroll
            for (int q = 1; q < 8; q <<= 1) ss += shx(ss, q, lane);
            const float rs = rsqrtf(ss * (1.0f / 128.0f) + EPS); const int vv0 = (lane & 7) * 16;
            u32x4 w0, w1;
#pragma unroll
            for (int i = 0; i < 8; ++i) t8[i] = o[i] * rs * dnw[vv0 + i] * siluf_(z[i]);
            w0 = pack8(t8);
#pragma unroll
            for (int i = 0; i < 8; ++i) t8[i] = o[8 + i] * rs * dnw[vv0 + 8 + i] * siluf_(z[8 + i]);
            w1 = pack8(t8);
            *(u32x4*)(ygd + (size_t)r * 3072 + c0) = w0; *(u32x4*)(ygd + (size_t)r * 3072 + c0 + 8) = w1; }
        { const int T = r < RL ? SEQ : CTXL, ts = r < RL ? (r & (SEQ - 1)) : ((r - RL) & (CTXL - 1)), segbase = r - ts;
            const int win = 2 << (lane >> 4), lo = max(ts - win / 2, 0), hi = min(ts - win / 2 + win, T);
            float s[16], t8[8];
#pragma unroll
            for (int i = 0; i < 16; ++i) s[i] = 0.f;
#pragma unroll
            for (int hb = 0; hb < 2; ++hb) { u32x4 ra[8], rb[8]; const u32x4 z4 = (u32x4){0u, 0u, 0u, 0u};
#pragma unroll
                for (int j = 0; j < 8; ++j) { const int t = lo + hb * 8 + j; const bool ok = t < hi; const bf16_t* up = P + (size_t)(segbase + (ok ? t : lo)) * NP + PC_POOL + c0;
                    ra[j] = ok ? *(const u32x4*)up : z4; rb[j] = ok ? *(const u32x4*)(up + 8) : z4; }
#pragma unroll
                for (int j = 0; j < 8; ++j) { unpack8(ra[j], t8);
#pragma unroll
                    for (int i = 0; i < 8; ++i) s[i] += t8[i];
                    unpack8(rb[j], t8);
#pragma unroll
                    for (int i = 0; i < 8; ++i) s[8 + i] += t8[i]; } }
            const float inv = 1.0f / (float)(hi - lo);
            const bf16_t* up = P + (size_t)r * NP + PC_POOL + c0;
            u32x4 w0, w1;
            unpack8(*(const u32x4*)up, t8);
#pragma unroll
            for (int i = 0; i < 8; ++i) t8[i] = s[i] * inv - t8[i];
            w0 = pack8(t8);
            unpack8(*(const u32x4*)(up + 8), t8);
#pragma unroll
            for (int i = 0; i < 8; ++i) t8[i] = s[8 + i] * inv - t8[i];
            w1 = pack8(t8);
            *(u32x4*)(pld + (size_t)r * 3072 + c0) = w0; *(u32x4*)(pld + (size_t)r * 3072 + c0 + 8) = w1; }
    }
}

template <int VAR> __device__ __forceinline__ void phase_convglu(const Frame& F, int l, int nrows) {
    int tid = F.tid; asm volatile("" : "+v"(tid));
    const int lane = tid & 63, wave = __builtin_amdgcn_readfirstlane(tid >> 6);
    size_t wz_ = 0; asm volatile("" : "+s"(wz_)); unsigned char* wsl = F.ws + wz_;
    int bxl = F.bx; asm volatile("" : "+s"(bxl));
    const bf16_t* av = (const bf16_t*)(wsl + WS_AV); bf16_t* gout = (bf16_t*)(wsl + WS_G) + (VAR ? (size_t)R * DFF : 0);
    const float* cw = F.in[I_FFNCONV] + (size_t)l * 9 * DFF;
    constexpr int CSEG = 16, NSEG = 64 / CSEG;
    const int nwi = ((nrows > RL) ? 396 : 352) * NSEG;
    for (int wq = bxl; wq < nwi; wq += F.G) {
        const int wi = wq / NSEG, seg = wq % NSEG;
        int strip, ck;
        if (wi < 352) { ck = wi % 11; strip = (wi / 11) * 8 + wave; } else { ck = (wi - 352) % 11; strip = 256 + ((wi - 352) / 11) * 8 + wave; }
        const int c = (ck * 64 + lane) * 8;
        int row0, W, x0; bool up, dn;
        if (strip < 256) { const int gy = strip & 31; row0 = (strip >> 5) * SEQ + gy * 64; W = 64; x0 = seg * CSEG; up = gy > 0; dn = gy < 31; }
        else { const int t = strip - 256; row0 = RL + (t >> 2) * CTXL; W = CTXL; x0 = (t & 3) * 64 + seg * CSEG; up = false; dn = false; }
        float wt[9][8];
#pragma unroll
        for (int k = 0; k < 9; ++k) { const f32x4 w0 = *(const f32x4*)(cw + k * DFF + c), w1 = *(const f32x4*)(cw + k * DFF + c + 4);
#pragma unroll
            for (int i = 0; i < 4; ++i) { wt[k][i] = w0[i]; wt[k][4 + i] = w1[i]; } }
        const bf16_t* base = av + (size_t)row0 * NAV + c;
        const long rstep = (long)W * NAV;
        u32x4 win[3][3];
        const u32x4 zero4 = (u32x4){0u, 0u, 0u, 0u};
        const bool rok[3] = {up, true, dn};
#pragma unroll
        for (int r = 0; r < 3; ++r) { const bf16_t* rp = base + (long)(r - 1) * rstep;
            win[r][1] = (rok[r] && x0 > 0) ? *(const u32x4*)(rp + (long)(x0 - 1) * NAV) : zero4;
            win[r][2] = rok[r] ? *(const u32x4*)(rp + (long)x0 * NAV) : zero4; }
        u32x4 nw[2][3], vv[2];
#define CG_LOAD(XB) do { _Pragma("unroll") for (int j = 0; j < 2; ++j) { _Pragma("unroll") for (int r = 0; r < 3; ++r) \
            nw[j][r] = (rok[r] && ((XB) + j + 1 < W) && ((XB) + j < x0 + CSEG)) ? *(const u32x4*)(base + (long)(r - 1) * rstep + (long)((XB) + j + 1) * NAV) : zero4; \
            vv[j] = ((XB) + j < x0 + CSEG) ? *(const u32x4*)(base + (long)((XB) + j) * NAV + DFF) : zero4; } } while (0)
        CG_LOAD(x0);
        for (int xb = x0; xb < x0 + CSEG; xb += 2) {
            u32x4 cw_[2][3], cv[2];
#pragma unroll
            for (int j = 0; j < 2; ++j) { cv[j] = vv[j];
#pragma unroll
                for (int r = 0; r < 3; ++r) cw_[j][r] = nw[j][r]; }
            CG_LOAD(xb + 2);
#pragma unroll
            for (int j = 0; j < 2; ++j) {
                float acc[8];
#pragma unroll
                for (int i = 0; i < 8; ++i) acc[i] = 0.f;
#pragma unroll
                for (int r = 0; r < 3; ++r) { win[r][0] = win[r][1]; win[r][1] = win[r][2]; win[r][2] = cw_[j][r];
#pragma unroll
                    for (int dx = 0; dx < 3; ++dx) { float f8[8]; unpack8(win[r][dx], f8);
#pragma unroll
                        for (int i = 0; i < 8; ++i) acc[i] += f8[i] * wt[r * 3 + dx][i]; } }
                float v8[8]; unpack8(cv[j], v8);
#pragma unroll
                for (int i = 0; i < 8; ++i) v8[i] = (VAR == 2) ? acc[i] * v8[i] : acc[i] * __builtin_amdgcn_rcpf(1.0f + __expf(-acc[i])) * v8[i];
                if (VAR != 3 || acc[0] == 12345.f) *(u32x4*)(gout + (size_t)(row0 + xb + j) * DFF + c) = pack8(v8); }
        }
#undef CG_LOAD
    }
}

#ifndef PROBE_MASK
#define PROBE_MASK 0u
#endif
#ifndef PROBE_MULT
#define PROBE_MULT 1
#endif
#define PT0(id) do { if (PROBE_MASK & (1u << (id))) pt0 = wall_clock64(); } while (0)
#define PT1(id) do { if (PROBE_MASK & (1u << (id))) pacc += wall_clock64() - pt0; } while (0)
__global__ void __launch_bounds__(512, 2) fwd(Args args) {
    extern __shared__ __attribute__((aligned(16))) unsigned char lds_raw[];
    Frame F;
    F.lds = (LAS unsigned char*)lds_raw; F.ws = args.ws; F.in = args.in; F.out = args.out;
    F.tid = threadIdx.x; F.lane = F.tid & 63; F.wave = __builtin_amdgcn_readfirstlane(F.tid >> 6); F.G = gridDim.x; F.bx = blockIdx.x;
    volatile LAS unsigned* misc = (volatile LAS unsigned*)(F.lds + MISC_OFF);
    if (F.tid < 4) misc[F.tid] = 0u;
    __syncthreads();
    XcdBarrier bar = xcd_barrier_post((unsigned*)(F.ws + WS_CTL), misc);
    unsigned char* ws = F.ws; int bx = F.bx;
#define mods ((float*)(ws + WS_MODS))
#define xres ((bf16_t*)(ws + WS_XRES))
#define hA ((bf16_t*)(ws + WS_HA))
#define P ((bf16_t*)(ws + WS_P))
#define small ((float*)(ws + WS_SMALL))

    unsigned long long pt0 = 0, pacc = 0; (void)pt0;
    PT0(0);
#ifndef SK_MODS
    phase_mods(F);
#endif
    PT1(0);
    for (int l = 0; l < DEPTH; ++l) {
        const bool last = (l == DEPTH - 1);
        const int Mrows = last ? RL : R;
        const float* mods_l = mods + (size_t)l * 9 * 12288;
        PT0(1);
#ifndef SK_W
        if (l == 0) phase_weights(F, 0, 0, bx, F.G);
#endif
        PT1(1);
        if (l == 0) { PT0(0); xcd_barrier(bar); phase_mods_reduce(F); xcd_barrier(bar); PT1(0); }
        PT0(2);
        if (l == 0) phase_norm<true>(F, F.in[I_X], F.in[I_CTX], xres, F.in[I_N1W] + l * D, mods_l, 0, hA, R);
        else phase_norm<false>(F, xres, xres + (size_t)RL * D, nullptr, F.in[I_N1W] + l * D, mods_l, 0, hA, R);
        xcd_barrier(bar);
        { size_t wz_ = 0; asm volatile("" : "+s"(wz_)); ws = F.ws + wz_; } asm volatile("" : "+s"(bx));
        PT1(2);
        PT0(3);
        { pg8::Sched S; S.init(hA, D, 0, ws + WS_WIN, D, 0, last ? RL : R, NIN, 1, F.G, bx);
          if (last) { S.xtra = 8 * 15; S.xpm0 = RL / 256; }
          pg8::EpiInProj E{P, small};
#if !defined(SK_GEMM) && !defined(SK_GEMM0)
          pg8::gemm_phase<decltype(E), 4>(F.lds, D, D, D, S, E);
#endif
          }
        { const int TAIL = (last ? (RL / 256 * (NIN / 256) + 8 * 15) : (R / 256 * (NIN / 256))) % 256;
          if (F.G == 256 && bx >= TAIL) phase_weights(F, l, 1, bx - TAIL, 256 - TAIL); else if (F.G != 256) phase_weights(F, l, 1, bx, F.G); }
        xcd_barrier(bar);
        { size_t wz_ = 0; asm volatile("" : "+s"(wz_)); ws = F.ws + wz_; } asm volatile("" : "+s"(bx));
        PT1(3);
        PT0(4);
#ifndef SK_GLAPREP
        for (int u = bx; u < NB * NCH * 4 * 2; u += F.G) { const int d = u & 1, h = (u >> 1) & 3, ch = (u >> 3) % NCH, b = (u >> 3) / NCH; gla_prep_unit(F, l, b, ch, h, d); }
#endif
        PT1(4); PT0(5);
#ifndef SK_GDNPREP
        { int hprev = -1;
          for (int u = bx; u < NB * NCH * 8; u += F.G) { const int h = u & 7, ch = (u >> 3) % NCH, b = (u >> 3) / NCH; const unsigned long long dt_ = gdn_prep_unit(F, l, b, ch, h, h != hprev); hprev = h; if (PROBE_GDN) pacc += dt_; } }
#endif
        xcd_barrier(bar);
        { size_t wz_ = 0; asm volatile("" : "+s"(wz_)); ws = F.ws + wz_; } asm volatile("" : "+s"(bx));
        PT1(5);
        PT0(6);
#if !defined(SK_GLASCAN) && !defined(SK_GDNSCAN)
        for (int u = bx; u < 256; u += F.G) { const int xx = u & 7, yy = u >> 3; scan_pair_unit(F, (((yy >> 2) * 8 + xx) << 2) | (yy & 3), (((yy >> 1) * 8 + xx) << 1) | (yy & 1)); }
#endif
        PT1(6); PT0(7);
        xcd_barrier(bar);
        { size_t wz_ = 0; asm volatile("" : "+s"(wz_)); ws = F.ws + wz_; } asm volatile("" : "+s"(bx));
        PT1(7);
        PT0(8);
#ifndef SK_MERGE
        phase_merge_prep(F, l, Mrows);
#endif
        xcd_barrier(bar);
        { size_t wz_ = 0; asm volatile("" : "+s"(wz_)); ws = F.ws + wz_; } asm volatile("" : "+s"(bx));
        PT1(8);
        PT0(9);
        PT1(9); PT0(10);
        if (!last) { pg8::Sched S; S.init(ws + WS_Y3, 3072, 0, ws + WS_WBR, 3072, 0, Mrows, D, 1, F.G, bx, 192);
          pg8::EpiBranch<3> E{P, hA};
          pg8::gemm_phase<decltype(E), 3>(F.lds, 3072, 3072, 3072, S, E); }
        else { pg8::Sched S; S.init(ws + WS_Y3, 3072, 0, ws + WS_WBR, 3072, 0, Mrows, D, 1, F.G, bx);
          pg8::EpiBranch<4> E{P, hA};
          pg8::gemm_phase<decltype(E), 4>(F.lds, 3072, 3072, 3072, S, E); }
        xcd_barrier(bar);
        { size_t wz_ = 0; asm volatile("" : "+s"(wz_)); ws = F.ws + wz_; } asm volatile("" : "+s"(bx));
        PT1(10);
        PT0(12);
        if (!last) { pg8::Sched S; S.init(hA, D, 0, ws + WS_WOUT, D, 0, Mrows, D, 1, F.G, bx, 192);
          pg8::EpiResid<3> E{xres, mods_l + 2 * D};
          pg8::gemm_phase<decltype(E), 3>(F.lds, D, D, D, S, E); }
        else { pg8::Sched S; S.init(hA, D, 0, ws + WS_WOUT, D, 0, Mrows, D, 1, F.G, bx);
          pg8::EpiResid<4> E{xres, mods_l + 2 * D};
          pg8::gemm_phase<decltype(E), 4>(F.lds, D, D, D, S, E); }
        xcd_barrier(bar);
        { size_t wz_ = 0; asm volatile("" : "+s"(wz_)); ws = F.ws + wz_; } asm volatile("" : "+s"(bx));
        PT1(12);
        PT0(13);
        phase_norm<false>(F, xres, xres + (size_t)RL * D, nullptr, F.in[I_N2W] + l * D, mods_l, 3, hA, Mrows);
        xcd_barrier(bar);
        { size_t wz_ = 0; asm volatile("" : "+s"(wz_)); ws = F.ws + wz_; } asm volatile("" : "+s"(bx));
        PT1(13);
        PT0(14);
        { pg8::Sched S; S.init(hA, D, 0, ws + WS_WUP, D, 0, Mrows, NAV, 1, F.G, bx);
          pg8::EpiBf16 E{(bf16_t*)(ws + WS_AV), NAV};
#if !defined(SK_GEMM) && !defined(SK_GEMM6)
          pg8::gemm_phase<decltype(E), 4>(F.lds, D, D, D, S, E);
#endif
          }
        if (!last) { constexpr int TAIL = (R / 256 * (NAV / 256)) % 256;
          if (F.G == 256 && bx >= TAIL) phase_weights(F, l + 1, 0, bx - TAIL, 256 - TAIL); else if (F.G != 256) phase_weights(F, l + 1, 0, bx, F.G); }
        xcd_barrier(bar);
        { size_t wz_ = 0; asm volatile("" : "+s"(wz_)); ws = F.ws + wz_; } asm volatile("" : "+s"(bx));
        PT1(14);
        PT0(15);
#ifndef SK_CONV
        phase_convglu<0>(F, l, Mrows);
#if defined(CONV_ABL)
        phase_convglu<CONV_ABL>(F, l, Mrows);
#endif
#endif
        xcd_barrier(bar);
        { size_t wz_ = 0; asm volatile("" : "+s"(wz_)); ws = F.ws + wz_; } asm volatile("" : "+s"(bx));
        PT1(15);
        PT0(16);
        if (!last) { pg8::Sched S; S.init(ws + WS_G, DFF, 0, ws + WS_WDN, DFF, 0, Mrows, D, 1, F.G, bx, 192);
          pg8::EpiResid<3> E{xres, mods_l + 5 * D};
          pg8::gemm_phase<decltype(E), 3>(F.lds, DFF, DFF, DFF, S, E); }
        else { pg8::Sched S; S.init(ws + WS_G, DFF, 0, ws + WS_WDN, DFF, 0, Mrows, D, 1, F.G, bx);
          pg8::EpiResid<4> E{xres, mods_l + 5 * D};
          pg8::gemm_phase<decltype(E), 4>(F.lds, DFF, DFF, DFF, S, E); }
        xcd_barrier(bar);
        { size_t wz_ = 0; asm volatile("" : "+s"(wz_)); ws = F.ws + wz_; } asm volatile("" : "+s"(bx));
        PT1(16);
    }
    if (PROBE_MASK || PROBE_GDN) { const unsigned long long w0 = wall_clock64(); while (wall_clock64() - w0 < pacc * PROBE_MULT) __builtin_amdgcn_s_sleep(8); }
    phase_final_norm(F, xres, F.in[I_FINALW], F.out);
#undef mods
#undef xres
#undef hA
#undef P
#undef small
}

extern "C" void kernel_launch(void* const* d_in, const int* in_sizes, int n_in, void* d_out, int out_size, void* d_ws, size_t ws_size, hipStream_t stream) {
    static int grid = 0;
    if (grid == 0) {
        if (n_in != 26 || in_sizes[0] != RL * D || out_size != RL * D || ws_size < WS_END) { fprintf(stderr, "kernel_launch: unexpected shapes / workspace (%zu needed, %zu given)\n", (size_t)WS_END, ws_size); grid = -1; return; }
        int dev = 0, cus = 0, per_cu = 0;
        if (hipGetDevice(&dev) != hipSuccess || hipDeviceGetAttribute(&cus, hipDeviceAttributeMultiprocessorCount, dev) != hipSuccess) { grid = -1; return; }
        if (hipFuncSetAttribute((const void*)fwd, hipFuncAttributeMaxDynamicSharedMemorySize, LDS_BYTES) != hipSuccess) { fprintf(stderr, "kernel_launch: hipFuncSetAttribute failed\n"); grid = -1; return; }
        if (hipOccupancyMaxActiveBlocksPerMultiprocessor(&per_cu, (const void*)fwd, NTHR, LDS_BYTES) != hipSuccess || per_cu < 1) { fprintf(stderr, "kernel_launch: occupancy query says %d\n", per_cu); (void)hipGetLastError(); grid = -1; return; }
        grid = cus;
    }
    if (grid < 0) return;
    if (hipMemsetAsync((char*)d_ws + WS_CTL, 0, ZERO_BYTES, stream) != hipSuccess) return;
    Args a{};
    for (int i = 0; i < 26; ++i) a.in[i] = (const float*)d_in[i];
    a.out = (float*)d_out; a.ws = (unsigned char*)d_ws;
    hipLaunchKernelGGL(fwd, dim3(grid), dim3(NTHR), LDS_BYTES, stream, a);
}
```

```cpp
#include <hip/hip_runtime.h>
#include <cstdio>
#include <cstdint>

#define LAS __attribute__((address_space(3)))
#ifndef PROBE_GDN
#define PROBE_GDN 0
#endif
typedef unsigned short bf16_t;
typedef short bf16x8 __attribute__((ext_vector_type(8)));
typedef float f32x4 __attribute__((ext_vector_type(4)));
typedef unsigned u32x4 __attribute__((ext_vector_type(4)));
typedef unsigned u32x2 __attribute__((ext_vector_type(2)));

constexpr int D = 2048, NB = 8, SEQ = 2048, CTXL = 256, DEPTH = 4;
constexpr int RL = NB * SEQ, RC = NB * CTXL, R = RL + RC;
constexpr int NP = 14336, NIN = 14592, NIN_ORIG = 14400;
constexpr int DFF = 5632, NAV = 2 * DFF;
constexpr int PC_GLA_Q = 0, PC_GLA_K = 512, PC_GLA_V = 1024, PC_GLA_Z = 2048, PC_GDN_Q = 3072, PC_GDN_K = 4096, PC_GDN_V = 5120, PC_GDN_Z = 6144, PC_POOL = 7168, PC_GATE = 8192;
constexpr int NCH = 36;
constexpr float EPS = 1e-6f;
constexpr int NTHR = 512;

constexpr size_t al256(size_t x) { return (x + 255) & ~(size_t)255; }
constexpr size_t WS_CTL = 0;
constexpr size_t CTL_BYTES = 65536;
constexpr size_t WS_MODS = WS_CTL + CTL_BYTES;
constexpr size_t MODS_BYTES = (size_t)DEPTH * 9 * 12288 * 4;
constexpr size_t ZERO_BYTES = CTL_BYTES;
constexpr size_t WS_SMALL = al256(WS_MODS + MODS_BYTES);
constexpr size_t WS_XRES = al256(WS_SMALL + (size_t)R * 64 * 4);
constexpr size_t WS_HA = al256(WS_XRES + (size_t)R * D * 4);
constexpr size_t WS_WIN = al256(WS_HA + (size_t)R * D * 2);
constexpr size_t WS_WBR = al256(WS_WIN + (size_t)NIN * D * 2);
constexpr size_t WS_WOUT = al256(WS_WBR + (size_t)3 * D * 1024 * 2);
constexpr size_t WS_WUP = al256(WS_WOUT + (size_t)D * D * 2);
constexpr size_t WS_WDN = al256(WS_WUP + (size_t)NAV * D * 2);
constexpr size_t WS_WPOOL = al256(WS_WDN + (size_t)D * DFF * 2);
constexpr size_t WS_BIG = al256(WS_WPOOL + (size_t)4 * 256 * 256 * 2);
constexpr size_t WS_P = WS_BIG;
constexpr size_t WS_MODP = WS_BIG;
constexpr size_t GLA_UNIT = 66048, GDN_UNIT = 73984;
constexpr size_t WS_GLAPREP = al256(WS_P + (size_t)R * NP * 2);
constexpr size_t WS_GDNPREP = al256(WS_GLAPREP + (size_t)NB * NCH * 4 * 2 * GLA_UNIT);
constexpr size_t GDNPREP_BYTES = (size_t)NB * NCH * 8 * 2 * GDN_UNIT;
constexpr size_t WS_OGLA = al256(WS_GDNPREP + GDNPREP_BYTES);
constexpr size_t WS_OGDN = al256(WS_OGLA + (size_t)2 * R * 1024 * 2);
constexpr size_t WS_MIX_END = al256(WS_OGDN + (size_t)2 * R * 1024 * 2);
constexpr size_t WS_Y3 = WS_GDNPREP;
constexpr size_t WS_PLD = WS_Y3 + (size_t)R * 3072 * 2;
static_assert(WS_PLD + (size_t)R * 1024 * 2 <= WS_GDNPREP + GDNPREP_BYTES, "overlay");
constexpr size_t WS_AV = WS_BIG;
constexpr size_t WS_G = al256(WS_AV + (size_t)R * NAV * 2);
static_assert(WS_G + (size_t)R * DFF * 2 <= WS_MIX_END, "ffn overlay");
constexpr size_t WS_END = WS_MIX_END;

constexpr int LDS_BYTES = 131072 + 1024;
constexpr int MISC_OFF = 131072;

__device__ __forceinline__ float bf2f(bf16_t b) { return __uint_as_float(((unsigned)b) << 16); }
typedef float f32x2_t __attribute__((ext_vector_type(2)));
typedef __bf16 bf16x2_t __attribute__((ext_vector_type(2)));
__device__ __forceinline__ unsigned pk2(float lo, float hi) { const f32x2_t v = {lo, hi}; const bf16x2_t b = __builtin_convertvector(v, bf16x2_t); return __builtin_bit_cast(unsigned, b); }
__device__ __forceinline__ bf16_t f2bf(float f) { return (bf16_t)(pk2(f, 0.f) & 0xFFFFu); }
__device__ __forceinline__ float lo16(unsigned w) { return __uint_as_float(w << 16); }
__device__ __forceinline__ float hi16(unsigned w) { return __uint_as_float(w & 0xFFFF0000u); }
__device__ __forceinline__ float sigmoidf_(float x) { return __builtin_amdgcn_rcpf(1.0f + __expf(-x)); }
__device__ __forceinline__ float siluf_(float x) { return x * __builtin_amdgcn_rcpf(1.0f + __expf(-x)); }
__device__ __forceinline__ float softplusf_(float x) { return x > 20.f ? x : __logf(1.0f + __expf(x)); }
__device__ __forceinline__ float logsigf_(float z) { return fminf(z, 0.f) - __logf(1.0f + __expf(-fabsf(z))); }
__device__ __forceinline__ void unpack8(const u32x4 w, float (&f)[8]) { f[0] = lo16(w.x); f[1] = hi16(w.x); f[2] = lo16(w.y); f[3] = hi16(w.y); f[4] = lo16(w.z); f[5] = hi16(w.z); f[6] = lo16(w.w); f[7] = hi16(w.w); }
__device__ __forceinline__ u32x4 pack8(const float (&f)[8]) { u32x4 w; w.x = pk2(f[0], f[1]); w.y = pk2(f[2], f[3]); w.z = pk2(f[4], f[5]); w.w = pk2(f[6], f[7]); return w; }
typedef _Float16 h16x8_t __attribute__((ext_vector_type(8)));
typedef float f32x8_t __attribute__((ext_vector_type(8)));
__device__ __forceinline__ void unpack8h(const u32x4 w, float (&f)[8]) { const f32x8_t v = __builtin_convertvector(__builtin_bit_cast(h16x8_t, w), f32x8_t);
#pragma unroll
    for (int i = 0; i < 8; ++i) f[i] = v[i]; }
__device__ __forceinline__ u32x4 pack8h(const float (&f)[8]) { f32x8_t v;
#pragma unroll
    for (int i = 0; i < 8; ++i) v[i] = f[i];
    return __builtin_bit_cast(u32x4, __builtin_convertvector(v, h16x8_t)); }
__device__ __forceinline__ float shx(float v, int o, int lane) { return __int_as_float(__builtin_amdgcn_ds_bpermute((lane ^ o) << 2, __float_as_int(v))); }
__device__ __forceinline__ float shup(float v, int o, int lane) { return __int_as_float(__builtin_amdgcn_ds_bpermute((lane - o) << 2, __float_as_int(v))); }
__device__ __forceinline__ int frag_off(int row, int k, int KT) { return ((((row >> 4) * KT + (k >> 5)) << 9) + ((((k >> 3) & 3) << 4) + (row & 15)) * 8 + (k & 7)); }
__device__ __forceinline__ int frag_tile(int rb, int ks, int KT, int lane) { return (((rb * KT + ks) << 9) + lane * 8); }
#define MFMA16(a, b, c) __builtin_amdgcn_mfma_f32_16x16x32_bf16((a), (b), (c), 0, 0, 0)

#define XB_TMO      128
#define XB_XCNT(j)  (256  + 64 * (j))
#define XB_XSUB(j)  (1280 + 64 * (j))
#define XB_XGEN(j)  (2304 + 64 * (j))
#define XB_TOP      3328
#define XB_TOPGEN   3392
#define XCD_BAR_WORDS 3456
#define XB_SPIN_CAP (1u << 22)
__device__ __forceinline__ unsigned xb_ld(unsigned* p)              { return __hip_atomic_load(p, __ATOMIC_RELAXED, __HIP_MEMORY_SCOPE_AGENT); }
__device__ __forceinline__ unsigned xb_add(unsigned* p, unsigned v) { return __hip_atomic_fetch_add(p, v, __ATOMIC_RELAXED, __HIP_MEMORY_SCOPE_AGENT); }
__device__ __forceinline__ unsigned xb_xcc_id() { return (unsigned)__builtin_amdgcn_s_getreg((3 << 11) | 20) & 0xFu; }
#define XB_SPIN(cond, bar) do { unsigned _sp = 0; while (cond) { __builtin_amdgcn_s_sleep(1); \
    if ((++_sp & 255u) == 0u) { if (xb_ld(&(bar)[XB_TMO])) break; if (_sp > XB_SPIN_CAP) { atomicAdd(&(bar)[XB_TMO], 1u); break; } } } } while (0)
struct XcdBarrier { unsigned* bar; unsigned x; volatile LAS unsigned* st; };
__device__ __forceinline__ XcdBarrier xcd_barrier_post(unsigned* bar, volatile LAS unsigned* st) {
    XcdBarrier b; b.bar = bar; b.x = xb_xcc_id(); b.st = st;
    if (threadIdx.x == 0) (void)xb_add(&bar[XB_XCNT(b.x)], 1u);
    return b;
}
__device__ __forceinline__ void xcd_barrier_complete(unsigned* bar, unsigned x, unsigned& nloc, unsigned& nx) {
    const unsigned G = gridDim.x * gridDim.y * gridDim.z;
    unsigned sum, cnt, mine, sp = 0u;
    for (;;) {
        sum = 0u; cnt = 0u; mine = 0u;
#pragma unroll
        for (unsigned j = 0; j < 16; ++j) { const unsigned c = xb_ld(&bar[XB_XCNT(j)]); sum += c; cnt += (c > 0u) ? 1u : 0u; }
        mine = xb_ld(&bar[XB_XCNT(x)]);
        if (sum == G) break;
        __builtin_amdgcn_s_sleep(1);
        if ((++sp & 255u) == 0u) { if (xb_ld(&bar[XB_TMO])) break; if (sp > XB_SPIN_CAP) { atomicAdd(&bar[XB_TMO], 1u); break; } }
    }
    nloc = mine > 0u ? mine : 1u; nx = cnt > 0u ? cnt : 1u;
}
__device__ __forceinline__ void xcd_barrier(const XcdBarrier& b) {
    asm volatile("s_waitcnt vmcnt(0)" ::: "memory");
    __syncthreads();
    if (threadIdx.x == 0) {
        unsigned bz_ = 0; asm volatile("" : "+s"(bz_)); unsigned* bar = b.bar + bz_;
        __builtin_amdgcn_s_waitcnt(0);
        unsigned nloc = b.st[0], nx = b.st[1];
        if (nloc == 0u) { xcd_barrier_complete(bar, b.x, nloc, nx); b.st[0] = nloc; b.st[1] = nx; }
        const unsigned old = xb_add(&bar[XB_XSUB(b.x)], 1u);
        const unsigned gen = old / nloc;
        if (old + 1u == (gen + 1u) * nloc) {
            __builtin_amdgcn_fence(__ATOMIC_RELEASE, "agent");
            asm volatile("s_waitcnt vmcnt(0)" ::: "memory");
            const unsigned og = xb_add(&bar[XB_TOP], 1u);
            const unsigned tg = og / nx;
            if (og + 1u == (tg + 1u) * nx) xb_add(&bar[XB_TOPGEN], 1u);
            else XB_SPIN(xb_ld(&bar[XB_TOPGEN]) == tg, bar);
            __builtin_amdgcn_fence(__ATOMIC_ACQUIRE, "agent");
            xb_add(&bar[XB_XGEN(b.x)], 1u);
            asm volatile("s_waitcnt vmcnt(0)" ::: "memory");
        } else {
            XB_SPIN(xb_ld(&bar[XB_XGEN(b.x)]) == gen, bar);
            __builtin_amdgcn_fence(__ATOMIC_ACQUIRE, "agent");
            asm volatile("s_waitcnt vmcnt(0)" ::: "memory");
        }
    }
    __syncthreads();
}

namespace pg8 {
constexpr int BM = 256, BK = 64, HALF = 128, HTB = HALF * BK * 2, STAGE_BYTES = 8 * HTB, NXCD = 8, WGM = 8;
__device__ __forceinline__ int lds_byte(int r, int c) { const int st = (r >> 4) * 2 + (c >> 5), rr = r & 15, cc = c & 31, ob = rr * 64 + cc * 2; return st * 1024 + (ob ^ (((ob >> 9) & 1) << 5)); }
__device__ __forceinline__ void stage_rc(int b, int& R_, int& C_) { const int st = b / 1024, sb = b % 1024, swz = sb ^ (((sb >> 9) & 1) << 5); R_ = (st >> 1) * 16 + swz / 64; C_ = (st & 1) * 32 + (swz % 64) / 2; }
__device__ __forceinline__ int perm32(int rho) { const int n = rho >> 4, i = rho & 15; return 8 * (i >> 2) + 4 * n + (i & 3); }
struct Unit { int pm, pn, z; const char* a; const char* b; };
struct Sched {
    int nM, nN, nZ, per, G, c, xtra, xpm0; const char* A; const char* B; size_t sA, sB, zA, zB;
    __device__ __forceinline__ void init(const void* A_, int lda, size_t zA_, const void* B_, int ldb, size_t zB_, int M, int N, int nZ_, int G_, int c_, int bm = BM) {
        nM = M / bm; nN = N / BM; nZ = nZ_; per = nM * nN; G = G_; c = c_; xtra = 0; xpm0 = 0; A = (const char*)A_; B = (const char*)B_; sA = (size_t)bm * lda * 2; sB = (size_t)BM * ldb * 2; zA = zA_; zB = zB_; }
    __device__ __forceinline__ bool next(int i, Unit& u) const {
        const long L = (long)i * G + c; if (L >= (long)per * nZ + xtra) return false;
        if (L >= (long)per * nZ) { const int e = (int)(L - (long)per * nZ), idx = e % 15;
            u.pm = xpm0 + e / 15; u.pn = idx < 6 ? 2 + idx : (idx < 14 ? 10 + idx : 56); u.z = 0;
            u.a = A + (size_t)u.pm * sA; u.b = B + (size_t)u.pn * sB; return true; }
        const int z = (int)(L / per); int wgid = (int)(L % per);
        { const int q = per / NXCD, r = per % NXCD, xcd = wgid % NXCD, off = wgid / NXCD; wgid = (xcd < r ? xcd * (q + 1) : r * (q + 1) + (xcd - r) * q) + off; }
        const int nig = WGM * nN, gid = wgid / nig, fm = gid * WGM, gsz = (nM - fm) < WGM ? (nM - fm) : WGM;
        u.pm = fm + ((wgid % nig) % gsz); u.pn = (wgid % nig) / gsz; u.z = z;
        u.a = A + (size_t)z * zA + (size_t)u.pm * sA; u.b = B + (size_t)z * zB + (size_t)u.pn * sB; return true;
    }
};
__device__ __forceinline__ unsigned cvt_pk_bf16(float lo, float hi) { return pk2(lo, hi); }
__device__ __forceinline__ u32x4 pack_acc(const f32x4 v0, const f32x4 v1) { u32x4 w; w.x = cvt_pk_bf16(v0[0], v0[1]); w.y = cvt_pk_bf16(v0[2], v0[3]); w.z = cvt_pk_bf16(v1[0], v1[1]); w.w = cvt_pk_bf16(v1[2], v1[3]); return w; }

template <class E, class = void> struct has_rescale { static constexpr bool value = false; };
template <class E> struct has_rescale<E, decltype((void)E::HAS_RESCALE)> { static constexpr bool value = true; };
template <class Epi, int MT>
__device__ __forceinline__ void gemm_phase(LAS unsigned char* lds, const int K, const int lda, const int ldb, const Sched& S, const Epi& E) {
    int tid = threadIdx.x; asm volatile("" : "+v"(tid));
    const int wid = __builtin_amdgcn_readfirstlane(tid >> 6), lane = tid & 63, wr = wid >> 2, wc = wid & 3, fr = lane & 15, fq = lane >> 4;
    const int nt = K / BK; constexpr int HA = MT * 32;
    unsigned voffA[2], voffB[2];
#pragma unroll
    for (int i = 0; i < 2; ++i) { int R_, C_; stage_rc(tid * 16 + i * 8192, R_, C_); const int Rb = (R_ & ~31) + perm32(R_ & 31);
        const int Ra = R_ < HA ? R_ : HA - 1;
        voffA[i] = (unsigned)(Ra * lda + C_) * 2u; voffB[i] = (unsigned)(Rb * ldb + C_) * 2u; }
    const size_t kstep = (size_t)(BK * 2);
    const size_t hstepA = (size_t)HA * lda * 2, hstepB = (size_t)HALF * ldb * 2;
    const unsigned ldsw = (unsigned)wid * 1024u;
    const int aoff = lds_byte(wr * (MT * 16) + fr, fq * 8), boff = lds_byte(wc * 32 + fr, fq * 8);
#define PG8_SA(b, h) (((b) * 2 + (h)) * HTB)
#define PG8_SB(b, h) ((4 + (b) * 2 + (h)) * HTB)
#define PG8_STAGE(bufoff, gbase, voff) do { _Pragma("unroll") for (int _i = 0; _i < 2; ++_i) \
        __builtin_amdgcn_global_load_lds((const unsigned*)((const char*)(gbase) + (voff)[_i]), (LAS unsigned*)(lds + (bufoff) + ldsw + _i * 8192), 16, 0, 0); } while (0)
#define PG8_STAGE_A(bufoff, gbase) do { __builtin_amdgcn_global_load_lds((const unsigned*)((const char*)(gbase) + voffA[0]), (LAS unsigned*)(lds + (bufoff) + ldsw), 16, 0, 0); \
        if (!(MT == 3 && wr == 1)) __builtin_amdgcn_global_load_lds((const unsigned*)((const char*)(gbase) + voffA[1]), (LAS unsigned*)(lds + (bufoff) + ldsw + 8192), 16, 0, 0); } while (0)
#define PG8_WAIT_VX(full, half) do { if (MT == 3 && wr == 1) asm volatile("s_waitcnt vmcnt(" #half ")" ::: "memory"); else asm volatile("s_waitcnt vmcnt(" #full ")" ::: "memory"); } while (0)
#define PG8_LDA(dst, b, h) do { _Pragma("unroll") for (int m = 0; m < MT; ++m) _Pragma("unroll") for (int k = 0; k < 2; ++k) dst[m][k] = *(const LAS bf16x8*)(lds + PG8_SA(b, h) + aoff + m * 2048 + k * 1024); } while (0)
#define PG8_LDB(dst, b, h) do { _Pragma("unroll") for (int n = 0; n < 2; ++n) _Pragma("unroll") for (int k = 0; k < 2; ++k) dst[n][k] = *(const LAS bf16x8*)(lds + PG8_SB(b, h) + boff + n * 2048 + k * 1024); } while (0)
#define PG8_MMA(ai, bj, At, Bt) do { __builtin_amdgcn_s_setprio(1); _Pragma("unroll") for (int m = 0; m < MT; ++m) _Pragma("unroll") for (int n = 0; n < 2; ++n) _Pragma("unroll") for (int k = 0; k < 2; ++k) \
        acc[ai][bj][m][n] = __builtin_amdgcn_mfma_f32_16x16x32_bf16(Bt[n][k], At[m][k], acc[ai][bj][m][n], 0, 0, 0); __builtin_amdgcn_s_setprio(0); } while (0)
#define PG8_WAIT_V(n) asm volatile("s_waitcnt vmcnt(" #n ")" ::: "memory")
#define PG8_WAIT_L(n) asm volatile("s_waitcnt lgkmcnt(" #n ")" ::: "memory")
#define PG8_BAR __builtin_amdgcn_s_barrier()
#define PG8_SCHED __builtin_amdgcn_sched_barrier(0)
    Unit cur, nxt; int ui = 0;
    if (!S.next(0, cur)) return;
    f32x4 acc[2][2][MT][2];
#pragma unroll
    for (int a = 0; a < 2; ++a)
#pragma unroll
        for (int b = 0; b < 2; ++b)
#pragma unroll
            for (int m = 0; m < MT; ++m)
#pragma unroll
                for (int n = 0; n < 2; ++n) acc[a][b][m][n] = (f32x4){0.f, 0.f, 0.f, 0.f};
    bf16x8 At[MT][2], B0[2][2], B1[2][2];
    const char* cA = cur.a; const char* cB = cur.b;
    PG8_STAGE(PG8_SB(0, 0), cB, voffB); PG8_STAGE(PG8_SB(0, 1), cB + hstepB, voffB); PG8_STAGE_A(PG8_SA(0, 0), cA); PG8_STAGE_A(PG8_SA(0, 1), cA + hstepA);
    if (wr == 1) PG8_BAR;
    PG8_WAIT_VX(2, 1); PG8_BAR;
    PG8_STAGE(PG8_SB(1, 0), cB + kstep, voffB); PG8_STAGE_A(PG8_SA(1, 0), cA + kstep); PG8_STAGE(PG8_SB(1, 1), cB + hstepB + kstep, voffB);
    PG8_WAIT_VX(6, 5); PG8_BAR;
    for (;;) {
        const bool has_next = S.next(ui + 1, nxt);
        const char* nA = has_next ? nxt.a : cA; const char* nB = has_next ? nxt.b : cB;
#pragma unroll 1
        for (int t = 0; t < nt; t += 2) {
            const bool last = (t == nt - 2);
            if constexpr (has_rescale<Epi>::value) { if (t == 16 || t == 32) E.rescale(acc, cur, wr, wc, fr, fq, (t >> 4) - 1); }
            const char* a1 = cA + (size_t)(t + 1) * kstep;
            const char* a2 = last ? nA : cA + (size_t)(t + 2) * kstep; const char* b2 = last ? nB : cB + (size_t)(t + 2) * kstep;
            const char* a3 = a2 + kstep; const char* b3 = b2 + kstep;
            PG8_LDB(B0, 0, 0); PG8_LDB(B1, 0, 1); PG8_SCHED; PG8_LDA(At, 0, 0); PG8_STAGE_A(PG8_SA(1, 1), a1 + hstepA);
            PG8_WAIT_VX(8, 6); PG8_WAIT_L(0); PG8_BAR; PG8_MMA(0, 0, At, B0); PG8_MMA(0, 1, At, B1); PG8_BAR; PG8_SCHED;
            PG8_LDA(At, 0, 1); PG8_STAGE(PG8_SB(0, 0), b2, voffB); PG8_STAGE(PG8_SB(0, 1), b2 + hstepB, voffB); PG8_STAGE_A(PG8_SA(0, 0), a2);
            PG8_WAIT_VX(8, 6); PG8_WAIT_L(0); PG8_BAR; PG8_MMA(1, 0, At, B0); PG8_MMA(1, 1, At, B1); PG8_BAR; PG8_SCHED;
            PG8_LDB(B0, 1, 0); PG8_LDB(B1, 1, 1); PG8_SCHED; PG8_LDA(At, 1, 0); PG8_STAGE_A(PG8_SA(0, 1), a2 + hstepA);
            PG8_WAIT_VX(8, 6); PG8_WAIT_L(0); PG8_BAR; PG8_MMA(0, 0, At, B0); PG8_MMA(0, 1, At, B1); PG8_BAR; PG8_SCHED;
            PG8_LDA(At, 1, 1); PG8_STAGE(PG8_SB(1, 0), b3, voffB); PG8_STAGE(PG8_SB(1, 1), b3 + hstepB, voffB); PG8_STAGE_A(PG8_SA(1, 0), a3);
            PG8_WAIT_VX(8, 6); PG8_WAIT_L(0); PG8_BAR; PG8_MMA(1, 0, At, B0); PG8_MMA(1, 1, At, B1); PG8_BAR; PG8_SCHED;
        }
        if (wr == 0) PG8_BAR;
        E(acc, cur, wr, wc, fr, fq);
        if (!has_next) break;
        { float zz = 0.f; asm volatile("" : "+v"(zz));
#pragma unroll
        for (int a = 0; a < 2; ++a)
#pragma unroll
            for (int b = 0; b < 2; ++b)
#pragma unroll
                for (int m = 0; m < MT; ++m)
#pragma unroll
                    for (int n = 0; n < 2; ++n) acc[a][b][m][n] = (f32x4){zz, zz, zz, zz}; }
        cur = nxt; cA = nA; cB = nB; ++ui;
        if (wr == 1) PG8_BAR;
    }
    PG8_WAIT_V(0);
    PG8_BAR;
#undef PG8_SA
#undef PG8_SB
#undef PG8_STAGE
#undef PG8_STAGE_A
#undef PG8_WAIT_VX
#undef PG8_LDA
#undef PG8_LDB
#undef PG8_MMA
#undef PG8_WAIT_V
#undef PG8_WAIT_L
#undef PG8_BAR
#undef PG8_SCHED
}

struct EpiInProj {
    bf16_t* P; float* small;
    __device__ __forceinline__ void operator()(const f32x4 (&acc)[2][2][4][2], const Unit& u, int wr, int wc, int fr, int fq) const {
        const int row0 = u.pm * BM + wr * 64 + fr;
        if (u.pn < 56) {
            const int col0 = u.pn * BM + wc * 32 + 8 * fq;
#pragma unroll
            for (int ai = 0; ai < 2; ++ai)
#pragma unroll
                for (int m = 0; m < 4; ++m) { bf16_t* rowp = P + (size_t)(row0 + ai * HALF + m * 16) * NP + col0;
#pragma unroll
                    for (int bj = 0; bj < 2; ++bj) *(u32x4*)(rowp + bj * HALF) = pack_acc(acc[ai][bj][m][0], acc[ai][bj][m][1]); }
        } else if (wc < 2) {
            const int col0 = wc * 32 + 8 * fq;
#pragma unroll
            for (int ai = 0; ai < 2; ++ai)
#pragma unroll
                for (int m = 0; m < 4; ++m) { float* rowp = small + (size_t)(row0 + ai * HALF + m * 16) * 64 + col0;
                    *(f32x4*)rowp = acc[ai][0][m][0]; *(f32x4*)(rowp + 4) = acc[ai][0][m][1]; }
        }
    }
};
struct EpiBf16 {
    bf16_t* O; int ldc;
    __device__ __forceinline__ void operator()(const f32x4 (&acc)[2][2][4][2], const Unit& u, int wr, int wc, int fr, int fq) const {
        const int row0 = u.pm * BM + wr * 64 + fr, col0 = u.pn * BM + wc * 32 + 8 * fq;
#pragma unroll
        for (int ai = 0; ai < 2; ++ai)
#pragma unroll
            for (int m = 0; m < 4; ++m) { bf16_t* rowp = O + (size_t)(row0 + ai * HALF + m * 16) * ldc + col0;
#pragma unroll
                for (int bj = 0; bj < 2; ++bj) *(u32x4*)(rowp + bj * HALF) = pack_acc(acc[ai][bj][m][0], acc[ai][bj][m][1]); }
    }
};
struct EpiPool {
    bf16_t* O; const float* scale;
    __device__ __forceinline__ void operator()(const f32x4 (&acc)[2][2][4][2], const Unit& u, int wr, int wc, int fr, int fq) const {
        const int row0 = u.pm * BM + wr * 64 + fr, col0 = u.z * 256 + wc * 32 + 8 * fq;
        f32x4 sv[2][2];
#pragma unroll
        for (int bj = 0; bj < 2; ++bj) { sv[bj][0] = *(const f32x4*)(scale + col0 + bj * HALF); sv[bj][1] = *(const f32x4*)(scale + col0 + bj * HALF + 4); }
#pragma unroll
        for (int ai = 0; ai < 2; ++ai)
#pragma unroll
            for (int m = 0; m < 4; ++m) { bf16_t* rowp = O + (size_t)(row0 + ai * HALF + m * 16) * 3072 + col0;
#pragma unroll
                for (int bj = 0; bj < 2; ++bj) *(u32x4*)(rowp + bj * HALF) = pack_acc(acc[ai][bj][m][0] * sv[bj][0], acc[ai][bj][m][1] * sv[bj][1]); }
    }
};
template <int MT> struct EpiBranch {
    static constexpr bool HAS_RESCALE = true;
    const bf16_t* P; bf16_t* mbf;
    __device__ __forceinline__ void rescale(f32x4 (&acc)[2][2][MT][2], const Unit& u, int wr, int wc, int fr, int fq, int seg) const {
        int row0 = u.pm * (MT * 64) + wr * (MT * 16) + fr, col0 = u.pn * BM + wc * 32 + 8 * fq;
        asm volatile("" : "+v"(row0), "+v"(col0));
#pragma unroll
        for (int ai = 0; ai < 2; ++ai) {
            u32x4 ra[MT][2], rb[MT][2];
#pragma unroll
            for (int m = 0; m < MT; ++m)
#pragma unroll
                for (int bj = 0; bj < 2; ++bj) { const bf16_t* gp = P + (size_t)(row0 + ai * (MT * 32) + m * 16) * NP + PC_GATE + seg * 2048 + col0 + bj * HALF;
                    ra[m][bj] = *(const u32x4*)gp; rb[m][bj] = *(const u32x4*)(gp + 2048); }
            __builtin_amdgcn_sched_barrier(0);
#pragma unroll
            for (int m = 0; m < MT; ++m)
#pragma unroll
                for (int bj = 0; bj < 2; ++bj) { float ga[8], gb[8]; unpack8(ra[m][bj], ga); unpack8(rb[m][bj], gb);
#pragma unroll
                    for (int j = 0; j < 4; ++j) { acc[ai][bj][m][0][j] *= (1.0f + __expf(-gb[j])) * __builtin_amdgcn_rcpf(1.0f + __expf(-ga[j]));
                        acc[ai][bj][m][1][j] *= (1.0f + __expf(-gb[4 + j])) * __builtin_amdgcn_rcpf(1.0f + __expf(-ga[4 + j])); } }
            __builtin_amdgcn_sched_barrier(0); }
    }
    __device__ __forceinline__ void operator()(const f32x4 (&acc)[2][2][MT][2], const Unit& u, int wr, int wc, int fr, int fq) const {
        const int row0 = u.pm * (MT * 64) + wr * (MT * 16) + fr, col0 = u.pn * BM + wc * 32 + 8 * fq;
#pragma unroll
        for (int ai = 0; ai < 2; ++ai) {
            u32x4 gr[MT][2];
#pragma unroll
            for (int m = 0; m < MT; ++m)
#pragma unroll
                for (int bj = 0; bj < 2; ++bj) gr[m][bj] = *(const u32x4*)(P + (size_t)(row0 + ai * (MT * 32) + m * 16) * NP + PC_GATE + 2 * 2048 + col0 + bj * HALF);
            __builtin_amdgcn_sched_barrier(0);
#pragma unroll
            for (int m = 0; m < MT; ++m) { const size_t row = (size_t)(row0 + ai * (MT * 32) + m * 16);
#pragma unroll
                for (int bj = 0; bj < 2; ++bj) { const int col = col0 + bj * HALF;
                    float g[8]; unpack8(gr[m][bj], g);
                    f32x4 v0 = acc[ai][bj][m][0], v1 = acc[ai][bj][m][1];
#pragma unroll
                    for (int j = 0; j < 4; ++j) { v0[j] *= sigmoidf_(g[j]); v1[j] *= sigmoidf_(g[4 + j]); }
                    *(u32x4*)(mbf + row * D + col) = pack_acc(v0, v1); } }
            __builtin_amdgcn_sched_barrier(0); }
    }
};
template <int MT> struct EpiResid {
    bf16_t* X; const float* gates;
    __device__ __forceinline__ void operator()(const f32x4 (&acc)[2][2][MT][2], const Unit& u, int wr, int wc, int fr, int fq) const {
        const int row0 = u.pm * (MT * 64) + wr * (MT * 16) + fr, col0 = u.pn * BM + wc * 32 + 8 * fq;
#pragma unroll
        for (int ai = 0; ai < 2; ++ai)
#pragma unroll
            for (int mp = 0; mp < MT; mp += 2) {
                u32x4 xv[2][2]; f32x4 gv[2][2][2];
#pragma unroll
                for (int q = 0; q < 2; ++q) if (mp + q < MT) { const int row = row0 + ai * (MT * 32) + (mp + q) * 16; const int j = row < RL ? (row >> 11) : 8;
                    const float* gp = gates + (size_t)j * 12288 + col0; const bf16_t* rowp = X + (size_t)row * D + col0;
#pragma unroll
                    for (int bj = 0; bj < 2; ++bj) { xv[q][bj] = *(const u32x4*)(rowp + bj * HALF);
                        gv[q][bj][0] = *(const f32x4*)(gp + bj * HALF); gv[q][bj][1] = *(const f32x4*)(gp + bj * HALF + 4); } }
                __builtin_amdgcn_sched_barrier(0);
#pragma unroll
                for (int q = 0; q < 2; ++q) if (mp + q < MT) { const int row = row0 + ai * (MT * 32) + (mp + q) * 16; bf16_t* rowp = X + (size_t)row * D + col0;
#pragma unroll
                    for (int bj = 0; bj < 2; ++bj) { float xf[8]; unpack8h(xv[q][bj], xf);
#pragma unroll
                        for (int e = 0; e < 4; ++e) { xf[e] += gv[q][bj][0][e] * acc[ai][bj][mp + q][0][e]; xf[4 + e] += gv[q][bj][1][e] * acc[ai][bj][mp + q][1][e]; }
                        *(u32x4*)(rowp + bj * HALF) = pack8h(xf); } }
                __builtin_amdgcn_sched_barrier(0); }
    }
};
}

struct Args { const float* in[26]; float* out; unsigned char* ws; };
struct Frame {
    LAS unsigned char* lds; unsigned char* ws; const float* const* in; float* out;
    int tid, lane, wave, G, bx;
};
enum { I_X = 0, I_C, I_CTX, I_CCTX, I_ADAW, I_ADAB, I_N1W, I_N2W, I_WIN, I_LRW2, I_LRB, I_GLANW, I_CONVW, I_ALOG, I_DTB, I_GDNNW, I_POOLW, I_POOLS, I_WBRGLA, I_WBRGDN, I_WBRPOOL, I_WOUT, I_FFNUP, I_FFNCONV, I_FFNDOWN, I_FINALW };

__device__ __forceinline__ void phase_mods(const Frame& F) {
    int tid = F.tid; asm volatile("" : "+v"(tid));
    size_t wz_ = 0; asm volatile("" : "+s"(wz_)); unsigned char* wsl = F.ws + wz_;
    int bxl = F.bx; asm volatile("" : "+s"(bxl)); (void)bxl;
    const int lane = tid & 63, wave = __builtin_amdgcn_readfirstlane(tid >> 6); (void)lane; (void)wave;
    LAS float* sc = (LAS float*)F.lds;
    const float* c = F.in[I_C]; const float* cc = F.in[I_CCTX]; const float* aw = F.in[I_ADAW];
    float* part = (float*)(wsl + WS_MODP);
    for (int u = bxl; u < DEPTH * 24 * 8; u += F.G) {
        const int ks = u % 8, cb = (u / 8) % 24, l = u / 192;
        __syncthreads();
        for (int i = tid; i < 9 * 256; i += NTHR) { const int j = i / 256, k = i % 256; const float cv = (j < 8) ? c[j * D + ks * 256 + k] : cc[ks * 256 + k]; sc[i] = siluf_(cv); }
        __syncthreads();
        const int c4 = (tid & 127) * 4, kq = tid >> 7;
        const float* w = aw + ((size_t)l * D + ks * 256 + kq * 64) * 12288 + cb * 512 + c4;
        f32x4 acc[9];
#pragma unroll
        for (int j = 0; j < 9; ++j) acc[j] = (f32x4){0.f, 0.f, 0.f, 0.f};
#pragma unroll 1
        for (int k0 = 0; k0 < 64; k0 += 8) { f32x4 wv[8];
#pragma unroll
            for (int q = 0; q < 8; ++q) wv[q] = *(const f32x4*)(w + (size_t)(k0 + q) * 12288);
#pragma unroll
            for (int j = 0; j < 9; ++j) { const f32x4 s0 = *(const LAS f32x4*)(sc + j * 256 + kq * 64 + k0), s1 = *(const LAS f32x4*)(sc + j * 256 + kq * 64 + k0 + 4);
#pragma unroll
                for (int q = 0; q < 4; ++q) { acc[j] += wv[q] * s0[q]; acc[j] += wv[4 + q] * s1[q]; } } }
        LAS float* red = (LAS float*)(F.lds + 16384);
#pragma unroll
        for (int j = 0; j < 9; ++j) *(LAS f32x4*)(red + (kq * 9 + j) * 512 + c4) = acc[j];
        __syncthreads();
#pragma unroll
        for (int j = 0; j < 9; ++j) { const float v = (red[(0 * 9 + j) * 512 + tid] + red[(1 * 9 + j) * 512 + tid]) + (red[(2 * 9 + j) * 512 + tid] + red[(3 * 9 + j) * 512 + tid]);
            part[(size_t)ks * (DEPTH * 9 * 12288) + ((size_t)l * 9 + j) * 12288 + cb * 512 + tid] = v; }
    }
    __syncthreads();
}
__device__ __forceinline__ void phase_mods_reduce(const Frame& F) {
    int tid = F.tid; asm volatile("" : "+v"(tid));
    size_t wz_ = 0; asm volatile("" : "+s"(wz_)); unsigned char* wsl = F.ws + wz_;
    int bxl = F.bx; asm volatile("" : "+s"(bxl));
    const float* part = (const float*)(wsl + WS_MODP); float* mods = (float*)(wsl + WS_MODS); const float* ab = F.in[I_ADAB];
    for (int i = bxl * NTHR + tid; i < DEPTH * 9 * 12288; i += F.G * NTHR) {
        const int l = i / (9 * 12288), col = i % 12288;
        float pv[8];
#pragma unroll
        for (int ks = 0; ks < 8; ++ks) pv[ks] = part[(size_t)ks * (DEPTH * 9 * 12288) + i];
        float s = ab[l * 12288 + col];
        __builtin_amdgcn_sched_barrier(0);
#pragma unroll
        for (int ks = 0; ks < 8; ++ks) s += pv[ks];
        mods[i] = s; }
}

__device__ __forceinline__ int map_in_col(int n) {
    if (n < 3072) return n;
    if (n < 3104) return NP + (n - 3072);
    if (n < 6176) return n - 32;
    if (n < 6192) return NP + 32 + (n - 6176);
    if (n < 6208) return NP + 48 + (n - 6192);
    return n - 64;
}
__device__ __forceinline__ void wtile4(const Frame& F, const float* src, int N, bf16_t* dst, int K, int kt, int nt0, int cnt, bool perm_in) {
    int tid = F.tid; asm volatile("" : "+v"(tid));
    LAS float* t = (LAS float*)F.lds;
    const int kk = tid >> 3, seg = (tid & 7) * 8;
    const float* s0 = src + (size_t)(kt * 64 + kk) * N + nt0 * 64 + seg;
    f32x4 v0[4], v1[4];
#pragma unroll
    for (int q = 0; q < 4; ++q) if (q < cnt) { v0[q] = *(const f32x4*)(s0 + q * 64); v1[q] = *(const f32x4*)(s0 + q * 64 + 4); }
    __syncthreads();
#pragma unroll
    for (int q = 0; q < 4; ++q) if (q < cnt) {
#pragma unroll
        for (int i = 0; i < 4; ++i) { t[q * 4160 + kk * 65 + seg + i] = v0[q][i]; t[q * 4160 + kk * 65 + seg + 4 + i] = v1[q][i]; } }
    __syncthreads();
    const int nn = tid >> 3, kseg = (tid & 7) * 8;
#pragma unroll
    for (int q = 0; q < 4; ++q) if (q < cnt) { float f[8];
#pragma unroll
        for (int i = 0; i < 8; ++i) f[i] = t[q * 4160 + (kseg + i) * 65 + nn];
        const int n = (nt0 + q) * 64 + nn, np = perm_in ? map_in_col(n) : n;
        *(u32x4*)(dst + (size_t)np * K + kt * 64 + kseg) = pack8(f); }
}
__device__ __forceinline__ void wfold_pool(const Frame& F, int l, int g, int nt, bf16_t* Wbr) {
    int tid = F.tid; asm volatile("" : "+v"(tid));
    const int lane = tid & 63, w = __builtin_amdgcn_readfirstlane(tid >> 6), fr = lane & 15, fq = lane >> 4;
    LAS bf16_t* Bt = (LAS bf16_t*)F.lds;
    const float* wp = F.in[I_WBRPOOL] + (size_t)l * 1024 * D + (size_t)(g * 256) * D + nt * 64;
    const float* pw = F.in[I_POOLW] + ((size_t)l * 4 + g) * 65536;
    const int d = tid >> 1, hf = (tid & 1) * 32;
    f32x4 v[8];
#pragma unroll
    for (int q = 0; q < 8; ++q) v[q] = *(const f32x4*)(wp + (size_t)d * D + hf + q * 4);
    const float sc = F.in[I_POOLS][l * 1024 + g * 256 + d];
    __syncthreads();
#pragma unroll
    for (int q = 0; q < 8; ++q)
#pragma unroll
        for (int i = 0; i < 4; ++i) Bt[(hf + q * 4 + i) * 264 + d] = f2bf(v[q][i] * sc);
    __syncthreads();
#pragma unroll 1
    for (int cbi = 0; cbi < 2; ++cbi) { const int cb = w * 2 + cbi;
        f32x4 a0[8], a1[8];
#pragma unroll
        for (int ks = 0; ks < 8; ++ks) { const float* ap = pw + (size_t)(cb * 16 + fr) * 256 + ks * 32 + fq * 8; a0[ks] = *(const f32x4*)ap; a1[ks] = *(const f32x4*)(ap + 4); }
        bf16x8 af[8];
#pragma unroll
        for (int ks = 0; ks < 8; ++ks) { u32x4 pk; pk.x = pk2(a0[ks][0], a0[ks][1]); pk.y = pk2(a0[ks][2], a0[ks][3]); pk.z = pk2(a1[ks][0], a1[ks][1]); pk.w = pk2(a1[ks][2], a1[ks][3]); af[ks] = __builtin_bit_cast(bf16x8, pk); }
#pragma unroll
        for (int nb = 0; nb < 4; ++nb) { f32x4 acc = (f32x4){0.f, 0.f, 0.f, 0.f};
#pragma unroll
            for (int ks = 0; ks < 8; ++ks) { const bf16x8 bfr = *(const LAS bf16x8*)(Bt + (nb * 16 + fr) * 264 + ks * 32 + fq * 8); acc = MFMA16(af[ks], bfr, acc); }
            u32x2 ov; ov.x = pk2(acc[0], acc[1]); ov.y = pk2(acc[2], acc[3]);
            *(u32x2*)(Wbr + (size_t)(nt * 64 + nb * 16 + fr) * 3072 + 2048 + g * 256 + cb * 16 + 4 * fq) = ov; } }
}
__device__ __forceinline__ void phase_weights(const Frame& F, int l, int set, int r, int n) {
    int tid = F.tid; asm volatile("" : "+v"(tid));
    size_t wz_ = 0; asm volatile("" : "+s"(wz_)); unsigned char* wsl = F.ws + wz_;
    asm volatile("" : "+s"(r));
    bf16_t* Win = (bf16_t*)(wsl + WS_WIN); bf16_t* Wbr = (bf16_t*)(wsl + WS_WBR); bf16_t* Wout = (bf16_t*)(wsl + WS_WOUT);
    bf16_t* Wup = (bf16_t*)(wsl + WS_WUP); bf16_t* Wdn = (bf16_t*)(wsl + WS_WDN);
    constexpr int G_IN = 32 * 57, G_BR = 16 * 8, G_OUT = 32 * 8, G_UP = 32 * 44, G_DN = 88 * 8;
    constexpr int O_BR = G_IN, O_OUT = O_BR + 3 * G_BR, O_UP = O_OUT + G_OUT, O_DN = O_UP + G_UP, G_ALL = O_DN + G_DN;
    const int lo = set ? O_UP : 0, hi = set ? G_ALL : O_UP;
    for (int u = lo + r; u < hi; u += n) {
        if (u < O_BR) { const int kt = u / 57, g4 = u % 57; wtile4(F, F.in[I_WIN] + (size_t)l * D * NIN_ORIG, NIN_ORIG, Win, D, kt, g4 * 4, g4 < 56 ? 4 : 1, true); }
        else if (u < O_BR + 2 * G_BR) { const int v = u - O_BR, br = v / G_BR, w = v % G_BR; wtile4(F, F.in[I_WBRGLA + br] + (size_t)l * 1024 * D, D, Wbr + br * 1024, 3072, w / 8, (w % 8) * 4, 4, false); }
        else if (u < O_OUT) { const int v = u - O_BR - 2 * G_BR; wfold_pool(F, l, v >> 5, v & 31, Wbr); }
        else if (u < O_UP) { const int v = u - O_OUT; wtile4(F, F.in[I_WOUT] + (size_t)l * D * D, D, Wout, D, v / 8, (v % 8) * 4, 4, false); }
        else if (u < O_DN) { const int v = u - O_UP; wtile4(F, F.in[I_FFNUP] + (size_t)l * D * NAV, NAV, Wup, D, v / 44, (v % 44) * 4, 4, false); }
        else { const int v = u - O_DN; wtile4(F, F.in[I_FFNDOWN] + (size_t)l * DFF * D, D, Wdn, DFF, v / 8, (v % 8) * 4, 4, false); }
    }
    if (set == 0) {
      u32x4* z = (u32x4*)(Win + (size_t)NIN_ORIG * D); const int n16 = (NIN - NIN_ORIG) * D * 2 / 16;
      unsigned zz = 0u; asm volatile("" : "+v"(zz));
      for (int i = r * NTHR + tid; i < n16; i += n * NTHR) z[i] = (u32x4){zz, zz, zz, zz}; }
    __syncthreads();
}

template <bool IN32> __device__ __forceinline__ void phase_norm(const Frame& F, const void* xl_, const void* xc_, bf16_t* xcopy, const float* nw, const float* mods_l, int sh, bf16_t* out, int nrows) {
    int tid = F.tid; asm volatile("" : "+v"(tid));
    size_t wz_ = 0; asm volatile("" : "+s"(wz_)); unsigned char* wsl = F.ws + wz_;
    int bxl = F.bx; asm volatile("" : "+s"(bxl)); (void)bxl; (void)wsl;
    const int lane = tid & 63, wave = __builtin_amdgcn_readfirstlane(tid >> 6);
    f32x4 wv[8];
#pragma unroll
    for (int i = 0; i < 8; ++i) wv[i] = *(const f32x4*)(nw + (i >> 1) * 512 + lane * 8 + (i & 1) * 4);
    for (int r = bxl * 8 + wave; r < nrows; r += F.G * 8) {
        const int j = (r < RL) ? (r >> 11) : 8;
        const float* shp = mods_l + (size_t)j * 12288 + sh * D; const float* scp = shp + D;
        f32x4 v[8], s1v[8], s0v[8]; float ss = 0.f;
        if constexpr (IN32) { const float* xr = (r < RL) ? (const float*)xl_ + (size_t)r * D : (const float*)xc_ + (size_t)(r - RL) * D;
#pragma unroll
            for (int i = 0; i < 8; ++i) v[i] = *(const f32x4*)(xr + (i >> 1) * 512 + lane * 8 + (i & 1) * 4);
        } else { const bf16_t* xr = (r < RL) ? (const bf16_t*)xl_ + (size_t)r * D : (const bf16_t*)xc_ + (size_t)(r - RL) * D;
            u32x4 rw[4];
#pragma unroll
            for (int k = 0; k < 4; ++k) rw[k] = *(const u32x4*)(xr + k * 512 + lane * 8);
#pragma unroll
            for (int k = 0; k < 4; ++k) { float f8[8]; unpack8h(rw[k], f8); v[2 * k] = (f32x4){f8[0], f8[1], f8[2], f8[3]}; v[2 * k + 1] = (f32x4){f8[4], f8[5], f8[6], f8[7]}; } }
#pragma unroll
        for (int i = 0; i < 8; ++i) { const int c = (i >> 1) * 512 + lane * 8 + (i & 1) * 4; s1v[i] = *(const f32x4*)(scp + c); s0v[i] = *(const f32x4*)(shp + c); }
        __builtin_amdgcn_sched_barrier(0);
#pragma unroll
        for (int i = 0; i < 8; ++i) ss += v[i][0] * v[i][0] + v[i][1] * v[i][1] + v[i][2] * v[i][2] + v[i][3] * v[i][3];
#pragma unroll
        for (int o = 32; o >= 1; o >>= 1) ss += shx(ss, o, lane);
        const float rs = rsqrtf(ss * (1.0f / D) + EPS);
#pragma unroll
        for (int k = 0; k < 4; ++k) { const int c = k * 512 + lane * 8;
            if constexpr (IN32) { float f8[8];
#pragma unroll
                for (int q = 0; q < 4; ++q) { f8[q] = v[2 * k][q]; f8[4 + q] = v[2 * k + 1][q]; }
                *(u32x4*)(xcopy + (size_t)r * D + c) = pack8h(f8); }
            float y[8];
#pragma unroll
            for (int q = 0; q < 4; ++q) { y[q] = v[2 * k][q] * rs * wv[2 * k][q] * (1.0f + s1v[2 * k][q]) + s0v[2 * k][q]; y[4 + q] = v[2 * k + 1][q] * rs * wv[2 * k + 1][q] * (1.0f + s1v[2 * k + 1][q]) + s0v[2 * k + 1][q]; }
            *(u32x4*)(out + (size_t)r * D + c) = pack8(y); }
    }
}
__device__ __forceinline__ void phase_final_norm(const Frame& F, const bf16_t* x, const float* nw, float* out) {
    int tid = F.tid; asm volatile("" : "+v"(tid));
    size_t wz_ = 0; asm volatile("" : "+s"(wz_)); unsigned char* wsl = F.ws + wz_;
    int bxl = F.bx; asm volatile("" : "+s"(bxl)); (void)bxl; (void)wsl;
    const int lane = tid & 63, wave = __builtin_amdgcn_readfirstlane(tid >> 6);
    f32x4 wv[8];
#pragma unroll
    for (int i = 0; i < 8; ++i) wv[i] = *(const f32x4*)(nw + (i >> 1) * 512 + lane * 8 + (i & 1) * 4);
    for (int r = bxl * 8 + wave; r < RL; r += F.G * 8) {
        const bf16_t* xr = x + (size_t)r * D;
        f32x4 v[8]; float ss = 0.f; u32x4 rw[4];
#pragma unroll
        for (int k = 0; k < 4; ++k) rw[k] = *(const u32x4*)(xr + k * 512 + lane * 8);
#pragma unroll
        for (int k = 0; k < 4; ++k) { float f8[8]; unpack8h(rw[k], f8); v[2 * k] = (f32x4){f8[0], f8[1], f8[2], f8[3]}; v[2 * k + 1] = (f32x4){f8[4], f8[5], f8[6], f8[7]}; }
#pragma unroll
        for (int i = 0; i < 8; ++i) ss += v[i][0] * v[i][0] + v[i][1] * v[i][1] + v[i][2] * v[i][2] + v[i][3] * v[i][3];
#pragma unroll
        for (int o = 32; o >= 1; o >>= 1) ss += shx(ss, o, lane);
        const float rs = rsqrtf(ss * (1.0f / D) + EPS);
#pragma unroll
        for (int i = 0; i < 8; ++i) { const int c = (i >> 1) * 512 + lane * 8 + (i & 1) * 4;
            *(f32x4*)(out + (size_t)r * D + c) = v[i] * rs * wv[i]; }
    }
}

__device__ __forceinline__ int chunk_rowbase(int b, int ch) { return ch < 4 ? RL + b * CTXL + ch * 64 : b * SEQ + (ch - 4) * 64; }
__device__ __forceinline__ int step_chunk(int d, int i) { return d == 0 ? i : (i < 4 ? 3 - i : 39 - i); }

__device__ __forceinline__ void gla_prep_unit(const Frame& F, int l, int b, int ch, int h, int d) {
    int tid = F.tid; asm volatile("" : "+v"(tid));
    size_t wz_ = 0; asm volatile("" : "+s"(wz_)); unsigned char* wsl = F.ws + wz_;
    int bxl = F.bx; asm volatile("" : "+s"(bxl)); (void)bxl;
    const int lane = tid & 63, w = __builtin_amdgcn_readfirstlane(tid >> 6), fr = lane & 15, fq = lane >> 4;
    LAS bf16_t* qd = (LAS bf16_t*)(F.lds + 0);
    LAS bf16_t* kn = (LAS bf16_t*)(F.lds + 17408);
    LAS bf16_t* vT = (LAS bf16_t*)(F.lds + 34816);
    LAS bf16_t* sc = (LAS bf16_t*)(F.lds + 71680);
    LAS float* bc = (LAS float*)(F.lds + 80896);
    LAS float* lr = (LAS float*)(F.lds + 113920);
    LAS float* w2 = (LAS float*)(F.lds + 118016);
    LAS float* bs = (LAS float*)(F.lds + 126208);
    const bf16_t* P = (const bf16_t*)(wsl + WS_P); const float* small = (const float*)(wsl + WS_SMALL);
    const int rowbase = chunk_rowbase(b, ch);
    unsigned char* ub = wsl + WS_GLAPREP + (size_t)(((b * NCH + ch) * 4 + h) * 2 + d) * GLA_UNIT;
    bf16_t* g_qd = (bf16_t*)ub; bf16_t* g_keT = (bf16_t*)(ub + 16384); bf16_t* g_vT = (bf16_t*)(ub + 32768); float* g_dec = (float*)(ub + 65536);
    bf16_t* og = (bf16_t*)(wsl + WS_OGLA) + (size_t)d * R * 1024;
    const int p = tid >> 3, k0 = (tid & 7) * 16, tok = d ? 63 - p : p;
    f32x4 lrv = (f32x4){0.f, 0.f, 0.f, 0.f}, w2v; float bsv = 0.f; u32x4 qraw[2], kraw[2], vraw[4];
    if (tid < 256) { const int p1 = tid >> 2, r4 = (tid & 3) * 4, tok1 = d ? 63 - p1 : p1; lrv = *(const f32x4*)(small + (size_t)(rowbase + tok1) * 64 + d * 16 + r4); }
    { const int idx = tid * 4, r = idx >> 7, k = idx & 127; w2v = *(const f32x4*)(F.in[I_LRW2] + ((size_t)(l * 2 + d) * 16 + r) * 512 + h * 128 + k); }
    if (tid < 128) bsv = F.in[I_LRB][(size_t)(l * 2 + d) * 512 + h * 128 + tid];
    { const bf16_t* qp = P + (size_t)(rowbase + tok) * NP + PC_GLA_Q + h * 128 + k0; const bf16_t* kp = P + (size_t)(rowbase + tok) * NP + PC_GLA_K + h * 128 + k0;
        const bf16_t* vp = P + (size_t)(rowbase + tok) * NP + PC_GLA_V + h * 256 + (tid & 7) * 32;
        qraw[0] = *(const u32x4*)qp; qraw[1] = *(const u32x4*)(qp + 8); kraw[0] = *(const u32x4*)kp; kraw[1] = *(const u32x4*)(kp + 8);
#pragma unroll
        for (int j = 0; j < 4; ++j) vraw[j] = *(const u32x4*)(vp + j * 8); }
    __builtin_amdgcn_sched_barrier(0);
    if (tid < 256) { const int p1 = tid >> 2, r4 = (tid & 3) * 4; *(LAS f32x4*)(lr + p1 * 16 + r4) = lrv; }
    *(LAS f32x4*)(w2 + tid * 4) = w2v;
    if (tid < 128) bs[tid] = bsv;
    __syncthreads();
    { float z[16];
#pragma unroll
        for (int i = 0; i < 16; ++i) z[i] = bs[k0 + i];
#pragma unroll
        for (int r = 0; r < 16; ++r) { const float lv = lr[p * 16 + r];
#pragma unroll
            for (int i = 0; i < 16; ++i) z[i] += lv * w2[r * 128 + k0 + i]; }
#pragma unroll
        for (int i = 0; i < 16; ++i) bc[p * 129 + k0 + i] = logsigf_(z[i]) * (1.0f / 16.0f); }
    __syncthreads();
    if (tid < 128) { float cv[64];
#pragma unroll
        for (int q = 0; q < 64; ++q) cv[q] = bc[q * 129 + tid];
#pragma unroll
        for (int q = 1; q < 64; ++q) cv[q] += cv[q - 1];
#pragma unroll
        for (int q = 0; q < 64; ++q) bc[q * 129 + tid] = cv[q]; }
    __syncthreads();
    {
        float qf[16], kf[16];
        { float t8[8]; unpack8(qraw[0], t8);
#pragma unroll
            for (int i = 0; i < 8; ++i) qf[i] = t8[i];
            unpack8(qraw[1], t8);
#pragma unroll
            for (int i = 0; i < 8; ++i) qf[8 + i] = t8[i];
            unpack8(kraw[0], t8);
#pragma unroll
            for (int i = 0; i < 8; ++i) kf[i] = t8[i];
            unpack8(kraw[1], t8);
#pragma unroll
            for (int i = 0; i < 8; ++i) kf[8 + i] = t8[i]; }
        float qo[16], ko[16];
#pragma unroll
        for (int i = 0; i < 16; ++i) { const float bb = bc[p * 129 + k0 + i], bl = bc[63 * 129 + k0 + i];
            qo[i] = qf[i] * 0.08838834764831845f * __expf(bb); ko[i] = kf[i] * __expf(-bb);
            g_keT[frag_off(k0 + i, p, 2)] = f2bf(kf[i] * __expf(bl - bb));
            if (p == 63) g_dec[k0 + i] = __expf(bl); }
        u32x4 q0, q1, k0v, k1v;
        { float t8[8];
#pragma unroll
            for (int i = 0; i < 8; ++i) t8[i] = qo[i];
            q0 = pack8(t8);
#pragma unroll
            for (int i = 0; i < 8; ++i) t8[i] = qo[8 + i];
            q1 = pack8(t8);
#pragma unroll
            for (int i = 0; i < 8; ++i) t8[i] = ko[i];
            k0v = pack8(t8);
#pragma unroll
            for (int i = 0; i < 8; ++i) t8[i] = ko[8 + i];
            k1v = pack8(t8); }
        *(LAS u32x4*)(qd + p * 136 + k0) = q0; *(LAS u32x4*)(qd + p * 136 + k0 + 8) = q1;
        *(LAS u32x4*)(kn + p * 136 + k0) = k0v; *(LAS u32x4*)(kn + p * 136 + k0 + 8) = k1v;
        *(u32x4*)(g_qd + frag_off(p, k0, 4)) = q0; *(u32x4*)(g_qd + frag_off(p, k0 + 8, 4)) = q1; }
    { const int v0 = (tid & 7) * 32;
#pragma unroll
        for (int j = 0; j < 4; ++j) { const u32x4 wv = vraw[j];
            const unsigned ws_[4] = {wv.x, wv.y, wv.z, wv.w};
#pragma unroll
            for (int q = 0; q < 4; ++q) { vT[(v0 + j * 8 + 2 * q) * 72 + p] = (bf16_t)(ws_[q] & 0xFFFFu); vT[(v0 + j * 8 + 2 * q + 1) * 72 + p] = (bf16_t)(ws_[q] >> 16); } } }
    __syncthreads();
    { const int row = tid >> 1, half = tid & 1;
#pragma unroll
        for (int j = 0; j < 4; ++j) *(u32x4*)(g_vT + frag_off(row, half * 32 + j * 8, 2)) = *(const LAS u32x4*)(vT + row * 72 + half * 32 + j * 8); }
    { const int rb = w >> 1;
#pragma unroll
        for (int j = 0; j < 2; ++j) { const int cb = (w & 1) * 2 + j; f32x4 acc = (f32x4){0.f, 0.f, 0.f, 0.f};
#pragma unroll
            for (int ks = 0; ks < 4; ++ks) { const bf16x8 a = *(const LAS bf16x8*)(qd + (rb * 16 + fr) * 136 + ks * 32 + fq * 8); const bf16x8 bt = *(const LAS bf16x8*)(kn + (cb * 16 + fr) * 136 + ks * 32 + fq * 8);
                acc = MFMA16(bt, a, acc); }
            const int pr = rb * 16 + fr, s0 = cb * 16 + 4 * fq;
            u32x2 o; o.x = pk2(s0 + 0 <= pr ? acc[0] : 0.f, s0 + 1 <= pr ? acc[1] : 0.f); o.y = pk2(s0 + 2 <= pr ? acc[2] : 0.f, s0 + 3 <= pr ? acc[3] : 0.f);
            *(LAS u32x2*)(sc + pr * 72 + s0) = o; } }
    __syncthreads();
    { bf16x8 af[4][2];
#pragma unroll
        for (int rb = 0; rb < 4; ++rb)
#pragma unroll
            for (int ks = 0; ks < 2; ++ks) af[rb][ks] = *(const LAS bf16x8*)(sc + (rb * 16 + fr) * 72 + ks * 32 + fq * 8);
#pragma unroll
        for (int j = 0; j < 2; ++j) { const int cb = w * 2 + j; bf16x8 bf[2];
#pragma unroll
            for (int ks = 0; ks < 2; ++ks) bf[ks] = *(const LAS bf16x8*)(vT + (cb * 16 + fr) * 72 + ks * 32 + fq * 8);
#pragma unroll
            for (int rb = 0; rb < 4; ++rb) { f32x4 acc = (f32x4){0.f, 0.f, 0.f, 0.f};
#pragma unroll
                for (int ks = 0; ks < 2; ++ks) acc = MFMA16(bf[ks], af[rb][ks], acc);
                const int pr = rb * 16 + fr, tk = d ? 63 - pr : pr;
                u32x2 o; o.x = pk2(acc[0], acc[1]); o.y = pk2(acc[2], acc[3]);
                *(u32x2*)(og + (size_t)(rowbase + tk) * 1024 + h * 256 + cb * 16 + 4 * fq) = o; } } }
    __syncthreads();
}

struct GlaOps { bf16x8 qa[4]; bf16x8 va[2][2]; bf16x8 ke[2][2]; f32x4 dc[2]; };
__device__ __forceinline__ void gla_ops_load(GlaOps& o, unsigned char* wsl, int b, int h, int d, int vs, int step, int fr, int fq, int pb, int vvb0, int vb, int kb0) {
    const int ch = step_chunk(d, step);
    const unsigned char* ub = wsl + WS_GLAPREP + (size_t)(((b * NCH + ch) * 4 + h) * 2 + d) * GLA_UNIT;
    const bf16_t* g_qd = (const bf16_t*)ub; const bf16_t* g_keT = (const bf16_t*)(ub + 16384); const bf16_t* g_vT = (const bf16_t*)(ub + 32768); const float* g_dec = (const float*)(ub + 65536);
#pragma unroll
    for (int ks = 0; ks < 4; ++ks) o.qa[ks] = *(const bf16x8*)(g_qd + frag_tile(pb, ks, 4, fq * 16 + fr));
#pragma unroll
    for (int j = 0; j < 2; ++j) { o.dc[j] = *(const f32x4*)(g_dec + (kb0 + j) * 16 + 4 * fq);
#pragma unroll
        for (int ks = 0; ks < 2; ++ks) { o.va[j][ks] = *(const bf16x8*)(g_vT + frag_tile(vs * 4 + vb + j, ks, 2, fq * 16 + fr)); o.ke[j][ks] = *(const bf16x8*)(g_keT + frag_tile(kb0 + j, ks, 2, fq * 16 + fr)); } }
}
__device__ __forceinline__ void gla_flush(LAS const bf16_t* OTp, unsigned char* wsl, int b, int h, int d, int vs, int step, int tid, const u32x4 oldv) {
    const int ch = step_chunk(d, step), rowbase = chunk_rowbase(b, ch), p = tid >> 3, c8 = (tid & 7) * 8, tk = d ? 63 - p : p;
    bf16_t* op = (bf16_t*)(wsl + WS_OGLA) + (size_t)d * R * 1024 + (size_t)(rowbase + tk) * 1024 + h * 256 + vs * 64 + c8;
    float a[8], o8[8]; unpack8(*(const LAS u32x4*)(OTp + p * 72 + c8), a); unpack8(oldv, o8);
#pragma unroll
    for (int i = 0; i < 8; ++i) a[i] += o8[i];
    *(u32x4*)op = pack8(a);
}
__device__ __forceinline__ u32x4 gla_old(unsigned char* wsl, int b, int h, int d, int vs, int step, int tid) {
    const int ch = step_chunk(d, step), rowbase = chunk_rowbase(b, ch), p = tid >> 3, c8 = (tid & 7) * 8, tk = d ? 63 - p : p;
    return *(const u32x4*)((const bf16_t*)(wsl + WS_OGLA) + (size_t)d * R * 1024 + (size_t)(rowbase + tk) * 1024 + h * 256 + vs * 64 + c8);
}
__device__ __forceinline__ void gla_step(const GlaOps& o, f32x4 (&Sacc)[4], LAS const bf16_t* Sc, LAS bf16_t* Sn, LAS bf16_t* OT, unsigned char* wsl, int b, int h, int d, int vs, int step, int tid, int fr, int fq, int pb, int vvb0, int vb, int kb0, const u32x4 oldv) {
    LAS bf16_t* OTc = OT + (step & 1) * (64 * 72);
#pragma unroll
    for (int j = 0; j < 2; ++j) { const int vvb = vvb0 + j; f32x4 acc = (f32x4){0.f, 0.f, 0.f, 0.f};
#pragma unroll
        for (int ks = 0; ks < 4; ++ks) { const bf16x8 bt = *(const LAS bf16x8*)(Sc + (vvb * 16 + fr) * 136 + ks * 32 + fq * 8); acc = MFMA16(bt, o.qa[ks], acc); }
        u32x2 w; w.x = pk2(acc[0], acc[1]); w.y = pk2(acc[2], acc[3]);
        *(LAS u32x2*)(OTc + (pb * 16 + fr) * 72 + vvb * 16 + 4 * fq) = w; }
#pragma unroll
    for (int j = 0; j < 4; ++j) { const int kj = j & 1, vj = j >> 1; f32x4 acc = Sacc[j] * o.dc[kj];
#pragma unroll
        for (int ks = 0; ks < 2; ++ks) acc = MFMA16(o.ke[kj][ks], o.va[vj][ks], acc);
        Sacc[j] = acc;
        u32x2 w; w.x = pk2(acc[0], acc[1]); w.y = pk2(acc[2], acc[3]);
        *(LAS u32x2*)(Sn + ((vb + vj) * 16 + fr) * 136 + (kb0 + kj) * 16 + 4 * fq) = w; }
    gla_flush(OT + ((step - 1) & 1) * (64 * 72), wsl, b, h, d, vs, step > 0 ? step - 1 : 0, tid, oldv);
}
__device__ __forceinline__ void gla_scan_unit(const Frame& F, int b, int h, int d, int vs) {
    int tid = F.tid; asm volatile("" : "+v"(tid));
    size_t wz_ = 0; asm volatile("" : "+s"(wz_)); unsigned char* wsl = F.ws + wz_;
    const int lane = tid & 63, w = __builtin_amdgcn_readfirstlane(tid >> 6), fr = lane & 15, fq = lane >> 4;
    LAS bf16_t* ST = (LAS bf16_t*)(F.lds);
    LAS bf16_t* OT = (LAS bf16_t*)(F.lds + 34816);
    const int pb = w >> 1, vvb0 = (w & 1) * 2, vb = w >> 1, kb0 = (w & 1) * 4;
    f32x4 Sacc[4];
#pragma unroll
    for (int j = 0; j < 4; ++j) Sacc[j] = (f32x4){0.f, 0.f, 0.f, 0.f};
    GlaOps A, B;
    gla_ops_load(A, wsl, b, h, d, vs, 0, fr, fq, pb, vvb0, vb, kb0);
    __syncthreads();
    for (int i = tid; i < 64 * 136 / 2; i += NTHR) ((LAS unsigned*)ST)[i] = 0u;
    __syncthreads();
    LAS bf16_t* S0 = ST; LAS bf16_t* S1 = ST + 64 * 136;
#pragma unroll 1
    for (int step = 0; step < NCH; step += 2) {
        gla_ops_load(B, wsl, b, h, d, vs, step + 1, fr, fq, pb, vvb0, vb, kb0);
        __builtin_amdgcn_sched_barrier(0);
        gla_step(A, Sacc, S0, S1, OT, wsl, b, h, d, vs, step, tid, fr, fq, pb, vvb0, vb, kb0, step > 0 ? gla_old(wsl, b, h, d, vs, step - 1, tid) : (u32x4){0u, 0u, 0u, 0u});
        __syncthreads();
        if (step + 2 < NCH) gla_ops_load(A, wsl, b, h, d, vs, step + 2, fr, fq, pb, vvb0, vb, kb0);
        __builtin_amdgcn_sched_barrier(0);
        gla_step(B, Sacc, S1, S0, OT, wsl, b, h, d, vs, step + 1, tid, fr, fq, pb, vvb0, vb, kb0, gla_old(wsl, b, h, d, vs, step, tid));
        __syncthreads();
    }
    gla_flush(OT + ((NCH - 1) & 1) * (64 * 72), wsl, b, h, d, vs, NCH - 1, tid, gla_old(wsl, b, h, d, vs, NCH - 1, tid));
}

__device__ __forceinline__ void ld16(const bf16_t* p, float (&x)[16]) { float t8[8]; unpack8(*(const u32x4*)p, t8);
#pragma unroll
    for (int i = 0; i < 8; ++i) x[i] = t8[i];
    unpack8(*(const u32x4*)(p + 8), t8);
#pragma unroll
    for (int i = 0; i < 8; ++i) x[8 + i] = t8[i]; }
template <int BI> __device__ __forceinline__ void tinv_row(LAS float* Ti, LAS const float* Nx, int tid) {
    for (int e = tid; e < BI * 256; e += NTHR) { const int bj = e >> 8, a = (e >> 4) & 15, c = e & 15; float acc = 0.f;
#pragma unroll
        for (int sx = 0; sx < BI * 16; ++sx) acc -= Nx[((BI - 1) * 16 + a) * 52 + sx] * Ti[sx * 68 + bj * 16 + c];
        Ti[(BI * 16 + a) * 68 + bj * 16 + c] = acc; }
}
__device__ __forceinline__ unsigned long long gdn_prep_unit(const Frame& F, int l, int b, int ch, int h) {
    unsigned long long tacc = 0, tl_ = 0; if (PROBE_GDN) tl_ = wall_clock64();
#define GST(id) do { if (PROBE_GDN) { const unsigned long long tn_ = wall_clock64(); if (PROBE_GDN == (id)) tacc += tn_ - tl_; tl_ = tn_; } } while (0)
    int tid = F.tid; asm volatile("" : "+v"(tid));
    size_t wz_ = 0; asm volatile("" : "+s"(wz_)); unsigned char* wsl = F.ws + wz_;
    const int lane = tid & 63, w = __builtin_amdgcn_readfirstlane(tid >> 6), fr = lane & 15, fq = lane >> 4;
    LAS float* Lm = (LAS float*)(F.lds + 0);
    LAS bf16_t* TH = (LAS bf16_t*)(F.lds + 0);
    LAS bf16_t* TL = (LAS bf16_t*)(F.lds + 9216);
    LAS float* Ti = (LAS float*)(F.lds + 17408);
    LAS float* Nx = (LAS float*)(F.lds + 34816);
    LAS float* gb = (LAS float*)(F.lds + 44800);
    LAS float* bt = (LAS float*)(F.lds + 45312);
    LAS bf16_t* qh = (LAS bf16_t*)(F.lds + 45824);
    LAS bf16_t* kh = (LAS bf16_t*)(F.lds + 63232);
    LAS bf16_t* kbT = (LAS bf16_t*)(F.lds + 80640);
    LAS bf16_t* vbT = (LAS bf16_t*)(F.lds + 99072);
    LAS float* cwL = (LAS float*)(F.lds + 117504);
    const bf16_t* P = (const bf16_t*)(wsl + WS_P); const float* small = (const float*)(wsl + WS_SMALL);
    const int rowbase = chunk_rowbase(b, ch);
    const int T = ch < 4 ? CTXL : SEQ, chl = ch < 4 ? ch : ch - 4;
    unsigned char* ub0 = wsl + WS_GDNPREP + (size_t)(((b * NCH + ch) * 8 + h) * 2) * GDN_UNIT;
    const int t = tid >> 3, c0 = (tid & 7) * 16;
    u32x4 raw[3][3][2];
    { const int ts = chl * 64 + t; const u32x4 z4 = (u32x4){0u, 0u, 0u, 0u};
#pragma unroll
        for (int part = 0; part < 3; ++part) { const bf16_t* xp = P + (size_t)(rowbase + t) * NP + PC_GDN_Q + part * 1024 + h * 128 + c0;
            raw[part][0][0] = (ts - 1 >= 0) ? *(const u32x4*)(xp - NP) : z4; raw[part][0][1] = (ts - 1 >= 0) ? *(const u32x4*)(xp - NP + 8) : z4;
            raw[part][1][0] = *(const u32x4*)xp; raw[part][1][1] = *(const u32x4*)(xp + 8);
            raw[part][2][0] = (ts + 1 < T) ? *(const u32x4*)(xp + NP) : z4; raw[part][2][1] = (ts + 1 < T) ? *(const u32x4*)(xp + NP + 8) : z4; } }
    f32x4 cwv = (f32x4){0.f, 0.f, 0.f, 0.f};
    if (tid < 288) { const int tap = tid / 96, rem = tid % 96, part = rem >> 5, c4 = (rem & 31) * 4;
        cwv = *(const f32x4*)(F.in[I_CONVW] + (size_t)l * 3 * 3072 + tap * 3072 + part * 1024 + h * 128 + c4); }
    float g0a = 0.f, g0b = 0.f, g0l = 0.f, g0t = 0.f;
    if (w < 2) { const int d = w, tok = d ? 63 - lane : lane;
        g0a = small[(size_t)(rowbase + tok) * 64 + 32 + d * 8 + h]; g0b = small[(size_t)(rowbase + tok) * 64 + 48 + d * 8 + h];
        g0l = F.in[I_ALOG][(l * 2 + d) * 8 + h]; g0t = F.in[I_DTB][(l * 2 + d) * 8 + h]; }
    __builtin_amdgcn_sched_barrier(0);
    if (tid < 288) { const int tap = tid / 96, rem = tid % 96; *(LAS f32x4*)(cwL + tap * 384 + rem * 4) = cwv; }
    __syncthreads();
    float qn[16], kn[16], vv[16];
    {
#pragma unroll
        for (int part = 0; part < 3; ++part) {
            const int wc = part * 128 + c0;
            float x0[16], x1[16], x2[16], t8[8];
            unpack8(raw[part][0][0], t8);
#pragma unroll
            for (int i = 0; i < 8; ++i) x0[i] = t8[i];
            unpack8(raw[part][0][1], t8);
#pragma unroll
            for (int i = 0; i < 8; ++i) x0[8 + i] = t8[i];
            unpack8(raw[part][1][0], t8);
#pragma unroll
            for (int i = 0; i < 8; ++i) x1[i] = t8[i];
            unpack8(raw[part][1][1], t8);
#pragma unroll
            for (int i = 0; i < 8; ++i) x1[8 + i] = t8[i];
            unpack8(raw[part][2][0], t8);
#pragma unroll
            for (int i = 0; i < 8; ++i) x2[i] = t8[i];
            unpack8(raw[part][2][1], t8);
#pragma unroll
            for (int i = 0; i < 8; ++i) x2[8 + i] = t8[i];
#pragma unroll
            for (int i = 0; i < 16; ++i) { const float v = siluf_(cwL[wc + i] * x0[i] + cwL[384 + wc + i] * x1[i] + cwL[768 + wc + i] * x2[i]);
                if (part == 0) qn[i] = v; else if (part == 1) kn[i] = v; else vv[i] = v; }
        }
        float sq = 0.f, sk = 0.f;
#pragma unroll
        for (int i = 0; i < 16; ++i) { sq += qn[i] * qn[i]; sk += kn[i] * kn[i]; }
#pragma unroll
        for (int o = 1; o < 8; o <<= 1) { sq += shx(sq, o, lane); sk += shx(sk, o, lane); }
        const float rq = rsqrtf(sq + EPS) * 0.08838834764831845f, rk = rsqrtf(sk + EPS);
#pragma unroll
        for (int i = 0; i < 16; ++i) { qn[i] *= rq; kn[i] *= rk; }
        float t8[8];
#pragma unroll
        for (int i = 0; i < 8; ++i) t8[i] = qn[i];
        *(LAS u32x4*)(qh + t * 136 + c0) = pack8(t8);
#pragma unroll
        for (int i = 0; i < 8; ++i) t8[i] = qn[8 + i];
        *(LAS u32x4*)(qh + t * 136 + c0 + 8) = pack8(t8);
#pragma unroll
        for (int i = 0; i < 8; ++i) t8[i] = kn[i];
        *(LAS u32x4*)(kh + t * 136 + c0) = pack8(t8);
#pragma unroll
        for (int i = 0; i < 8; ++i) t8[i] = kn[8 + i];
        *(LAS u32x4*)(kh + t * 136 + c0 + 8) = pack8(t8); }
    if (w < 2) { const int d = w;
        float g = -__expf(g0l) * softplusf_(g0a + g0t);
#pragma unroll
        for (int o = 1; o < 64; o <<= 1) { const float tt = shup(g, o, lane); if (lane >= o) g += tt; }
        gb[d * 64 + lane] = g; bt[d * 64 + lane] = sigmoidf_(g0b);
        if (lane == 63) *(float*)(ub0 + (size_t)d * GDN_UNIT + 73728) = __expf(g); }
    __syncthreads();
    GST(1);
#pragma unroll 1
    for (int d = 0; d < 2; ++d) {
        unsigned char* ub = ub0 + (size_t)d * GDN_UNIT;
        bf16_t* g_nw = (bf16_t*)ub; bf16_t* g_uT = (bf16_t*)(ub + 16384); bf16_t* g_at = (bf16_t*)(ub + 32768); bf16_t* g_qd = (bf16_t*)(ub + 40960); bf16_t* g_kdT = (bf16_t*)(ub + 57344);
        LAS const float* gbd = gb + d * 64; LAS const float* btd = bt + d * 64;
        { const int p = d ? 63 - t : t; const float bcp = gbd[p], bl = gbd[63], beta = btd[p], eq = __expf(bcp), ek = __expf(bl - bcp), sk = beta * eq;
            float t8[8];
#pragma unroll
            for (int i = 0; i < 8; ++i) t8[i] = qn[i] * eq;
            *(u32x4*)(g_qd + frag_off(p, c0, 4)) = pack8(t8);
#pragma unroll
            for (int i = 0; i < 8; ++i) t8[i] = qn[8 + i] * eq;
            *(u32x4*)(g_qd + frag_off(p, c0 + 8, 4)) = pack8(t8);
#pragma unroll
            for (int i = 0; i < 16; ++i) { g_kdT[frag_off(c0 + i, p, 2)] = f2bf(kn[i] * ek); kbT[(c0 + i) * 72 + p] = f2bf(kn[i] * sk); vbT[(c0 + i) * 72 + p] = f2bf(vv[i] * beta); } }
        __syncthreads();
        GST(2);
        { const bool isq = w >= 4; const int rb = w & 3; LAS const bf16_t* Asrc = isq ? qh : kh;
            const int pr = rb * 16 + fr, tr = d ? 63 - pr : pr;
            bf16x8 af[4];
#pragma unroll
            for (int ks = 0; ks < 4; ++ks) af[ks] = *(const LAS bf16x8*)(Asrc + tr * 136 + ks * 32 + fq * 8);
            const float bp = gbd[pr], betap = btd[pr];
#pragma unroll
            for (int cb = 0; cb < 4; ++cb) { f32x4 acc = (f32x4){0.f, 0.f, 0.f, 0.f}; const int sr = cb * 16 + fr, tsr = d ? 63 - sr : sr;
#pragma unroll
                for (int ks = 0; ks < 4; ++ks) { const bf16x8 bfr = *(const LAS bf16x8*)(kh + tsr * 136 + ks * 32 + fq * 8); acc = MFMA16(bfr, af[ks], acc); }
                const int s0 = cb * 16 + 4 * fq; float o[4];
#pragma unroll
                for (int i = 0; i < 4; ++i) { const int sx = s0 + i; const bool keep = isq ? (sx <= pr) : (sx < pr);
                    const float e = keep ? __expf(bp - gbd[sx]) : 0.f; o[i] = keep ? acc[i] * e * (isq ? 1.0f : betap) : 0.f; }
                if (isq) { u32x2 ov; ov.x = pk2(o[0], o[1]); ov.y = pk2(o[2], o[3]); *(u32x2*)(g_at + frag_off(pr, s0, 2)) = ov; }
                else *(LAS f32x4*)(Lm + pr * 68 + s0) = (f32x4){o[0], o[1], o[2], o[3]}; } }
        __syncthreads();
        GST(3);
        if (w < 4) { const int jb = w, a = lane & 15, g = lane >> 4;
            float bn[4][3][4];
#pragma unroll
            for (int bi = 1; bi < 4; ++bi)
#pragma unroll
                for (int bk = 0; bk < bi; ++bk) if (bk >= jb) {
#pragma unroll
                    for (int ks = 0; ks < 4; ++ks) bn[bi][bk][ks] = Lm[(bi * 16 + ks * 4 + g) * 68 + bk * 16 + a]; }
            { LAS const float* Lb = Lm + (g * 16) * 68 + g * 16; float x[16];
#pragma unroll
                for (int r = 0; r < 16; ++r) { float acc = (r == a) ? 1.0f : 0.0f;
#pragma unroll
                    for (int sx = 0; sx < r; ++sx) acc -= Lb[r * 68 + sx] * x[sx];
                    x[r] = acc; }
#pragma unroll
                for (int r = 0; r < 16; ++r) Ti[(g * 16 + r) * 68 + g * 16 + a] = x[r]; }
            float an[4][4];
#pragma unroll
            for (int bi = 1; bi < 4; ++bi) if (bi > jb) {
#pragma unroll
                for (int ks = 0; ks < 4; ++ks) an[bi][ks] = Ti[(bi * 16 + a) * 68 + bi * 16 + ks * 4 + g]; }
#pragma unroll
            for (int bi = 1; bi < 4; ++bi)
#pragma unroll
                for (int bk = 0; bk < bi; ++bk) if (bk >= jb) { f32x4 acc = (f32x4){0.f, 0.f, 0.f, 0.f};
#pragma unroll
                    for (int ks = 0; ks < 4; ++ks) acc = __builtin_amdgcn_mfma_f32_16x16x4f32(an[bi][ks], bn[bi][bk][ks], acc, 0, 0, 0);
#pragma unroll
                    for (int q = 0; q < 4; ++q) Nx[((bi - 1) * 16 + 4 * g + q) * 52 + bk * 16 + a] = acc[q]; }
#pragma unroll
            for (int bi = 1; bi < 4; ++bi) if (bi > jb) { float la[3][4], lb[3][4];
#pragma unroll
                for (int bk = 0; bk < bi; ++bk) if (bk >= jb) {
#pragma unroll
                    for (int ks = 0; ks < 4; ++ks) { la[bk][ks] = Nx[((bi - 1) * 16 + a) * 52 + bk * 16 + ks * 4 + g]; lb[bk][ks] = Ti[(bk * 16 + ks * 4 + g) * 68 + jb * 16 + a]; } }
                f32x4 acc = (f32x4){0.f, 0.f, 0.f, 0.f};
#pragma unroll
                for (int bk = 0; bk < bi; ++bk) if (bk >= jb) {
#pragma unroll
                    for (int ks = 0; ks < 4; ++ks) acc = __builtin_amdgcn_mfma_f32_16x16x4f32(la[bk][ks], lb[bk][ks], acc, 0, 0, 0); }
#pragma unroll
                for (int q = 0; q < 4; ++q) Ti[(bi * 16 + 4 * g + q) * 68 + jb * 16 + a] = -acc[q]; } }
        __syncthreads();
        GST(5);
        { const int p = tid >> 3, s0 = (tid & 7) * 8; float hi[8], lo[8];
#pragma unroll
            for (int i = 0; i < 8; ++i) { const float v = ((s0 >> 4) <= (p >> 4)) ? Ti[p * 68 + s0 + i] : 0.f; const float hf = bf2f(f2bf(v)); hi[i] = hf; lo[i] = v - hf; }
            *(LAS u32x4*)(TH + p * 72 + s0) = pack8(hi); *(LAS u32x4*)(TL + p * 72 + s0) = pack8(lo); }
        __syncthreads();
        { const bool isu = w >= 4; LAS const bf16_t* Bsrc = isu ? vbT : kbT;
            bf16x8 th[4][2], tl[4][2];
#pragma unroll
            for (int rb = 0; rb < 4; ++rb)
#pragma unroll
                for (int ks = 0; ks < 2; ++ks) { th[rb][ks] = *(const LAS bf16x8*)(TH + (rb * 16 + fr) * 72 + ks * 32 + fq * 8); tl[rb][ks] = *(const LAS bf16x8*)(TL + (rb * 16 + fr) * 72 + ks * 32 + fq * 8); }
#pragma unroll
            for (int jj = 0; jj < 2; ++jj) { const int cb = (w & 3) * 2 + jj;
                bf16x8 bf[2];
#pragma unroll
                for (int ks = 0; ks < 2; ++ks) bf[ks] = *(const LAS bf16x8*)(Bsrc + (cb * 16 + fr) * 72 + ks * 32 + fq * 8);
#pragma unroll
                for (int rb = 0; rb < 4; ++rb) { f32x4 acc = (f32x4){0.f, 0.f, 0.f, 0.f};
                    if (!isu) {
#pragma unroll
                        for (int ks = 0; ks < 2; ++ks) { acc = MFMA16(bf[ks], th[rb][ks], acc); acc = MFMA16(bf[ks], tl[rb][ks], acc); }
                        u32x2 ov; ov.x = pk2(-acc[0], -acc[1]); ov.y = pk2(-acc[2], -acc[3]);
                        *(u32x2*)(g_nw + frag_off(rb * 16 + fr, cb * 16 + 4 * fq, 4)) = ov;
                    } else {
#pragma unroll
                        for (int ks = 0; ks < 2; ++ks) { acc = MFMA16(th[rb][ks], bf[ks], acc); acc = MFMA16(tl[rb][ks], bf[ks], acc); }
                        u32x2 ov; ov.x = pk2(acc[0], acc[1]); ov.y = pk2(acc[2], acc[3]);
                        *(u32x2*)(g_uT + (((cb * 4 + rb) << 8) + (fq * 16 + fr) * 4)) = ov;
                    } } } }
        __syncthreads();
        GST(6);
    }
    return tacc;
#undef GST
}

struct GdnOps { bf16x8 wa[4]; u32x2 uw[2]; bf16x8 qa[4]; bf16x8 aa[2]; bf16x8 kd[2]; float cd; };
__device__ __forceinline__ void gdn_ops_load(GdnOps& o, unsigned char* wsl, int b, int h, int d, int vs, int step, int fr, int fq, int pb, int vvb0, int kb0) {
    const int ch = step_chunk(d, step);
    const unsigned char* ub = wsl + WS_GDNPREP + (size_t)(((b * NCH + ch) * 8 + h) * 2 + d) * GDN_UNIT;
    const bf16_t* g_nw = (const bf16_t*)ub; const bf16_t* g_uT = (const bf16_t*)(ub + 16384); const bf16_t* g_at = (const bf16_t*)(ub + 32768); const bf16_t* g_qd = (const bf16_t*)(ub + 40960); const bf16_t* g_kdT = (const bf16_t*)(ub + 57344);
#pragma unroll
    for (int ks = 0; ks < 4; ++ks) o.wa[ks] = *(const bf16x8*)(g_nw + frag_tile(pb, ks, 4, fq * 16 + fr));
#pragma unroll
    for (int j = 0; j < 2; ++j) o.uw[j] = *(const u32x2*)(g_uT + ((((vs * 4 + vvb0 + j) * 4 + pb) << 8) + (fq * 16 + fr) * 4));
#pragma unroll
    for (int ks = 0; ks < 4; ++ks) o.qa[ks] = *(const bf16x8*)(g_qd + frag_tile(pb, ks, 4, fq * 16 + fr));
#pragma unroll
    for (int ks = 0; ks < 2; ++ks) o.aa[ks] = *(const bf16x8*)(g_at + frag_tile(pb, ks, 2, fq * 16 + fr));
#pragma unroll
    for (int ks = 0; ks < 2; ++ks) o.kd[ks] = *(const bf16x8*)(g_kdT + frag_tile(pb * 2 + (kb0 >> 2), ks, 2, fq * 16 + fr));
    o.cd = *(const float*)(ub + 73728);
}
__device__ __forceinline__ void gdn_flush(LAS const bf16_t* OTp, unsigned char* wsl, int b, int h, int d, int vs, int step, int tid) {
    const int ch = step_chunk(d, step), rowbase = chunk_rowbase(b, ch), p = tid >> 3, c8 = (tid & 7) * 8, tk = d ? 63 - p : p;
    *(u32x4*)((bf16_t*)(wsl + WS_OGDN) + (size_t)d * R * 1024 + (size_t)(rowbase + tk) * 1024 + h * 128 + vs * 64 + c8) = *(const LAS u32x4*)(OTp + p * 72 + c8);
}
__device__ __forceinline__ void gdn_step(const GdnOps& o, f32x4 (&Sacc)[4], LAS const bf16_t* Sc, LAS bf16_t* Sn, LAS bf16_t* VN, LAS bf16_t* OT, unsigned char* wsl, int b, int h, int d, int vs, int step, int tid, int fr, int fq, int pb, int vvb0, int vb, int kb0) {
    LAS bf16_t* OTc = OT + (step & 1) * (64 * 72);
    gdn_flush(OT + ((step - 1) & 1) * (64 * 72), wsl, b, h, d, vs, step > 0 ? step - 1 : 0, tid);
    bf16x8 sb[2][4];
#pragma unroll
    for (int j = 0; j < 2; ++j)
#pragma unroll
        for (int ks = 0; ks < 4; ++ks) sb[j][ks] = *(const LAS bf16x8*)(Sc + ((vvb0 + j) * 16 + fr) * 136 + ks * 32 + fq * 8);
#pragma unroll
    for (int j = 0; j < 2; ++j) { const int vvb = vvb0 + j;
        f32x4 acc = (f32x4){lo16(o.uw[j].x), hi16(o.uw[j].x), lo16(o.uw[j].y), hi16(o.uw[j].y)};
#pragma unroll
        for (int ks = 0; ks < 4; ++ks) acc = MFMA16(o.wa[ks], sb[j][ks], acc);
        u32x2 w; w.x = pk2(acc[0], acc[1]); w.y = pk2(acc[2], acc[3]);
        *(LAS u32x2*)(VN + (vvb * 16 + fr) * 72 + pb * 16 + 4 * fq) = w; }
    __syncthreads();
#pragma unroll
    for (int j = 0; j < 2; ++j) { const int vvb = vvb0 + j; f32x4 acc = (f32x4){0.f, 0.f, 0.f, 0.f};
#pragma unroll
        for (int ks = 0; ks < 4; ++ks) { const bf16x8 sbr = *(const LAS bf16x8*)(Sc + (vvb * 16 + fr) * 136 + ks * 32 + fq * 8); acc = MFMA16(sbr, o.qa[ks], acc); }
#pragma unroll
        for (int ks = 0; ks < 2; ++ks) { const bf16x8 bv = *(const LAS bf16x8*)(VN + (vvb * 16 + fr) * 72 + ks * 32 + fq * 8); acc = MFMA16(bv, o.aa[ks], acc); }
        u32x2 w; w.x = pk2(acc[0], acc[1]); w.y = pk2(acc[2], acc[3]);
        *(LAS u32x2*)(OTc + (pb * 16 + fr) * 72 + vvb * 16 + 4 * fq) = w; }
    { const int kbw = pb * 2 + (kb0 >> 2);
#pragma unroll
        for (int j = 0; j < 4; ++j) { f32x4 acc = Sacc[j] * o.cd;
#pragma unroll
            for (int ks = 0; ks < 2; ++ks) { const bf16x8 va = *(const LAS bf16x8*)(VN + (j * 16 + fr) * 72 + ks * 32 + fq * 8); acc = MFMA16(o.kd[ks], va, acc); }
            Sacc[j] = acc;
            u32x2 w; w.x = pk2(acc[0], acc[1]); w.y = pk2(acc[2], acc[3]);
            *(LAS u32x2*)(Sn + (j * 16 + fr) * 136 + kbw * 16 + 4 * fq) = w; } }
}
__device__ __forceinline__ void gdn_scan_unit(const Frame& F, int b, int h, int d, int vs) {
    int tid = F.tid; asm volatile("" : "+v"(tid));
    size_t wz_ = 0; asm volatile("" : "+s"(wz_)); unsigned char* wsl = F.ws + wz_;
    const int lane = tid & 63, w = __builtin_amdgcn_readfirstlane(tid >> 6), fr = lane & 15, fq = lane >> 4;
    LAS bf16_t* ST = (LAS bf16_t*)(F.lds);
    LAS bf16_t* VN = (LAS bf16_t*)(F.lds + 34816);
    LAS bf16_t* OT = (LAS bf16_t*)(F.lds + 44032);
    const int pb = w >> 1, vvb0 = (w & 1) * 2, vb = w >> 1, kb0 = (w & 1) * 4;
    f32x4 Sacc[4];
#pragma unroll
    for (int j = 0; j < 4; ++j) Sacc[j] = (f32x4){0.f, 0.f, 0.f, 0.f};
    GdnOps A, B;
    gdn_ops_load(A, wsl, b, h, d, vs, 0, fr, fq, pb, vvb0, kb0);
    __syncthreads();
    for (int i = tid; i < 64 * 136 / 2; i += NTHR) ((LAS unsigned*)ST)[i] = 0u;
    __syncthreads();
    LAS bf16_t* S0 = ST; LAS bf16_t* S1 = ST + 64 * 136;
#pragma unroll 1
    for (int step = 0; step < NCH; step += 2) {
        gdn_ops_load(B, wsl, b, h, d, vs, step + 1, fr, fq, pb, vvb0, kb0);
        __builtin_amdgcn_sched_barrier(0);
        gdn_step(A, Sacc, S0, S1, VN, OT, wsl, b, h, d, vs, step, tid, fr, fq, pb, vvb0, vb, kb0);
        __syncthreads();
        if (step + 2 < NCH) gdn_ops_load(A, wsl, b, h, d, vs, step + 2, fr, fq, pb, vvb0, kb0);
        __builtin_amdgcn_sched_barrier(0);
        gdn_step(B, Sacc, S1, S0, VN, OT, wsl, b, h, d, vs, step + 1, tid, fr, fq, pb, vvb0, vb, kb0);
        __syncthreads();
    }
    gdn_flush(OT + ((NCH - 1) & 1) * (64 * 72), wsl, b, h, d, vs, NCH - 1, tid);
}

__device__ __forceinline__ void scan_pair_unit(const Frame& F, int ua, int ud) {
    int tid = F.tid; asm volatile("" : "+v"(tid));
    size_t wz_ = 0; asm volatile("" : "+s"(wz_)); unsigned char* wsl = F.ws + wz_;
    const int lane = tid & 63, w = __builtin_amdgcn_readfirstlane(tid >> 6), fr = lane & 15, fq = lane >> 4;
    const int vsA = ua & 3, dA = (ua >> 2) & 1, hAx = (ua >> 3) & 3, bA = ua >> 5;
    const int vsD = ud & 1, dD = (ud >> 1) & 1, hD = (ud >> 2) & 7, bD = ud >> 5;
    LAS bf16_t* STa = (LAS bf16_t*)(F.lds);
    LAS bf16_t* OTa = (LAS bf16_t*)(F.lds + 34816);
    LAS bf16_t* STd = (LAS bf16_t*)(F.lds + 53248);
    LAS bf16_t* VN = (LAS bf16_t*)(F.lds + 88064);
    LAS bf16_t* OTd = (LAS bf16_t*)(F.lds + 97280);
    const int pb = w >> 1, vvb0 = (w & 1) * 2, vb = w >> 1, kb0 = (w & 1) * 4, vbA = (w & 1) * 2, kbA = (w >> 1) * 2;
    f32x4 SaccA[4], SaccD[4];
#pragma unroll
    for (int j = 0; j < 4; ++j) { SaccA[j] = (f32x4){0.f, 0.f, 0.f, 0.f}; SaccD[j] = (f32x4){0.f, 0.f, 0.f, 0.f}; }
    GlaOps GA; GdnOps GD;
    gla_ops_load(GA, wsl, bA, hAx, dA, vsA, 0, fr, fq, pb, vvb0, vbA, kbA);
    u32x4 oldv = gla_old(wsl, bA, hAx, dA, vsA, 0, tid);
    __builtin_amdgcn_sched_barrier(0);
    gdn_ops_load(GD, wsl, bD, hD, dD, vsD, 0, fr, fq, pb, vvb0, kb0);
    __builtin_amdgcn_sched_barrier(0);
    __syncthreads();
    for (int i = tid; i < 64 * 136 / 2; i += NTHR) { ((LAS unsigned*)STa)[i] = 0u; ((LAS unsigned*)STd)[i] = 0u; }
    for (int i = tid; i < 64 * 72 / 2; i += NTHR) { ((LAS unsigned*)(OTa + 64 * 72))[i] = 0u; ((LAS unsigned*)(OTd + 64 * 72))[i] = 0u; }
    __syncthreads();
#pragma unroll 1
    for (int step = 0; step < NCH; ++step) {
        const int cur = step & 1;
        __builtin_amdgcn_sched_barrier(0);
        gla_step(GA, SaccA, STa + cur * (64 * 136), STa + (cur ^ 1) * (64 * 136), OTa, wsl, bA, hAx, dA, vsA, step, tid, fr, fq, pb, vvb0, vbA, kbA, oldv);
        __builtin_amdgcn_sched_barrier(0);
        __syncthreads();
        gla_ops_load(GA, wsl, bA, hAx, dA, vsA, step + 1 < NCH ? step + 1 : NCH - 1, fr, fq, pb, vvb0, vbA, kbA);
        __builtin_amdgcn_sched_barrier(0);
        gdn_step(GD, SaccD, STd + cur * (64 * 136), STd + (cur ^ 1) * (64 * 136), VN, OTd, wsl, bD, hD, dD, vsD, step, tid, fr, fq, pb, vvb0, vb, kb0);
        __syncthreads();
        oldv = gla_old(wsl, bA, hAx, dA, vsA, step, tid);
        __builtin_amdgcn_sched_barrier(0);
        gdn_ops_load(GD, wsl, bD, hD, dD, vsD, step + 1 < NCH ? step + 1 : NCH - 1, fr, fq, pb, vvb0, kb0);
        __builtin_amdgcn_sched_barrier(0);
    }
    gla_flush(OTa + ((NCH - 1) & 1) * (64 * 72), wsl, bA, hAx, dA, vsA, NCH - 1, tid, oldv);
    gdn_flush(OTd + ((NCH - 1) & 1) * (64 * 72), wsl, bD, hD, dD, vsD, NCH - 1, tid);
}

__device__ __forceinline__ void phase_merge_prep(const Frame& F, int l, int nrows) {
    int tid = F.tid; asm volatile("" : "+v"(tid));
    size_t wz_ = 0; asm volatile("" : "+s"(wz_)); unsigned char* wsl = F.ws + wz_;
    int bxl = F.bx; asm volatile("" : "+s"(bxl)); (void)bxl;
    const int lane = tid & 63, wave = __builtin_amdgcn_readfirstlane(tid >> 6); (void)lane; (void)wave;
    const bf16_t* __restrict__ P = (const bf16_t*)(wsl + WS_P);
    const bf16_t* __restrict__ oga = (const bf16_t*)(wsl + WS_OGLA); const bf16_t* __restrict__ ogd = (const bf16_t*)(wsl + WS_OGDN);
    bf16_t* __restrict__ yga = (bf16_t*)(wsl + WS_Y3); bf16_t* __restrict__ ygd = yga + 1024; bf16_t* __restrict__ pld = yga + 2048;
    const float* __restrict__ gnw = F.in[I_GLANW] + l * 256; const float* __restrict__ dnw = F.in[I_GDNNW] + l * 128;
    const int c0 = lane * 16;
#pragma unroll 2
    for (int r = bxl * 8 + wave; r < nrows; r += F.G * 8) {
        { float o[16], z[16], t8[8];
            const bf16_t* a0 = oga + (size_t)r * 1024 + c0; const bf16_t* a1 = a0 + (size_t)R * 1024;
            unpack8(*(const u32x4*)a0, t8);
#pragma unroll
            for (int i = 0; i < 8; ++i) o[i] = t8[i];
            unpack8(*(const u32x4*)(a0 + 8), t8);
#pragma unroll
            for (int i = 0; i < 8; ++i) o[8 + i] = t8[i];
            unpack8(*(const u32x4*)a1, t8);
#pragma unroll
            for (int i = 0; i < 8; ++i) o[i] += t8[i];
            unpack8(*(const u32x4*)(a1 + 8), t8);
#pragma unroll
            for (int i = 0; i < 8; ++i) o[8 + i] += t8[i];
            const bf16_t* zp = P + (size_t)r * NP + PC_GLA_Z + c0;
            unpack8(*(const u32x4*)zp, t8);
#pragma unroll
            for (int i = 0; i < 8; ++i) z[i] = t8[i];
            unpack8(*(const u32x4*)(zp + 8), t8);
#pragma unroll
            for (int i = 0; i < 8; ++i) z[8 + i] = t8[i];
            float ss = 0.f;
#pragma unroll
            for (int i = 0; i < 16; ++i) ss += o[i] * o[i];
#pragma unroll
            for (int q = 1; q < 16; q <<= 1) ss += shx(ss, q, lane);
            const float rs = rsqrtf(ss * (1.0f / 256.0f) + EPS); const int vv0 = (lane & 15) * 16;
            u32x4 w0, w1;
#pragma unroll
            for (int i = 0; i < 8; ++i) t8[i] = o[i] * rs * gnw[vv0 + i] * siluf_(z[i]);
            w0 = pack8(t8);
#pragma unroll
            for (int i = 0; i < 8; ++i) t8[i] = o[8 + i] * rs * gnw[vv0 + 8 + i] * siluf_(z[8 + i]);
            w1 = pack8(t8);
            *(u32x4*)(yga + (size_t)r * 3072 + c0) = w0; *(u32x4*)(yga + (size_t)r * 3072 + c0 + 8) = w1; }
        { float o[16], z[16], t8[8];
            const bf16_t* a0 = ogd + (size_t)r * 1024 + c0; const bf16_t* a1 = a0 + (size_t)R * 1024;
            unpack8(*(const u32x4*)a0, t8);
#pragma unroll
            for (int i = 0; i < 8; ++i) o[i] = t8[i];
            unpack8(*(const u32x4*)(a0 + 8), t8);
#pragma unroll
            for (int i = 0; i < 8; ++i) o[8 + i] = t8[i];
            unpack8(*(const u32x4*)a1, t8);
#pragma unroll
            for (int i = 0; i < 8; ++i) o[i] += t8[i];
            unpack8(*(const u32x4*)(a1 + 8), t8);
#pragma unroll
            for (int i = 0; i < 8; ++i) o[8 + i] += t8[i];
            const bf16_t* zp = P + (size_t)r * NP + PC_GDN_Z + c0;
            unpack8(*(const u32x4*)zp, t8);
#pragma unroll
            for (int i = 0; i < 8; ++i) z[i] = t8[i];
            unpack8(*(const u32x4*)(zp + 8), t8);
#pragma unroll
            for (int i = 0; i < 8; ++i) z[8 + i] = t8[i];
            float ss = 0.f;
#pragma unroll
            for (int i = 0; i < 16; ++i) ss += o[i] * o[i];
#pragma unroll
            for (int q = 1; q < 8; q <<= 1) ss += shx(ss, q, lane);
            const float rs = rsqrtf(ss * (1.0f / 128.0f) + EPS); const int vv0 = (lane & 7) * 16;
            u32x4 w0, w1;
#pragma unroll
            for (int i = 0; i < 8; ++i) t8[i] = o[i] * rs * dnw[vv0 + i] * siluf_(z[i]);
            w0 = pack8(t8);
#pragma unroll
            for (int i = 0; i < 8; ++i) t8[i] = o[8 + i] * rs * dnw[vv0 + 8 + i] * siluf_(z[8 + i]);
            w1 = pack8(t8);
            *(u32x4*)(ygd + (size_t)r * 3072 + c0) = w0; *(u32x4*)(ygd + (size_t)r * 3072 + c0 + 8) = w1; }
        { const int T = r < RL ? SEQ : CTXL, ts = r < RL ? (r & (SEQ - 1)) : ((r - RL) & (CTXL - 1)), segbase = r - ts;
            const int win = 2 << (lane >> 4), lo = max(ts - win / 2, 0), hi = min(ts - win / 2 + win, T);
            float s[16], t8[8];
#pragma unroll
            for (int i = 0; i < 16; ++i) s[i] = 0.f;
#pragma unroll
            for (int hb = 0; hb < 2; ++hb) { u32x4 ra[8], rb[8]; const u32x4 z4 = (u32x4){0u, 0u, 0u, 0u};
#pragma unroll
                for (int j = 0; j < 8; ++j) { const int t = lo + hb * 8 + j; const bool ok = t < hi; const bf16_t* up = P + (size_t)(segbase + (ok ? t : lo)) * NP + PC_POOL + c0;
                    ra[j] = ok ? *(const u32x4*)up : z4; rb[j] = ok ? *(const u32x4*)(up + 8) : z4; }
#pragma unroll
                for (int j = 0; j < 8; ++j) { unpack8(ra[j], t8);
#pragma unroll
                    for (int i = 0; i < 8; ++i) s[i] += t8[i];
                    unpack8(rb[j], t8);
#pragma unroll
                    for (int i = 0; i < 8; ++i) s[8 + i] += t8[i]; } }
            const float inv = 1.0f / (float)(hi - lo);
            const bf16_t* up = P + (size_t)r * NP + PC_POOL + c0;
            u32x4 w0, w1;
            unpack8(*(const u32x4*)up, t8);
#pragma unroll
            for (int i = 0; i < 8; ++i) t8[i] = s[i] * inv - t8[i];
            w0 = pack8(t8);
            unpack8(*(const u32x4*)(up + 8), t8);
#pragma unroll
            for (int i = 0; i < 8; ++i) t8[i] = s[8 + i] * inv - t8[i];
            w1 = pack8(t8);
            *(u32x4*)(pld + (size_t)r * 3072 + c0) = w0; *(u32x4*)(pld + (size_t)r * 3072 + c0 + 8) = w1; }
    }
}

template <int VAR> __device__ __forceinline__ void phase_convglu(const Frame& F, int l, int nrows) {
    int tid = F.tid; asm volatile("" : "+v"(tid));
    const int lane = tid & 63, wave = __builtin_amdgcn_readfirstlane(tid >> 6);
    size_t wz_ = 0; asm volatile("" : "+s"(wz_)); unsigned char* wsl = F.ws + wz_;
    int bxl = F.bx; asm volatile("" : "+s"(bxl));
    const bf16_t* av = (const bf16_t*)(wsl + WS_AV); bf16_t* gout = (bf16_t*)(wsl + WS_G) + (VAR ? (size_t)R * DFF : 0);
    const float* cw = F.in[I_FFNCONV] + (size_t)l * 9 * DFF;
    const int nit = (nrows > RL) ? 396 : 352, n4 = (nrows > RL) ? 348 : 224, nwi = n4 * 4 + (nit - n4) * 3;
    for (int wq = bxl; wq < nwi; wq += F.G) {
        int wi, xs, CSEG;
        if (wq < n4 * 4) { wi = wq >> 2; xs = (wq & 3) * 16; CSEG = 16; } else { const int e = wq - n4 * 4, sg = e % 3; wi = n4 + e / 3; xs = sg * 22; CSEG = sg < 2 ? 22 : 20; }
        int strip, ck;
        if (wi < 352) { ck = wi % 11; strip = (wi / 11) * 8 + wave; } else { ck = (wi - 352) % 11; strip = 256 + ((wi - 352) / 11) * 8 + wave; }
        const int c = (ck * 64 + lane) * 8;
        int row0, W, x0; bool up, dn;
        if (strip < 256) { const int gy = strip & 31; row0 = (strip >> 5) * SEQ + gy * 64; W = 64; x0 = xs; up = gy > 0; dn = gy < 31; }
        else { const int t = strip - 256; row0 = RL + (t >> 2) * CTXL; W = CTXL; x0 = (t & 3) * 64 + xs; up = false; dn = false; }
        float wt[9][8];
#pragma unroll
        for (int k = 0; k < 9; ++k) { const f32x4 w0 = *(const f32x4*)(cw + k * DFF + c), w1 = *(const f32x4*)(cw + k * DFF + c + 4);
#pragma unroll
            for (int i = 0; i < 4; ++i) { wt[k][i] = w0[i]; wt[k][4 + i] = w1[i]; } }
        const bf16_t* base = av + (size_t)row0 * NAV + c;
        const long rstep = (long)W * NAV;
        u32x4 win[3][3];
        const u32x4 zero4 = (u32x4){0u, 0u, 0u, 0u};
        const bool rok[3] = {up, true, dn};
#pragma unroll
        for (int r = 0; r < 3; ++r) { const bf16_t* rp = base + (long)(r - 1) * rstep;
            win[r][1] = (rok[r] && x0 > 0) ? *(const u32x4*)(rp + (long)(x0 - 1) * NAV) : zero4;
            win[r][2] = rok[r] ? *(const u32x4*)(rp + (long)x0 * NAV) : zero4; }
        u32x4 nw[2][3], vv[2];
#define CG_LOAD(XB) do { _Pragma("unroll") for (int j = 0; j < 2; ++j) { _Pragma("unroll") for (int r = 0; r < 3; ++r) \
            nw[j][r] = (rok[r] && ((XB) + j + 1 < W) && ((XB) + j < x0 + CSEG)) ? *(const u32x4*)(base + (long)(r - 1) * rstep + (long)((XB) + j + 1) * NAV) : zero4; \
            vv[j] = ((XB) + j < x0 + CSEG) ? *(const u32x4*)(base + (long)((XB) + j) * NAV + DFF) : zero4; } } while (0)
        CG_LOAD(x0);
        for (int xb = x0; xb < x0 + CSEG; xb += 2) {
            u32x4 cw_[2][3], cv[2];
#pragma unroll
            for (int j = 0; j < 2; ++j) { cv[j] = vv[j];
#pragma unroll
                for (int r = 0; r < 3; ++r) cw_[j][r] = nw[j][r]; }
            CG_LOAD(xb + 2);
#pragma unroll
            for (int j = 0; j < 2; ++j) {
                float acc[8];
#pragma unroll
                for (int i = 0; i < 8; ++i) acc[i] = 0.f;
#pragma unroll
                for (int r = 0; r < 3; ++r) { win[r][0] = win[r][1]; win[r][1] = win[r][2]; win[r][2] = cw_[j][r];
#pragma unroll
                    for (int dx = 0; dx < 3; ++dx) { float f8[8]; unpack8(win[r][dx], f8);
#pragma unroll
                        for (int i = 0; i < 8; ++i) acc[i] += f8[i] * wt[r * 3 + dx][i]; } }
                float v8[8]; unpack8(cv[j], v8);
#pragma unroll
                for (int i = 0; i < 8; ++i) v8[i] = (VAR == 2) ? acc[i] * v8[i] : acc[i] * __builtin_amdgcn_rcpf(1.0f + __expf(-acc[i])) * v8[i];
                if (VAR != 3 || acc[0] == 12345.f) *(u32x4*)(gout + (size_t)(row0 + xb + j) * DFF + c) = pack8(v8); }
        }
#undef CG_LOAD
    }
}

#ifndef PROBE_MASK
#define PROBE_MASK 0u
#endif
#ifndef PROBE_MULT
#define PROBE_MULT 1
#endif
#define PT0(id) do { if (PROBE_MASK & (1u << (id))) pt0 = wall_clock64(); } while (0)
#define PT1(id) do { if (PROBE_MASK & (1u << (id))) pacc += wall_clock64() - pt0; } while (0)
__global__ void __launch_bounds__(512, 2) fwd(Args args) {
    extern __shared__ __attribute__((aligned(16))) unsigned char lds_raw[];
    Frame F;
    F.lds = (LAS unsigned char*)lds_raw; F.ws = args.ws; F.in = args.in; F.out = args.out;
    F.tid = threadIdx.x; F.lane = F.tid & 63; F.wave = __builtin_amdgcn_readfirstlane(F.tid >> 6); F.G = gridDim.x; F.bx = blockIdx.x;
    volatile LAS unsigned* misc = (volatile LAS unsigned*)(F.lds + MISC_OFF);
    if (F.tid < 4) misc[F.tid] = 0u;
    __syncthreads();
    XcdBarrier bar = xcd_barrier_post((unsigned*)(F.ws + WS_CTL), misc);
    unsigned char* ws = F.ws; int bx = F.bx;
#define mods ((float*)(ws + WS_MODS))
#define xres ((bf16_t*)(ws + WS_XRES))
#define hA ((bf16_t*)(ws + WS_HA))
#define P ((bf16_t*)(ws + WS_P))
#define small ((float*)(ws + WS_SMALL))

    unsigned long long pt0 = 0, pacc = 0; (void)pt0;
    PT0(0);
#ifndef SK_MODS
    phase_mods(F);
#endif
    PT1(0);
    for (int l = 0; l < DEPTH; ++l) {
        const bool last = (l == DEPTH - 1);
        const int Mrows = last ? RL : R;
        const float* mods_l = mods + (size_t)l * 9 * 12288;
        PT0(1);
#ifndef SK_W
        if (l == 0) phase_weights(F, 0, 0, bx, F.G);
#endif
        PT1(1);
        if (l == 0) { PT0(0); xcd_barrier(bar); phase_mods_reduce(F); xcd_barrier(bar); PT1(0); }
        PT0(2);
        if (l == 0) phase_norm<true>(F, F.in[I_X], F.in[I_CTX], xres, F.in[I_N1W] + l * D, mods_l, 0, hA, R);
        else phase_norm<false>(F, xres, xres + (size_t)RL * D, nullptr, F.in[I_N1W] + l * D, mods_l, 0, hA, R);
        xcd_barrier(bar);
        { size_t wz_ = 0; asm volatile("" : "+s"(wz_)); ws = F.ws + wz_; } asm volatile("" : "+s"(bx));
        PT1(2);
        PT0(3);
        { pg8::Sched S; S.init(hA, D, 0, ws + WS_WIN, D, 0, last ? RL : R, NIN, 1, F.G, bx);
          if (last) { S.xtra = 8 * 15; S.xpm0 = RL / 256; }
          pg8::EpiInProj E{P, small};
#if !defined(SK_GEMM) && !defined(SK_GEMM0)
          pg8::gemm_phase<decltype(E), 4>(F.lds, D, D, D, S, E);
#endif
          }
        { const int TAIL = (last ? (RL / 256 * (NIN / 256) + 8 * 15) : (R / 256 * (NIN / 256))) % 256;
          if (F.G == 256 && bx >= TAIL) phase_weights(F, l, 1, bx - TAIL, 256 - TAIL); else if (F.G != 256) phase_weights(F, l, 1, bx, F.G); }
        xcd_barrier(bar);
        { size_t wz_ = 0; asm volatile("" : "+s"(wz_)); ws = F.ws + wz_; } asm volatile("" : "+s"(bx));
        PT1(3);
        PT0(4);
#ifndef SK_GLAPREP
        for (int u = bx; u < NB * NCH * 4 * 2; u += F.G) { const int d = u & 1, h = (u >> 1) & 3, ch = (u >> 3) % NCH, b = (u >> 3) / NCH; gla_prep_unit(F, l, b, ch, h, d); }
#endif
        PT1(4); PT0(5);
#ifndef SK_GDNPREP
        for (int u = bx; u < NB * NCH * 8; u += F.G) { const int h = u & 7, ch = (u >> 3) % NCH, b = (u >> 3) / NCH; const unsigned long long dt_ = gdn_prep_unit(F, l, b, ch, h); if (PROBE_GDN) pacc += dt_; }
#endif
        xcd_barrier(bar);
        { size_t wz_ = 0; asm volatile("" : "+s"(wz_)); ws = F.ws + wz_; } asm volatile("" : "+s"(bx));
        PT1(5);
        PT0(6);
#if !defined(SK_GLASCAN) && !defined(SK_GDNSCAN)
        for (int u = bx; u < 256; u += F.G) { const int xx = u & 7, yy = u >> 3; scan_pair_unit(F, (((yy >> 2) * 8 + xx) << 2) | (yy & 3), (((yy >> 1) * 8 + xx) << 1) | (yy & 1)); }
#endif
        PT1(6); PT0(7);
        xcd_barrier(bar);
        { size_t wz_ = 0; asm volatile("" : "+s"(wz_)); ws = F.ws + wz_; } asm volatile("" : "+s"(bx));
        PT1(7);
        PT0(8);
#ifndef SK_MERGE
        phase_merge_prep(F, l, Mrows);
#endif
        xcd_barrier(bar);
        { size_t wz_ = 0; asm volatile("" : "+s"(wz_)); ws = F.ws + wz_; } asm volatile("" : "+s"(bx));
        PT1(8);
        PT0(9);
        PT1(9); PT0(10);
        if (!last) { pg8::Sched S; S.init(ws + WS_Y3, 3072, 0, ws + WS_WBR, 3072, 0, Mrows, D, 1, F.G, bx, 192);
          pg8::EpiBranch<3> E{P, hA};
          pg8::gemm_phase<decltype(E), 3>(F.lds, 3072, 3072, 3072, S, E); }
        else { pg8::Sched S; S.init(ws + WS_Y3, 3072, 0, ws + WS_WBR, 3072, 0, Mrows, D, 1, F.G, bx);
          pg8::EpiBranch<4> E{P, hA};
          pg8::gemm_phase<decltype(E), 4>(F.lds, 3072, 3072, 3072, S, E); }
        xcd_barrier(bar);
        { size_t wz_ = 0; asm volatile("" : "+s"(wz_)); ws = F.ws + wz_; } asm volatile("" : "+s"(bx));
        PT1(10);
        PT0(12);
        if (!last) { pg8::Sched S; S.init(hA, D, 0, ws + WS_WOUT, D, 0, Mrows, D, 1, F.G, bx, 192);
          pg8::EpiResid<3> E{xres, mods_l + 2 * D};
          pg8::gemm_phase<decltype(E), 3>(F.lds, D, D, D, S, E); }
        else { pg8::Sched S; S.init(hA, D, 0, ws + WS_WOUT, D, 0, Mrows, D, 1, F.G, bx);
          pg8::EpiResid<4> E{xres, mods_l + 2 * D};
          pg8::gemm_phase<decltype(E), 4>(F.lds, D, D, D, S, E); }
        xcd_barrier(bar);
        { size_t wz_ = 0; asm volatile("" : "+s"(wz_)); ws = F.ws + wz_; } asm volatile("" : "+s"(bx));
        PT1(12);
        PT0(13);
        phase_norm<false>(F, xres, xres + (size_t)RL * D, nullptr, F.in[I_N2W] + l * D, mods_l, 3, hA, Mrows);
        xcd_barrier(bar);
        { size_t wz_ = 0; asm volatile("" : "+s"(wz_)); ws = F.ws + wz_; } asm volatile("" : "+s"(bx));
        PT1(13);
        PT0(14);
        { pg8::Sched S; S.init(hA, D, 0, ws + WS_WUP, D, 0, Mrows, NAV, 1, F.G, bx);
          pg8::EpiBf16 E{(bf16_t*)(ws + WS_AV), NAV};
#if !defined(SK_GEMM) && !defined(SK_GEMM6)
          pg8::gemm_phase<decltype(E), 4>(F.lds, D, D, D, S, E);
#endif
          }
        if (!last) { constexpr int TAIL = (R / 256 * (NAV / 256)) % 256;
          if (F.G == 256 && bx >= TAIL) phase_weights(F, l + 1, 0, bx - TAIL, 256 - TAIL); else if (F.G != 256) phase_weights(F, l + 1, 0, bx, F.G); }
        xcd_barrier(bar);
        { size_t wz_ = 0; asm volatile("" : "+s"(wz_)); ws = F.ws + wz_; } asm volatile("" : "+s"(bx));
        PT1(14);
        PT0(15);
#ifndef SK_CONV
        phase_convglu<0>(F, l, Mrows);
#if defined(CONV_ABL)
        phase_convglu<CONV_ABL>(F, l, Mrows);
#endif
#endif
        xcd_barrier(bar);
        { size_t wz_ = 0; asm volatile("" : "+s"(wz_)); ws = F.ws + wz_; } asm volatile("" : "+s"(bx));
        PT1(15);
        PT0(16);
        if (!last) { pg8::Sched S; S.init(ws + WS_G, DFF, 0, ws + WS_WDN, DFF, 0, Mrows, D, 1, F.G, bx, 192);
          pg8::EpiResid<3> E{xres, mods_l + 5 * D};
          pg8::gemm_phase<decltype(E), 3>(F.lds, DFF, DFF, DFF, S, E); }
        else { pg8::Sched S; S.init(ws + WS_G, DFF, 0, ws + WS_WDN, DFF, 0, Mrows, D, 1, F.G, bx);
          pg8::EpiResid<4> E{xres, mods_l + 5 * D};
          pg8::gemm_phase<decltype(E), 4>(F.lds, DFF, DFF, DFF, S, E); }
        xcd_barrier(bar);
        { size_t wz_ = 0; asm volatile("" : "+s"(wz_)); ws = F.ws + wz_; } asm volatile("" : "+s"(bx));
        PT1(16);
    }
    if (PROBE_MASK || PROBE_GDN) { const unsigned long long w0 = wall_clock64(); while (wall_clock64() - w0 < pacc * PROBE_MULT) __builtin_amdgcn_s_sleep(8); }
    phase_final_norm(F, xres, F.in[I_FINALW], F.out);
#undef mods
#undef xres
#undef hA
#undef P
#undef small
}

extern "C" void kernel_launch(void* const* d_in, const int* in_sizes, int n_in, void* d_out, int out_size, void* d_ws, size_t ws_size, hipStream_t stream) {
    static int grid = 0;
    if (grid == 0) {
        if (n_in != 26 || in_sizes[0] != RL * D || out_size != RL * D || ws_size < WS_END) { fprintf(stderr, "kernel_launch: unexpected shapes / workspace (%zu needed, %zu given)\n", (size_t)WS_END, ws_size); grid = -1; return; }
        int dev = 0, cus = 0, per_cu = 0;
        if (hipGetDevice(&dev) != hipSuccess || hipDeviceGetAttribute(&cus, hipDeviceAttributeMultiprocessorCount, dev) != hipSuccess) { grid = -1; return; }
        if (hipFuncSetAttribute((const void*)fwd, hipFuncAttributeMaxDynamicSharedMemorySize, LDS_BYTES) != hipSuccess) { fprintf(stderr, "kernel_launch: hipFuncSetAttribute failed\n"); grid = -1; return; }
        if (hipOccupancyMaxActiveBlocksPerMultiprocessor(&per_cu, (const void*)fwd, NTHR, LDS_BYTES) != hipSuccess || per_cu < 1) { fprintf(stderr, "kernel_launch: occupancy query says %d\n", per_cu); (void)hipGetLastError(); grid = -1; return; }
        grid = cus;
    }
    if (grid < 0) return;
    if (hipMemsetAsync((char*)d_ws + WS_CTL, 0, ZERO_BYTES, stream) != hipSuccess) return;
    Args a{};
    for (int i = 0; i < 26; ++i) a.in[i] = (const float*)d_in[i];
    a.out = (float*)d_out; a.ws = (unsigned char*)d_ws;
    hipLaunchKernelGGL(fwd, dim3(grid), dim3(NTHR), LDS_BYTES, stream, a);
}
```

```cpp
#include <hip/hip_runtime.h>
#include <cstdio>
#include <cstdint>

#define LAS __attribute__((address_space(3)))
#ifndef PROBE_GDN
#define PROBE_GDN 0
#endif
typedef unsigned short bf16_t;
typedef short bf16x8 __attribute__((ext_vector_type(8)));
typedef float f32x4 __attribute__((ext_vector_type(4)));
typedef unsigned u32x4 __attribute__((ext_vector_type(4)));
typedef unsigned u32x2 __attribute__((ext_vector_type(2)));

constexpr int D = 2048, NB = 8, SEQ = 2048, CTXL = 256, DEPTH = 4;
constexpr int RL = NB * SEQ, RC = NB * CTXL, R = RL + RC;
constexpr int NP = 14336, NIN = 14592, NIN_ORIG = 14400;
constexpr int DFF = 5632, NAV = 2 * DFF;
constexpr int PC_GLA_Q = 0, PC_GLA_K = 512, PC_GLA_V = 1024, PC_GLA_Z = 2048, PC_GDN_Q = 3072, PC_GDN_K = 4096, PC_GDN_V = 5120, PC_GDN_Z = 6144, PC_POOL = 7168, PC_GATE = 8192;
constexpr int NCH = 36;
constexpr float EPS = 1e-6f;
constexpr int NTHR = 512;

constexpr size_t al256(size_t x) { return (x + 255) & ~(size_t)255; }
constexpr size_t WS_CTL = 0;
constexpr size_t CTL_BYTES = 65536;
constexpr size_t WS_MODS = WS_CTL + CTL_BYTES;
constexpr size_t MODS_BYTES = (size_t)DEPTH * 9 * 12288 * 4;
constexpr size_t ZERO_BYTES = CTL_BYTES;
constexpr size_t WS_SMALL = al256(WS_MODS + MODS_BYTES);
constexpr size_t WS_XRES = al256(WS_SMALL + (size_t)R * 64 * 4);
constexpr size_t WS_HA = al256(WS_XRES + (size_t)R * D * 4);
constexpr size_t WS_WIN = al256(WS_HA + (size_t)R * D * 2);
constexpr size_t WS_WBR = al256(WS_WIN + (size_t)NIN * D * 2);
constexpr size_t WS_WOUT = al256(WS_WBR + (size_t)3 * D * 1024 * 2);
constexpr size_t WS_WUP = al256(WS_WOUT + (size_t)D * D * 2);
constexpr size_t WS_WDN = al256(WS_WUP + (size_t)NAV * D * 2);
constexpr size_t WS_WPOOL = al256(WS_WDN + (size_t)D * DFF * 2);
constexpr size_t WS_BIG = al256(WS_WPOOL + (size_t)4 * 256 * 256 * 2);
constexpr size_t WS_P = WS_BIG;
constexpr size_t WS_MODP = WS_BIG;
constexpr size_t GLA_UNIT = 66048, GDN_UNIT = 73984;
constexpr size_t WS_GLAPREP = al256(WS_P + (size_t)R * NP * 2);
constexpr size_t WS_GDNPREP = al256(WS_GLAPREP + (size_t)NB * NCH * 4 * 2 * GLA_UNIT);
constexpr size_t GDNPREP_BYTES = (size_t)NB * NCH * 8 * 2 * GDN_UNIT;
constexpr size_t WS_OGLA = al256(WS_GDNPREP + GDNPREP_BYTES);
constexpr size_t WS_OGDN = al256(WS_OGLA + (size_t)2 * R * 1024 * 2);
constexpr size_t WS_MIX_END = al256(WS_OGDN + (size_t)2 * R * 1024 * 2);
constexpr size_t WS_Y3 = WS_GDNPREP;
constexpr size_t WS_PLD = WS_Y3 + (size_t)R * 3072 * 2;
static_assert(WS_PLD + (size_t)R * 1024 * 2 <= WS_GDNPREP + GDNPREP_BYTES, "overlay");
constexpr size_t WS_AV = WS_BIG;
constexpr size_t WS_G = al256(WS_AV + (size_t)R * NAV * 2);
static_assert(WS_G + (size_t)R * DFF * 2 <= WS_MIX_END, "ffn overlay");
constexpr size_t WS_END = WS_MIX_END;

constexpr int LDS_BYTES = 131072 + 1024;
constexpr int MISC_OFF = 131072;

__device__ __forceinline__ float bf2f(bf16_t b) { return __uint_as_float(((unsigned)b) << 16); }
typedef float f32x2_t __attribute__((ext_vector_type(2)));
typedef __bf16 bf16x2_t __attribute__((ext_vector_type(2)));
__device__ __forceinline__ unsigned pk2(float lo, float hi) { const f32x2_t v = {lo, hi}; const bf16x2_t b = __builtin_convertvector(v, bf16x2_t); return __builtin_bit_cast(unsigned, b); }
__device__ __forceinline__ bf16_t f2bf(float f) { return (bf16_t)(pk2(f, 0.f) & 0xFFFFu); }
__device__ __forceinline__ float lo16(unsigned w) { return __uint_as_float(w << 16); }
__device__ __forceinline__ float hi16(unsigned w) { return __uint_as_float(w & 0xFFFF0000u); }
__device__ __forceinline__ float sigmoidf_(float x) { return __builtin_amdgcn_rcpf(1.0f + __expf(-x)); }
__device__ __forceinline__ float siluf_(float x) { return x * __builtin_amdgcn_rcpf(1.0f + __expf(-x)); }
__device__ __forceinline__ float softplusf_(float x) { return x > 20.f ? x : __logf(1.0f + __expf(x)); }
__device__ __forceinline__ float logsigf_(float z) { return fminf(z, 0.f) - __logf(1.0f + __expf(-fabsf(z))); }
__device__ __forceinline__ void unpack8(const u32x4 w, float (&f)[8]) { f[0] = lo16(w.x); f[1] = hi16(w.x); f[2] = lo16(w.y); f[3] = hi16(w.y); f[4] = lo16(w.z); f[5] = hi16(w.z); f[6] = lo16(w.w); f[7] = hi16(w.w); }
__device__ __forceinline__ u32x4 pack8(const float (&f)[8]) { u32x4 w; w.x = pk2(f[0], f[1]); w.y = pk2(f[2], f[3]); w.z = pk2(f[4], f[5]); w.w = pk2(f[6], f[7]); return w; }
typedef _Float16 h16x8_t __attribute__((ext_vector_type(8)));
typedef float f32x8_t __attribute__((ext_vector_type(8)));
__device__ __forceinline__ void unpack8h(const u32x4 w, float (&f)[8]) { const f32x8_t v = __builtin_convertvector(__builtin_bit_cast(h16x8_t, w), f32x8_t);
#pragma unroll
    for (int i = 0; i < 8; ++i) f[i] = v[i]; }
__device__ __forceinline__ u32x4 pack8h(const float (&f)[8]) { f32x8_t v;
#pragma unroll
    for (int i = 0; i < 8; ++i) v[i] = f[i];
    return __builtin_bit_cast(u32x4, __builtin_convertvector(v, h16x8_t)); }
__device__ __forceinline__ float shx(float v, int o, int lane) { return __int_as_float(__builtin_amdgcn_ds_bpermute((lane ^ o) << 2, __float_as_int(v))); }
__device__ __forceinline__ float shup(float v, int o, int lane) { return __int_as_float(__builtin_amdgcn_ds_bpermute((lane - o) << 2, __float_as_int(v))); }
__device__ __forceinline__ int frag_off(int row, int k, int KT) { return ((((row >> 4) * KT + (k >> 5)) << 9) + ((((k >> 3) & 3) << 4) + (row & 15)) * 8 + (k & 7)); }
__device__ __forceinline__ int frag_tile(int rb, int ks, int KT, int lane) { return (((rb * KT + ks) << 9) + lane * 8); }
#define MFMA16(a, b, c) __builtin_amdgcn_mfma_f32_16x16x32_bf16((a), (b), (c), 0, 0, 0)

#define XB_TMO      128
#define XB_XCNT(j)  (256  + 64 * (j))
#define XB_XSUB(j)  (1280 + 64 * (j))
#define XB_XGEN(j)  (2304 + 64 * (j))
#define XB_TOP      3328
#define XB_TOPGEN   3392
#define XCD_BAR_WORDS 3456
#define XB_SPIN_CAP (1u << 22)
__device__ __forceinline__ unsigned xb_ld(unsigned* p)              { return __hip_atomic_load(p, __ATOMIC_RELAXED, __HIP_MEMORY_SCOPE_AGENT); }
__device__ __forceinline__ unsigned xb_add(unsigned* p, unsigned v) { return __hip_atomic_fetch_add(p, v, __ATOMIC_RELAXED, __HIP_MEMORY_SCOPE_AGENT); }
__device__ __forceinline__ unsigned xb_xcc_id() { return (unsigned)__builtin_amdgcn_s_getreg((3 << 11) | 20) & 0xFu; }
#define XB_SPIN(cond, bar) do { unsigned _sp = 0; while (cond) { __builtin_amdgcn_s_sleep(1); \
    if ((++_sp & 255u) == 0u) { if (xb_ld(&(bar)[XB_TMO])) break; if (_sp > XB_SPIN_CAP) { atomicAdd(&(bar)[XB_TMO], 1u); break; } } } } while (0)
struct XcdBarrier { unsigned* bar; unsigned x; volatile LAS unsigned* st; };
__device__ __forceinline__ XcdBarrier xcd_barrier_post(unsigned* bar, volatile LAS unsigned* st) {
    XcdBarrier b; b.bar = bar; b.x = xb_xcc_id(); b.st = st;
    if (threadIdx.x == 0) (void)xb_add(&bar[XB_XCNT(b.x)], 1u);
    return b;
}
__device__ __forceinline__ void xcd_barrier_complete(unsigned* bar, unsigned x, unsigned& nloc, unsigned& nx) {
    const unsigned G = gridDim.x * gridDim.y * gridDim.z;
    unsigned sum, cnt, mine, sp = 0u;
    for (;;) {
        sum = 0u; cnt = 0u; mine = 0u;
#pragma unroll
        for (unsigned j = 0; j < 16; ++j) { const unsigned c = xb_ld(&bar[XB_XCNT(j)]); sum += c; cnt += (c > 0u) ? 1u : 0u; }
        mine = xb_ld(&bar[XB_XCNT(x)]);
        if (sum == G) break;
        __builtin_amdgcn_s_sleep(1);
        if ((++sp & 255u) == 0u) { if (xb_ld(&bar[XB_TMO])) break; if (sp > XB_SPIN_CAP) { atomicAdd(&bar[XB_TMO], 1u); break; } }
    }
    nloc = mine > 0u ? mine : 1u; nx = cnt > 0u ? cnt : 1u;
}
__device__ __forceinline__ void xcd_barrier(const XcdBarrier& b) {
    asm volatile("s_waitcnt vmcnt(0)" ::: "memory");
    __syncthreads();
    if (threadIdx.x == 0) {
        unsigned bz_ = 0; asm volatile("" : "+s"(bz_)); unsigned* bar = b.bar + bz_;
        __builtin_amdgcn_s_waitcnt(0);
        unsigned nloc = b.st[0], nx = b.st[1];
        if (nloc == 0u) { xcd_barrier_complete(bar, b.x, nloc, nx); b.st[0] = nloc; b.st[1] = nx; }
        const unsigned old = xb_add(&bar[XB_XSUB(b.x)], 1u);
        const unsigned gen = old / nloc;
        if (old + 1u == (gen + 1u) * nloc) {
            __builtin_amdgcn_fence(__ATOMIC_RELEASE, "agent");
            asm volatile("s_waitcnt vmcnt(0)" ::: "memory");
            const unsigned og = xb_add(&bar[XB_TOP], 1u);
            const unsigned tg = og / nx;
            if (og + 1u == (tg + 1u) * nx) xb_add(&bar[XB_TOPGEN], 1u);
            else XB_SPIN(xb_ld(&bar[XB_TOPGEN]) == tg, bar);
            __builtin_amdgcn_fence(__ATOMIC_ACQUIRE, "agent");
            xb_add(&bar[XB_XGEN(b.x)], 1u);
            asm volatile("s_waitcnt vmcnt(0)" ::: "memory");
        } else {
            XB_SPIN(xb_ld(&bar[XB_XGEN(b.x)]) == gen, bar);
            __builtin_amdgcn_fence(__ATOMIC_ACQUIRE, "agent");
            asm volatile("s_waitcnt vmcnt(0)" ::: "memory");
        }
    }
    __syncthreads();
}

namespace pg8 {
constexpr int BM = 256, BK = 64, HALF = 128, HTB = HALF * BK * 2, STAGE_BYTES = 8 * HTB, NXCD = 8, WGM = 8;
__device__ __forceinline__ int lds_byte(int r, int c) { const int st = (r >> 4) * 2 + (c >> 5), rr = r & 15, cc = c & 31, ob = rr * 64 + cc * 2; return st * 1024 + (ob ^ (((ob >> 9) & 1) << 5)); }
__device__ __forceinline__ void stage_rc(int b, int& R_, int& C_) { const int st = b / 1024, sb = b % 1024, swz = sb ^ (((sb >> 9) & 1) << 5); R_ = (st >> 1) * 16 + swz / 64; C_ = (st & 1) * 32 + (swz % 64) / 2; }
__device__ __forceinline__ int perm32(int rho) { const int n = rho >> 4, i = rho & 15; return 8 * (i >> 2) + 4 * n + (i & 3); }
struct Unit { int pm, pn, z; const char* a; const char* b; };
struct Sched {
    int nM, nN, nZ, per, G, c, xtra, xpm0; const char* A; const char* B; size_t sA, sB, zA, zB;
    __device__ __forceinline__ void init(const void* A_, int lda, size_t zA_, const void* B_, int ldb, size_t zB_, int M, int N, int nZ_, int G_, int c_, int bm = BM) {
        nM = M / bm; nN = N / BM; nZ = nZ_; per = nM * nN; G = G_; c = c_; xtra = 0; xpm0 = 0; A = (const char*)A_; B = (const char*)B_; sA = (size_t)bm * lda * 2; sB = (size_t)BM * ldb * 2; zA = zA_; zB = zB_; }
    __device__ __forceinline__ bool next(int i, Unit& u) const {
        const long L = (long)i * G + c; if (L >= (long)per * nZ + xtra) return false;
        if (L >= (long)per * nZ) { const int e = (int)(L - (long)per * nZ), idx = e % 15;
            u.pm = xpm0 + e / 15; u.pn = idx < 6 ? 2 + idx : (idx < 14 ? 10 + idx : 56); u.z = 0;
            u.a = A + (size_t)u.pm * sA; u.b = B + (size_t)u.pn * sB; return true; }
        const int z = (int)(L / per); int wgid = (int)(L % per);
        { const int q = per / NXCD, r = per % NXCD, xcd = wgid % NXCD, off = wgid / NXCD; wgid = (xcd < r ? xcd * (q + 1) : r * (q + 1) + (xcd - r) * q) + off; }
        const int nig = WGM * nN, gid = wgid / nig, fm = gid * WGM, gsz = (nM - fm) < WGM ? (nM - fm) : WGM;
        u.pm = fm + ((wgid % nig) % gsz); u.pn = (wgid % nig) / gsz; u.z = z;
        u.a = A + (size_t)z * zA + (size_t)u.pm * sA; u.b = B + (size_t)z * zB + (size_t)u.pn * sB; return true;
    }
};
__device__ __forceinline__ unsigned cvt_pk_bf16(float lo, float hi) { return pk2(lo, hi); }
__device__ __forceinline__ u32x4 pack_acc(const f32x4 v0, const f32x4 v1) { u32x4 w; w.x = cvt_pk_bf16(v0[0], v0[1]); w.y = cvt_pk_bf16(v0[2], v0[3]); w.z = cvt_pk_bf16(v1[0], v1[1]); w.w = cvt_pk_bf16(v1[2], v1[3]); return w; }

template <class E, class = void> struct has_rescale { static constexpr bool value = false; };
template <class E> struct has_rescale<E, decltype((void)E::HAS_RESCALE)> { static constexpr bool value = true; };
template <class Epi, int MT>
__device__ __forceinline__ void gemm_phase(LAS unsigned char* lds, const int K, const int lda, const int ldb, const Sched& S, const Epi& E) {
    int tid = threadIdx.x; asm volatile("" : "+v"(tid));
    const int wid = __builtin_amdgcn_readfirstlane(tid >> 6), lane = tid & 63, wr = wid >> 2, wc = wid & 3, fr = lane & 15, fq = lane >> 4;
    const int nt = K / BK; constexpr int HA = MT * 32;
    unsigned voffA[2], voffB[2];
#pragma unroll
    for (int i = 0; i < 2; ++i) { int R_, C_; stage_rc(tid * 16 + i * 8192, R_, C_); const int Rb = (R_ & ~31) + perm32(R_ & 31);
        const int Ra = R_ < HA ? R_ : HA - 1;
        voffA[i] = (unsigned)(Ra * lda + C_) * 2u; voffB[i] = (unsigned)(Rb * ldb + C_) * 2u; }
    const size_t kstep = (size_t)(BK * 2);
    const size_t hstepA = (size_t)HA * lda * 2, hstepB = (size_t)HALF * ldb * 2;
    const unsigned ldsw = (unsigned)wid * 1024u;
    const int aoff = lds_byte(wr * (MT * 16) + fr, fq * 8), boff = lds_byte(wc * 32 + fr, fq * 8);
#define PG8_SA(b, h) (((b) * 2 + (h)) * HTB)
#define PG8_SB(b, h) ((4 + (b) * 2 + (h)) * HTB)
#define PG8_STAGE(bufoff, gbase, voff) do { _Pragma("unroll") for (int _i = 0; _i < 2; ++_i) \
        __builtin_amdgcn_global_load_lds((const unsigned*)((const char*)(gbase) + (voff)[_i]), (LAS unsigned*)(lds + (bufoff) + ldsw + _i * 8192), 16, 0, 0); } while (0)
#define PG8_STAGE_A(bufoff, gbase) do { __builtin_amdgcn_global_load_lds((const unsigned*)((const char*)(gbase) + voffA[0]), (LAS unsigned*)(lds + (bufoff) + ldsw), 16, 0, 0); \
        if (!(MT == 3 && wr == 1)) __builtin_amdgcn_global_load_lds((const unsigned*)((const char*)(gbase) + voffA[1]), (LAS unsigned*)(lds + (bufoff) + ldsw + 8192), 16, 0, 0); } while (0)
#define PG8_WAIT_VX(full, half) do { if (MT == 3 && wr == 1) asm volatile("s_waitcnt vmcnt(" #half ")" ::: "memory"); else asm volatile("s_waitcnt vmcnt(" #full ")" ::: "memory"); } while (0)
#define PG8_LDA(dst, b, h) do { _Pragma("unroll") for (int m = 0; m < MT; ++m) _Pragma("unroll") for (int k = 0; k < 2; ++k) dst[m][k] = *(const LAS bf16x8*)(lds + PG8_SA(b, h) + aoff + m * 2048 + k * 1024); } while (0)
#define PG8_LDB(dst, b, h) do { _Pragma("unroll") for (int n = 0; n < 2; ++n) _Pragma("unroll") for (int k = 0; k < 2; ++k) dst[n][k] = *(const LAS bf16x8*)(lds + PG8_SB(b, h) + boff + n * 2048 + k * 1024); } while (0)
#define PG8_MMA(ai, bj, At, Bt) do { __builtin_amdgcn_s_setprio(1); _Pragma("unroll") for (int m = 0; m < MT; ++m) _Pragma("unroll") for (int n = 0; n < 2; ++n) _Pragma("unroll") for (int k = 0; k < 2; ++k) \
        acc[ai][bj][m][n] = __builtin_amdgcn_mfma_f32_16x16x32_bf16(Bt[n][k], At[m][k], acc[ai][bj][m][n], 0, 0, 0); __builtin_amdgcn_s_setprio(0); } while (0)
#define PG8_WAIT_V(n) asm volatile("s_waitcnt vmcnt(" #n ")" ::: "memory")
#define PG8_WAIT_L(n) asm volatile("s_waitcnt lgkmcnt(" #n ")" ::: "memory")
#define PG8_BAR __builtin_amdgcn_s_barrier()
#define PG8_SCHED __builtin_amdgcn_sched_barrier(0)
    Unit cur, nxt; int ui = 0;
    if (!S.next(0, cur)) return;
    f32x4 acc[2][2][MT][2];
#pragma unroll
    for (int a = 0; a < 2; ++a)
#pragma unroll
        for (int b = 0; b < 2; ++b)
#pragma unroll
            for (int m = 0; m < MT; ++m)
#pragma unroll
                for (int n = 0; n < 2; ++n) acc[a][b][m][n] = (f32x4){0.f, 0.f, 0.f, 0.f};
    bf16x8 At[MT][2], B0[2][2], B1[2][2];
    const char* cA = cur.a; const char* cB = cur.b;
    PG8_STAGE(PG8_SB(0, 0), cB, voffB); PG8_STAGE(PG8_SB(0, 1), cB + hstepB, voffB); PG8_STAGE_A(PG8_SA(0, 0), cA); PG8_STAGE_A(PG8_SA(0, 1), cA + hstepA);
    if (wr == 1) PG8_BAR;
    PG8_WAIT_VX(2, 1); PG8_BAR;
    PG8_STAGE(PG8_SB(1, 0), cB + kstep, voffB); PG8_STAGE_A(PG8_SA(1, 0), cA + kstep); PG8_STAGE(PG8_SB(1, 1), cB + hstepB + kstep, voffB);
    PG8_WAIT_VX(6, 5); PG8_BAR;
    for (;;) {
        const bool has_next = S.next(ui + 1, nxt);
        const char* nA = has_next ? nxt.a : cA; const char* nB = has_next ? nxt.b : cB;
#pragma unroll 1
        for (int t = 0; t < nt; t += 2) {
            const bool last = (t == nt - 2);
            if constexpr (has_rescale<Epi>::value) { if (t == 16 || t == 32) E.rescale(acc, cur, wr, wc, fr, fq, (t >> 4) - 1); }
            const char* a1 = cA + (size_t)(t + 1) * kstep;
            const char* a2 = last ? nA : cA + (size_t)(t + 2) * kstep; const char* b2 = last ? nB : cB + (size_t)(t + 2) * kstep;
            const char* a3 = a2 + kstep; const char* b3 = b2 + kstep;
            PG8_LDB(B0, 0, 0); PG8_LDB(B1, 0, 1); PG8_SCHED; PG8_LDA(At, 0, 0); PG8_STAGE_A(PG8_SA(1, 1), a1 + hstepA);
            PG8_WAIT_VX(8, 6); PG8_WAIT_L(0); PG8_BAR; PG8_MMA(0, 0, At, B0); PG8_MMA(0, 1, At, B1); PG8_BAR; PG8_SCHED;
            PG8_LDA(At, 0, 1); PG8_STAGE(PG8_SB(0, 0), b2, voffB); PG8_STAGE(PG8_SB(0, 1), b2 + hstepB, voffB); PG8_STAGE_A(PG8_SA(0, 0), a2);
            PG8_WAIT_VX(8, 6); PG8_WAIT_L(0); PG8_BAR; PG8_MMA(1, 0, At, B0); PG8_MMA(1, 1, At, B1); PG8_BAR; PG8_SCHED;
            PG8_LDB(B0, 1, 0); PG8_LDB(B1, 1, 1); PG8_SCHED; PG8_LDA(At, 1, 0); PG8_STAGE_A(PG8_SA(0, 1), a2 + hstepA);
            PG8_WAIT_VX(8, 6); PG8_WAIT_L(0); PG8_BAR; PG8_MMA(0, 0, At, B0); PG8_MMA(0, 1, At, B1); PG8_BAR; PG8_SCHED;
            PG8_LDA(At, 1, 1); PG8_STAGE(PG8_SB(1, 0), b3, voffB); PG8_STAGE(PG8_SB(1, 1), b3 + hstepB, voffB); PG8_STAGE_A(PG8_SA(1, 0), a3);
            PG8_WAIT_VX(8, 6); PG8_WAIT_L(0); PG8_BAR; PG8_MMA(1, 0, At, B0); PG8_MMA(1, 1, At, B1); PG8_BAR; PG8_SCHED;
        }
        if (wr == 0) PG8_BAR;
        E(acc, cur, wr, wc, fr, fq);
        if (!has_next) break;
        { float zz = 0.f; asm volatile("" : "+v"(zz));
#pragma unroll
        for (int a = 0; a < 2; ++a)
#pragma unroll
            for (int b = 0; b < 2; ++b)
#pragma unroll
                for (int m = 0; m < MT; ++m)
#pragma unroll
                    for (int n = 0; n < 2; ++n) acc[a][b][m][n] = (f32x4){zz, zz, zz, zz}; }
        cur = nxt; cA = nA; cB = nB; ++ui;
        if (wr == 1) PG8_BAR;
    }
    PG8_WAIT_V(0);
    PG8_BAR;
#undef PG8_SA
#undef PG8_SB
#undef PG8_STAGE
#undef PG8_STAGE_A
#undef PG8_WAIT_VX
#undef PG8_LDA
#undef PG8_LDB
#undef PG8_MMA
#undef PG8_WAIT_V
#undef PG8_WAIT_L
#undef PG8_BAR
#undef PG8_SCHED
}

struct EpiInProj {
    bf16_t* P; float* small;
    __device__ __forceinline__ void operator()(const f32x4 (&acc)[2][2][4][2], const Unit& u, int wr, int wc, int fr, int fq) const {
        const int row0 = u.pm * BM + wr * 64 + fr;
        if (u.pn < 56) {
            const int col0 = u.pn * BM + wc * 32 + 8 * fq;
#pragma unroll
            for (int ai = 0; ai < 2; ++ai)
#pragma unroll
                for (int m = 0; m < 4; ++m) { bf16_t* rowp = P + (size_t)(row0 + ai * HALF + m * 16) * NP + col0;
#pragma unroll
                    for (int bj = 0; bj < 2; ++bj) *(u32x4*)(rowp + bj * HALF) = pack_acc(acc[ai][bj][m][0], acc[ai][bj][m][1]); }
        } else if (wc < 2) {
            const int col0 = wc * 32 + 8 * fq;
#pragma unroll
            for (int ai = 0; ai < 2; ++ai)
#pragma unroll
                for (int m = 0; m < 4; ++m) { float* rowp = small + (size_t)(row0 + ai * HALF + m * 16) * 64 + col0;
                    *(f32x4*)rowp = acc[ai][0][m][0]; *(f32x4*)(rowp + 4) = acc[ai][0][m][1]; }
        }
    }
};
struct EpiBf16 {
    bf16_t* O; int ldc;
    __device__ __forceinline__ void operator()(const f32x4 (&acc)[2][2][4][2], const Unit& u, int wr, int wc, int fr, int fq) const {
        const int row0 = u.pm * BM + wr * 64 + fr, col0 = u.pn * BM + wc * 32 + 8 * fq;
#pragma unroll
        for (int ai = 0; ai < 2; ++ai)
#pragma unroll
            for (int m = 0; m < 4; ++m) { bf16_t* rowp = O + (size_t)(row0 + ai * HALF + m * 16) * ldc + col0;
#pragma unroll
                for (int bj = 0; bj < 2; ++bj) *(u32x4*)(rowp + bj * HALF) = pack_acc(acc[ai][bj][m][0], acc[ai][bj][m][1]); }
    }
};
struct EpiPool {
    bf16_t* O; const float* scale;
    __device__ __forceinline__ void operator()(const f32x4 (&acc)[2][2][4][2], const Unit& u, int wr, int wc, int fr, int fq) const {
        const int row0 = u.pm * BM + wr * 64 + fr, col0 = u.z * 256 + wc * 32 + 8 * fq;
        f32x4 sv[2][2];
#pragma unroll
        for (int bj = 0; bj < 2; ++bj) { sv[bj][0] = *(const f32x4*)(scale + col0 + bj * HALF); sv[bj][1] = *(const f32x4*)(scale + col0 + bj * HALF + 4); }
#pragma unroll
        for (int ai = 0; ai < 2; ++ai)
#pragma unroll
            for (int m = 0; m < 4; ++m) { bf16_t* rowp = O + (size_t)(row0 + ai * HALF + m * 16) * 3072 + col0;
#pragma unroll
                for (int bj = 0; bj < 2; ++bj) *(u32x4*)(rowp + bj * HALF) = pack_acc(acc[ai][bj][m][0] * sv[bj][0], acc[ai][bj][m][1] * sv[bj][1]); }
    }
};
template <int MT> struct EpiBranch {
    static constexpr bool HAS_RESCALE = true;
    const bf16_t* P; bf16_t* mbf;
    __device__ __forceinline__ void rescale(f32x4 (&acc)[2][2][MT][2], const Unit& u, int wr, int wc, int fr, int fq, int seg) const {
        int row0 = u.pm * (MT * 64) + wr * (MT * 16) + fr, col0 = u.pn * BM + wc * 32 + 8 * fq;
        asm volatile("" : "+v"(row0), "+v"(col0));
#pragma unroll
        for (int ai = 0; ai < 2; ++ai) {
            u32x4 ra[MT][2], rb[MT][2];
#pragma unroll
            for (int m = 0; m < MT; ++m)
#pragma unroll
                for (int bj = 0; bj < 2; ++bj) { const bf16_t* gp = P + (size_t)(row0 + ai * (MT * 32) + m * 16) * NP + PC_GATE + seg * 2048 + col0 + bj * HALF;
                    ra[m][bj] = *(const u32x4*)gp; rb[m][bj] = *(const u32x4*)(gp + 2048); }
            __builtin_amdgcn_sched_barrier(0);
#pragma unroll
            for (int m = 0; m < MT; ++m)
#pragma unroll
                for (int bj = 0; bj < 2; ++bj) { float ga[8], gb[8]; unpack8(ra[m][bj], ga); unpack8(rb[m][bj], gb);
#pragma unroll
                    for (int j = 0; j < 4; ++j) { acc[ai][bj][m][0][j] *= (1.0f + __expf(-gb[j])) * __builtin_amdgcn_rcpf(1.0f + __expf(-ga[j]));
                        acc[ai][bj][m][1][j] *= (1.0f + __expf(-gb[4 + j])) * __builtin_amdgcn_rcpf(1.0f + __expf(-ga[4 + j])); } }
            __builtin_amdgcn_sched_barrier(0); }
    }
    __device__ __forceinline__ void operator()(const f32x4 (&acc)[2][2][MT][2], const Unit& u, int wr, int wc, int fr, int fq) const {
        const int row0 = u.pm * (MT * 64) + wr * (MT * 16) + fr, col0 = u.pn * BM + wc * 32 + 8 * fq;
#pragma unroll
        for (int ai = 0; ai < 2; ++ai) {
            u32x4 gr[MT][2];
#pragma unroll
            for (int m = 0; m < MT; ++m)
#pragma unroll
                for (int bj = 0; bj < 2; ++bj) gr[m][bj] = *(const u32x4*)(P + (size_t)(row0 + ai * (MT * 32) + m * 16) * NP + PC_GATE + 2 * 2048 + col0 + bj * HALF);
            __builtin_amdgcn_sched_barrier(0);
#pragma unroll
            for (int m = 0; m < MT; ++m) { const size_t row = (size_t)(row0 + ai * (MT * 32) + m * 16);
#pragma unroll
                for (int bj = 0; bj < 2; ++bj) { const int col = col0 + bj * HALF;
                    float g[8]; unpack8(gr[m][bj], g);
                    f32x4 v0 = acc[ai][bj][m][0], v1 = acc[ai][bj][m][1];
#pragma unroll
                    for (int j = 0; j < 4; ++j) { v0[j] *= sigmoidf_(g[j]); v1[j] *= sigmoidf_(g[4 + j]); }
                    *(u32x4*)(mbf + row * D + col) = pack_acc(v0, v1); } }
            __builtin_amdgcn_sched_barrier(0); }
    }
};
template <int MT> struct EpiResid {
    bf16_t* X; const float* gates;
    __device__ __forceinline__ void operator()(const f32x4 (&acc)[2][2][MT][2], const Unit& u, int wr, int wc, int fr, int fq) const {
        const int row0 = u.pm * (MT * 64) + wr * (MT * 16) + fr, col0 = u.pn * BM + wc * 32 + 8 * fq;
#pragma unroll
        for (int ai = 0; ai < 2; ++ai)
#pragma unroll
            for (int mp = 0; mp < MT; mp += 2) {
                u32x4 xv[2][2]; f32x4 gv[2][2][2];
#pragma unroll
                for (int q = 0; q < 2; ++q) if (mp + q < MT) { const int row = row0 + ai * (MT * 32) + (mp + q) * 16; const int j = row < RL ? (row >> 11) : 8;
                    const float* gp = gates + (size_t)j * 12288 + col0; const bf16_t* rowp = X + (size_t)row * D + col0;
#pragma unroll
                    for (int bj = 0; bj < 2; ++bj) { xv[q][bj] = *(const u32x4*)(rowp + bj * HALF);
                        gv[q][bj][0] = *(const f32x4*)(gp + bj * HALF); gv[q][bj][1] = *(const f32x4*)(gp + bj * HALF + 4); } }
                __builtin_amdgcn_sched_barrier(0);
#pragma unroll
                for (int q = 0; q < 2; ++q) if (mp + q < MT) { const int row = row0 + ai * (MT * 32) + (mp + q) * 16; bf16_t* rowp = X + (size_t)row * D + col0;
#pragma unroll
                    for (int bj = 0; bj < 2; ++bj) { float xf[8]; unpack8h(xv[q][bj], xf);
#pragma unroll
                        for (int e = 0; e < 4; ++e) { xf[e] += gv[q][bj][0][e] * acc[ai][bj][mp + q][0][e]; xf[4 + e] += gv[q][bj][1][e] * acc[ai][bj][mp + q][1][e]; }
                        *(u32x4*)(rowp + bj * HALF) = pack8h(xf); } }
                __builtin_amdgcn_sched_barrier(0); }
    }
};
}

struct Args { const float* in[26]; float* out; unsigned char* ws; };
struct Frame {
    LAS unsigned char* lds; unsigned char* ws; const float* const* in; float* out;
    int tid, lane, wave, G, bx;
};
enum { I_X = 0, I_C, I_CTX, I_CCTX, I_ADAW, I_ADAB, I_N1W, I_N2W, I_WIN, I_LRW2, I_LRB, I_GLANW, I_CONVW, I_ALOG, I_DTB, I_GDNNW, I_POOLW, I_POOLS, I_WBRGLA, I_WBRGDN, I_WBRPOOL, I_WOUT, I_FFNUP, I_FFNCONV, I_FFNDOWN, I_FINALW };

__device__ __forceinline__ void phase_mods(const Frame& F) {
    int tid = F.tid; asm volatile("" : "+v"(tid));
    size_t wz_ = 0; asm volatile("" : "+s"(wz_)); unsigned char* wsl = F.ws + wz_;
    int bxl = F.bx; asm volatile("" : "+s"(bxl)); (void)bxl;
    const int lane = tid & 63, wave = __builtin_amdgcn_readfirstlane(tid >> 6); (void)lane; (void)wave;
    LAS float* sc = (LAS float*)F.lds;
    const float* c = F.in[I_C]; const float* cc = F.in[I_CCTX]; const float* aw = F.in[I_ADAW];
    float* part = (float*)(wsl + WS_MODP);
    for (int u = bxl; u < DEPTH * 24 * 8; u += F.G) {
        const int ks = u % 8, cb = (u / 8) % 24, l = u / 192;
        __syncthreads();
        for (int i = tid; i < 9 * 256; i += NTHR) { const int j = i / 256, k = i % 256; const float cv = (j < 8) ? c[j * D + ks * 256 + k] : cc[ks * 256 + k]; sc[i] = siluf_(cv); }
        __syncthreads();
        const int c4 = (tid & 127) * 4, kq = tid >> 7;
        const float* w = aw + ((size_t)l * D + ks * 256 + kq * 64) * 12288 + cb * 512 + c4;
        f32x4 acc[9];
#pragma unroll
        for (int j = 0; j < 9; ++j) acc[j] = (f32x4){0.f, 0.f, 0.f, 0.f};
#pragma unroll 1
        for (int k0 = 0; k0 < 64; k0 += 8) { f32x4 wv[8];
#pragma unroll
            for (int q = 0; q < 8; ++q) wv[q] = *(const f32x4*)(w + (size_t)(k0 + q) * 12288);
#pragma unroll
            for (int j = 0; j < 9; ++j) { const f32x4 s0 = *(const LAS f32x4*)(sc + j * 256 + kq * 64 + k0), s1 = *(const LAS f32x4*)(sc + j * 256 + kq * 64 + k0 + 4);
#pragma unroll
                for (int q = 0; q < 4; ++q) { acc[j] += wv[q] * s0[q]; acc[j] += wv[4 + q] * s1[q]; } } }
        LAS float* red = (LAS float*)(F.lds + 16384);
#pragma unroll
        for (int j = 0; j < 9; ++j) *(LAS f32x4*)(red + (kq * 9 + j) * 512 + c4) = acc[j];
        __syncthreads();
#pragma unroll
        for (int j = 0; j < 9; ++j) { const float v = (red[(0 * 9 + j) * 512 + tid] + red[(1 * 9 + j) * 512 + tid]) + (red[(2 * 9 + j) * 512 + tid] + red[(3 * 9 + j) * 512 + tid]);
            part[(size_t)ks * (DEPTH * 9 * 12288) + ((size_t)l * 9 + j) * 12288 + cb * 512 + tid] = v; }
    }
    __syncthreads();
}
__device__ __forceinline__ void phase_mods_reduce(const Frame& F) {
    int tid = F.tid; asm volatile("" : "+v"(tid));
    size_t wz_ = 0; asm volatile("" : "+s"(wz_)); unsigned char* wsl = F.ws + wz_;
    int bxl = F.bx; asm volatile("" : "+s"(bxl));
    const float* part = (const float*)(wsl + WS_MODP); float* mods = (float*)(wsl + WS_MODS); const float* ab = F.in[I_ADAB];
    for (int i = bxl * NTHR + tid; i < DEPTH * 9 * 12288; i += F.G * NTHR) {
        const int l = i / (9 * 12288), col = i % 12288;
        float pv[8];
#pragma unroll
        for (int ks = 0; ks < 8; ++ks) pv[ks] = part[(size_t)ks * (DEPTH * 9 * 12288) + i];
        float s = ab[l * 12288 + col];
        __builtin_amdgcn_sched_barrier(0);
#pragma unroll
        for (int ks = 0; ks < 8; ++ks) s += pv[ks];
        mods[i] = s; }
}

__device__ __forceinline__ int map_in_col(int n) {
    if (n < 3072) return n;
    if (n < 3104) return NP + (n - 3072);
    if (n < 6176) return n - 32;
    if (n < 6192) return NP + 32 + (n - 6176);
    if (n < 6208) return NP + 48 + (n - 6192);
    return n - 64;
}
__device__ __forceinline__ void wtile4(const Frame& F, const float* src, int N, bf16_t* dst, int K, int kt, int nt0, int cnt, bool perm_in) {
    int tid = F.tid; asm volatile("" : "+v"(tid));
    LAS float* t = (LAS float*)F.lds;
    const int kk = tid >> 3, seg = (tid & 7) * 8;
    const float* s0 = src + (size_t)(kt * 64 + kk) * N + nt0 * 64 + seg;
    f32x4 v0[4], v1[4];
#pragma unroll
    for (int q = 0; q < 4; ++q) if (q < cnt) { v0[q] = *(const f32x4*)(s0 + q * 64); v1[q] = *(const f32x4*)(s0 + q * 64 + 4); }
    __syncthreads();
#pragma unroll
    for (int q = 0; q < 4; ++q) if (q < cnt) {
#pragma unroll
        for (int i = 0; i < 4; ++i) { t[q * 4160 + kk * 65 + seg + i] = v0[q][i]; t[q * 4160 + kk * 65 + seg + 4 + i] = v1[q][i]; } }
    __syncthreads();
    const int nn = tid >> 3, kseg = (tid & 7) * 8;
#pragma unroll
    for (int q = 0; q < 4; ++q) if (q < cnt) { float f[8];
#pragma unroll
        for (int i = 0; i < 8; ++i) f[i] = t[q * 4160 + (kseg + i) * 65 + nn];
        const int n = (nt0 + q) * 64 + nn, np = perm_in ? map_in_col(n) : n;
        *(u32x4*)(dst + (size_t)np * K + kt * 64 + kseg) = pack8(f); }
}
__device__ __forceinline__ void wfold_pool(const Frame& F, int l, int g, int nt, bf16_t* Wbr) {
    int tid = F.tid; asm volatile("" : "+v"(tid));
    const int lane = tid & 63, w = __builtin_amdgcn_readfirstlane(tid >> 6), fr = lane & 15, fq = lane >> 4;
    LAS bf16_t* Bt = (LAS bf16_t*)F.lds;
    const float* wp = F.in[I_WBRPOOL] + (size_t)l * 1024 * D + (size_t)(g * 256) * D + nt * 64;
    const float* pw = F.in[I_POOLW] + ((size_t)l * 4 + g) * 65536;
    const int d = tid >> 1, hf = (tid & 1) * 32;
    f32x4 v[8];
#pragma unroll
    for (int q = 0; q < 8; ++q) v[q] = *(const f32x4*)(wp + (size_t)d * D + hf + q * 4);
    const float sc = F.in[I_POOLS][l * 1024 + g * 256 + d];
    __syncthreads();
#pragma unroll
    for (int q = 0; q < 8; ++q)
#pragma unroll
        for (int i = 0; i < 4; ++i) Bt[(hf + q * 4 + i) * 264 + d] = f2bf(v[q][i] * sc);
    __syncthreads();
#pragma unroll 1
    for (int cbi = 0; cbi < 2; ++cbi) { const int cb = w * 2 + cbi;
        f32x4 a0[8], a1[8];
#pragma unroll
        for (int ks = 0; ks < 8; ++ks) { const float* ap = pw + (size_t)(cb * 16 + fr) * 256 + ks * 32 + fq * 8; a0[ks] = *(const f32x4*)ap; a1[ks] = *(const f32x4*)(ap + 4); }
        bf16x8 af[8];
#pragma unroll
        for (int ks = 0; ks < 8; ++ks) { u32x4 pk; pk.x = pk2(a0[ks][0], a0[ks][1]); pk.y = pk2(a0[ks][2], a0[ks][3]); pk.z = pk2(a1[ks][0], a1[ks][1]); pk.w = pk2(a1[ks][2], a1[ks][3]); af[ks] = __builtin_bit_cast(bf16x8, pk); }
#pragma unroll
        for (int nb = 0; nb < 4; ++nb) { f32x4 acc = (f32x4){0.f, 0.f, 0.f, 0.f};
#pragma unroll
            for (int ks = 0; ks < 8; ++ks) { const bf16x8 bfr = *(const LAS bf16x8*)(Bt + (nb * 16 + fr) * 264 + ks * 32 + fq * 8); acc = MFMA16(af[ks], bfr, acc); }
            u32x2 ov; ov.x = pk2(acc[0], acc[1]); ov.y = pk2(acc[2], acc[3]);
            *(u32x2*)(Wbr + (size_t)(nt * 64 + nb * 16 + fr) * 3072 + 2048 + g * 256 + cb * 16 + 4 * fq) = ov; } }
}
__device__ __forceinline__ void phase_weights(const Frame& F, int l, int set, int r, int n) {
    int tid = F.tid; asm volatile("" : "+v"(tid));
    size_t wz_ = 0; asm volatile("" : "+s"(wz_)); unsigned char* wsl = F.ws + wz_;
    asm volatile("" : "+s"(r));
    bf16_t* Win = (bf16_t*)(wsl + WS_WIN); bf16_t* Wbr = (bf16_t*)(wsl + WS_WBR); bf16_t* Wout = (bf16_t*)(wsl + WS_WOUT);
    bf16_t* Wup = (bf16_t*)(wsl + WS_WUP); bf16_t* Wdn = (bf16_t*)(wsl + WS_WDN);
    constexpr int G_IN = 32 * 57, G_BR = 16 * 8, G_OUT = 32 * 8, G_UP = 32 * 44, G_DN = 88 * 8;
    constexpr int O_BR = G_IN, O_OUT = O_BR + 3 * G_BR, O_UP = O_OUT + G_OUT, O_DN = O_UP + G_UP, G_ALL = O_DN + G_DN;
    const int lo = set ? O_UP : 0, hi = set ? G_ALL : O_UP;
    for (int u = lo + r; u < hi; u += n) {
        if (u < O_BR) { const int kt = u / 57, g4 = u % 57; wtile4(F, F.in[I_WIN] + (size_t)l * D * NIN_ORIG, NIN_ORIG, Win, D, kt, g4 * 4, g4 < 56 ? 4 : 1, true); }
        else if (u < O_BR + 2 * G_BR) { const int v = u - O_BR, br = v / G_BR, w = v % G_BR; wtile4(F, F.in[I_WBRGLA + br] + (size_t)l * 1024 * D, D, Wbr + br * 1024, 3072, w / 8, (w % 8) * 4, 4, false); }
        else if (u < O_OUT) { const int v = u - O_BR - 2 * G_BR; wfold_pool(F, l, v >> 5, v & 31, Wbr); }
        else if (u < O_UP) { const int v = u - O_OUT; wtile4(F, F.in[I_WOUT] + (size_t)l * D * D, D, Wout, D, v / 8, (v % 8) * 4, 4, false); }
        else if (u < O_DN) { const int v = u - O_UP; wtile4(F, F.in[I_FFNUP] + (size_t)l * D * NAV, NAV, Wup, D, v / 44, (v % 44) * 4, 4, false); }
        else { const int v = u - O_DN; wtile4(F, F.in[I_FFNDOWN] + (size_t)l * DFF * D, D, Wdn, DFF, v / 8, (v % 8) * 4, 4, false); }
    }
    if (set == 0) {
      u32x4* z = (u32x4*)(Win + (size_t)NIN_ORIG * D); const int n16 = (NIN - NIN_ORIG) * D * 2 / 16;
      unsigned zz = 0u; asm volatile("" : "+v"(zz));
      for (int i = r * NTHR + tid; i < n16; i += n * NTHR) z[i] = (u32x4){zz, zz, zz, zz}; }
    __syncthreads();
}

template <bool IN32> __device__ __forceinline__ void phase_norm(const Frame& F, const void* xl_, const void* xc_, bf16_t* xcopy, const float* nw, const float* mods_l, int sh, bf16_t* out, int nrows) {
    int tid = F.tid; asm volatile("" : "+v"(tid));
    size_t wz_ = 0; asm volatile("" : "+s"(wz_)); unsigned char* wsl = F.ws + wz_;
    int bxl = F.bx; asm volatile("" : "+s"(bxl)); (void)bxl; (void)wsl;
    const int lane = tid & 63, wave = __builtin_amdgcn_readfirstlane(tid >> 6);
    f32x4 wv[8];
#pragma unroll
    for (int i = 0; i < 8; ++i) wv[i] = *(const f32x4*)(nw + (i >> 1) * 512 + lane * 8 + (i & 1) * 4);
    if constexpr (!IN32) {
        const bf16_t* xl = (const bf16_t*)xl_; const bf16_t* xc = (const bf16_t*)xc_;
        const int nwv = F.G * 8, nper = (nrows + nwv - 1) / nwv, r0 = (bxl * 8 + wave) * nper, r1 = (r0 + nper < nrows) ? r0 + nper : nrows;
        if (r0 < r1) {
            int jc = -1; f32x4 gq[8], sq[8]; u32x4 rwA[4], rwB[4];
#pragma unroll
            for (int i = 0; i < 8; ++i) { gq[i] = (f32x4){0.f, 0.f, 0.f, 0.f}; sq[i] = gq[i]; }
            { const int ra = r0, rb = (r0 + 1 < r1) ? r0 + 1 : r0;
                const bf16_t* pa = (ra < RL) ? xl + (size_t)ra * D : xc + (size_t)(ra - RL) * D; const bf16_t* pb = (rb < RL) ? xl + (size_t)rb * D : xc + (size_t)(rb - RL) * D;
#pragma unroll
                for (int k = 0; k < 4; ++k) { rwA[k] = *(const u32x4*)(pa + k * 512 + lane * 8); rwB[k] = *(const u32x4*)(pb + k * 512 + lane * 8); } }
#pragma unroll 1
            for (int r = r0; r < r1; ++r) {
                u32x4 cur[4];
#pragma unroll
                for (int k = 0; k < 4; ++k) { cur[k] = rwA[k]; rwA[k] = rwB[k]; }
                { const int rn = (r + 2 < r1) ? r + 2 : r1 - 1; const bf16_t* pn = (rn < RL) ? xl + (size_t)rn * D : xc + (size_t)(rn - RL) * D;
#pragma unroll
                    for (int k = 0; k < 4; ++k) rwB[k] = *(const u32x4*)(pn + k * 512 + lane * 8); }
                const int j = (r < RL) ? (r >> 11) : 8;
                if (j != jc) { jc = j; const float* shp = mods_l + (size_t)j * 12288 + sh * D; const float* scp = shp + D;
#pragma unroll
                    for (int i = 0; i < 8; ++i) { const int c = (i >> 1) * 512 + lane * 8 + (i & 1) * 4; const f32x4 s1 = *(const f32x4*)(scp + c); sq[i] = *(const f32x4*)(shp + c); gq[i] = wv[i] * (1.0f + s1); } }
                __builtin_amdgcn_sched_barrier(0);
                f32x4 v[8]; float ss = 0.f;
#pragma unroll
                for (int k = 0; k < 4; ++k) { float f8[8]; unpack8h(cur[k], f8); v[2 * k] = (f32x4){f8[0], f8[1], f8[2], f8[3]}; v[2 * k + 1] = (f32x4){f8[4], f8[5], f8[6], f8[7]}; }
#pragma unroll
                for (int i = 0; i < 8; ++i) ss += v[i][0] * v[i][0] + v[i][1] * v[i][1] + v[i][2] * v[i][2] + v[i][3] * v[i][3];
#pragma unroll
                for (int o = 32; o >= 1; o >>= 1) ss += shx(ss, o, lane);
                const float rs = rsqrtf(ss * (1.0f / D) + EPS);
#pragma unroll
                for (int k = 0; k < 4; ++k) { float y[8];
#pragma unroll
                    for (int q = 0; q < 4; ++q) { y[q] = v[2 * k][q] * rs * gq[2 * k][q] + sq[2 * k][q]; y[4 + q] = v[2 * k + 1][q] * rs * gq[2 * k + 1][q] + sq[2 * k + 1][q]; }
                    *(u32x4*)(out + (size_t)r * D + k * 512 + lane * 8) = pack8(y); }
            } }
        return; }
    for (int r = bxl * 8 + wave; r < nrows; r += F.G * 8) {
        const int j = (r < RL) ? (r >> 11) : 8;
        const float* shp = mods_l + (size_t)j * 12288 + sh * D; const float* scp = shp + D;
        f32x4 v[8], s1v[8], s0v[8]; float ss = 0.f;
        if constexpr (IN32) { const float* xr = (r < RL) ? (const float*)xl_ + (size_t)r * D : (const float*)xc_ + (size_t)(r - RL) * D;
#pragma unroll
            for (int i = 0; i < 8; ++i) v[i] = *(const f32x4*)(xr + (i >> 1) * 512 + lane * 8 + (i & 1) * 4);
        } else { const bf16_t* xr = (r < RL) ? (const bf16_t*)xl_ + (size_t)r * D : (const bf16_t*)xc_ + (size_t)(r - RL) * D;
            u32x4 rw[4];
#pragma unroll
            for (int k = 0; k < 4; ++k) rw[k] = *(const u32x4*)(xr + k * 512 + lane * 8);
#pragma unroll
            for (int k = 0; k < 4; ++k) { float f8[8]; unpack8h(rw[k], f8); v[2 * k] = (f32x4){f8[0], f8[1], f8[2], f8[3]}; v[2 * k + 1] = (f32x4){f8[4], f8[5], f8[6], f8[7]}; } }
#pragma unroll
        for (int i = 0; i < 8; ++i) { const int c = (i >> 1) * 512 + lane * 8 + (i & 1) * 4; s1v[i] = *(const f32x4*)(scp + c); s0v[i] = *(const f32x4*)(shp + c); }
        __builtin_amdgcn_sched_barrier(0);
#pragma unroll
        for (int i = 0; i < 8; ++i) ss += v[i][0] * v[i][0] + v[i][1] * v[i][1] + v[i][2] * v[i][2] + v[i][3] * v[i][3];
#pragma unroll
        for (int o = 32; o >= 1; o >>= 1) ss += shx(ss, o, lane);
        const float rs = rsqrtf(ss * (1.0f / D) + EPS);
#pragma unroll
        for (int k = 0; k < 4; ++k) { const int c = k * 512 + lane * 8;
            if constexpr (IN32) { float f8[8];
#pragma unroll
                for (int q = 0; q < 4; ++q) { f8[q] = v[2 * k][q]; f8[4 + q] = v[2 * k + 1][q]; }
                *(u32x4*)(xcopy + (size_t)r * D + c) = pack8h(f8); }
            float y[8];
#pragma unroll
            for (int q = 0; q < 4; ++q) { y[q] = v[2 * k][q] * rs * wv[2 * k][q] * (1.0f + s1v[2 * k][q]) + s0v[2 * k][q]; y[4 + q] = v[2 * k + 1][q] * rs * wv[2 * k + 1][q] * (1.0f + s1v[2 * k + 1][q]) + s0v[2 * k + 1][q]; }
            *(u32x4*)(out + (size_t)r * D + c) = pack8(y); }
    }
}
__device__ __forceinline__ void phase_final_norm(const Frame& F, const bf16_t* x, const float* nw, float* out) {
    int tid = F.tid; asm volatile("" : "+v"(tid));
    size_t wz_ = 0; asm volatile("" : "+s"(wz_)); unsigned char* wsl = F.ws + wz_;
    int bxl = F.bx; asm volatile("" : "+s"(bxl)); (void)bxl; (void)wsl;
    const int lane = tid & 63, wave = __builtin_amdgcn_readfirstlane(tid >> 6);
    f32x4 wv[8];
#pragma unroll
    for (int i = 0; i < 8; ++i) wv[i] = *(const f32x4*)(nw + (i >> 1) * 512 + lane * 8 + (i & 1) * 4);
    const int nwv = F.G * 8, nper = (RL + nwv - 1) / nwv, r0 = (bxl * 8 + wave) * nper, r1 = (r0 + nper < RL) ? r0 + nper : RL;
    if (r0 >= r1) return;
    u32x4 rwA[4], rwB[4];
    { const int rb = (r0 + 1 < r1) ? r0 + 1 : r0;
#pragma unroll
        for (int k = 0; k < 4; ++k) { rwA[k] = *(const u32x4*)(x + (size_t)r0 * D + k * 512 + lane * 8); rwB[k] = *(const u32x4*)(x + (size_t)rb * D + k * 512 + lane * 8); } }
#pragma unroll 1
    for (int r = r0; r < r1; ++r) {
        u32x4 rw[4];
#pragma unroll
        for (int k = 0; k < 4; ++k) { rw[k] = rwA[k]; rwA[k] = rwB[k]; }
        { const int rn = (r + 2 < r1) ? r + 2 : r1 - 1;
#pragma unroll
            for (int k = 0; k < 4; ++k) rwB[k] = *(const u32x4*)(x + (size_t)rn * D + k * 512 + lane * 8); }
        __builtin_amdgcn_sched_barrier(0);
        f32x4 v[8]; float ss = 0.f;
#pragma unroll
        for (int k = 0; k < 4; ++k) { float f8[8]; unpack8h(rw[k], f8); v[2 * k] = (f32x4){f8[0], f8[1], f8[2], f8[3]}; v[2 * k + 1] = (f32x4){f8[4], f8[5], f8[6], f8[7]}; }
#pragma unroll
        for (int i = 0; i < 8; ++i) ss += v[i][0] * v[i][0] + v[i][1] * v[i][1] + v[i][2] * v[i][2] + v[i][3] * v[i][3];
#pragma unroll
        for (int o = 32; o >= 1; o >>= 1) ss += shx(ss, o, lane);
        const float rs = rsqrtf(ss * (1.0f / D) + EPS);
#pragma unroll
        for (int i = 0; i < 8; ++i) { const int c = (i >> 1) * 512 + lane * 8 + (i & 1) * 4;
            *(f32x4*)(out + (size_t)r * D + c) = v[i] * rs * wv[i]; }
    }
}

__device__ __forceinline__ int chunk_rowbase(int b, int ch) { return ch < 4 ? RL + b * CTXL + ch * 64 : b * SEQ + (ch - 4) * 64; }
__device__ __forceinline__ int step_chunk(int d, int i) { return d == 0 ? i : (i < 4 ? 3 - i : 39 - i); }

__device__ __forceinline__ f32x4 gla_lr_load(unsigned char* wsl, int b, int ch, int d, int tid) {
    f32x4 v = (f32x4){0.f, 0.f, 0.f, 0.f};
    if (tid < 256) { const int p1 = tid >> 2, r4 = (tid & 3) * 4, tok1 = d ? 63 - p1 : p1; v = *(const f32x4*)((const float*)(wsl + WS_SMALL) + (size_t)(chunk_rowbase(b, ch) + tok1) * 64 + d * 16 + r4); }
    return v;
}
__device__ __forceinline__ void gla_prep_unit(const Frame& F, int l, int b, int ch, int h, int d, f32x4& lrv_io, bool load_w, bool has_next, int nb, int nch) {
    int tid = F.tid; asm volatile("" : "+v"(tid));
    size_t wz_ = 0; asm volatile("" : "+s"(wz_)); unsigned char* wsl = F.ws + wz_;
    int bxl = F.bx; asm volatile("" : "+s"(bxl)); (void)bxl;
    const int lane = tid & 63, w = __builtin_amdgcn_readfirstlane(tid >> 6), fr = lane & 15, fq = lane >> 4;
    LAS bf16_t* qd = (LAS bf16_t*)(F.lds + 0);
    LAS bf16_t* kn = (LAS bf16_t*)(F.lds + 17408);
    LAS bf16_t* vT = (LAS bf16_t*)(F.lds + 34816);
    LAS bf16_t* sc = (LAS bf16_t*)(F.lds + 71680);
    LAS float* bc = (LAS float*)(F.lds + 80896);
    LAS float* lr = (LAS float*)(F.lds + 113920);
    LAS float* w2 = (LAS float*)(F.lds + 118016);
    LAS float* bs = (LAS float*)(F.lds + 126208);
    const bf16_t* P = (const bf16_t*)(wsl + WS_P); const float* small = (const float*)(wsl + WS_SMALL);
    const int rowbase = chunk_rowbase(b, ch);
    unsigned char* ub = wsl + WS_GLAPREP + (size_t)(((b * NCH + ch) * 4 + h) * 2 + d) * GLA_UNIT;
    bf16_t* g_qd = (bf16_t*)ub; bf16_t* g_keT = (bf16_t*)(ub + 16384); bf16_t* g_vT = (bf16_t*)(ub + 32768); float* g_dec = (float*)(ub + 65536);
    bf16_t* og = (bf16_t*)(wsl + WS_OGLA) + (size_t)d * R * 1024;
    const int p = tid >> 3, k0 = (tid & 7) * 16, tok = d ? 63 - p : p;
    const f32x4 lrv = lrv_io; f32x4 w2v = (f32x4){0.f, 0.f, 0.f, 0.f}; float bsv = 0.f; u32x4 qraw[2], kraw[2], vraw[4]; (void)small;
    if (load_w) { { const int idx = tid * 4, r = idx >> 7, k = idx & 127; w2v = *(const f32x4*)(F.in[I_LRW2] + ((size_t)(l * 2 + d) * 16 + r) * 512 + h * 128 + k); }
        if (tid < 128) bsv = F.in[I_LRB][(size_t)(l * 2 + d) * 512 + h * 128 + tid]; }
    { const bf16_t* qp = P + (size_t)(rowbase + tok) * NP + PC_GLA_Q + h * 128 + k0; const bf16_t* kp = P + (size_t)(rowbase + tok) * NP + PC_GLA_K + h * 128 + k0;
        const bf16_t* vp = P + (size_t)(rowbase + tok) * NP + PC_GLA_V + h * 256 + (tid & 7) * 32;
        qraw[0] = *(const u32x4*)qp; qraw[1] = *(const u32x4*)(qp + 8); kraw[0] = *(const u32x4*)kp; kraw[1] = *(const u32x4*)(kp + 8);
#pragma unroll
        for (int j = 0; j < 4; ++j) vraw[j] = *(const u32x4*)(vp + j * 8); }
    __builtin_amdgcn_sched_barrier(0);
    if (tid < 256) { const int p1 = tid >> 2, r4 = (tid & 3) * 4; *(LAS f32x4*)(lr + p1 * 16 + r4) = lrv; }
    if (load_w) { *(LAS f32x4*)(w2 + tid * 4) = w2v;
        if (tid < 128) bs[tid] = bsv; }
    __syncthreads();
    { const int a = lane & 15, g = lane >> 4;
        float bw[4];
#pragma unroll
        for (int ks = 0; ks < 4; ++ks) bw[ks] = w2[(ks * 4 + g) * 128 + w * 16 + a];
        const float bias = bs[w * 16 + a];
#pragma unroll
        for (int rt = 0; rt < 4; ++rt) { float av[4];
#pragma unroll
            for (int ks = 0; ks < 4; ++ks) av[ks] = lr[(rt * 16 + a) * 16 + ks * 4 + g];
            f32x4 acc = (f32x4){bias, bias, bias, bias};
#pragma unroll
            for (int ks = 0; ks < 4; ++ks) acc = __builtin_amdgcn_mfma_f32_16x16x4f32(av[ks], bw[ks], acc, 0, 0, 0);
#pragma unroll
            for (int i = 0; i < 4; ++i) bc[(rt * 16 + 4 * g + i) * 129 + w * 16 + a] = logsigf_(acc[i]) * (1.0f / 16.0f); } }
    __syncthreads();
    { float cv[16]; const int kk = tid >> 2, sg = tid & 3;
#pragma unroll
        for (int q = 0; q < 16; ++q) cv[q] = bc[(sg * 16 + q) * 129 + kk];
#pragma unroll
        for (int q = 1; q < 16; ++q) cv[q] += cv[q - 1];
        const float t1 = shup(cv[15], 1, lane), t2 = shup(cv[15], 2, lane), t3 = shup(cv[15], 3, lane);
        const float off = (sg >= 1 ? t1 : 0.f) + (sg >= 2 ? t2 : 0.f) + (sg >= 3 ? t3 : 0.f);
#pragma unroll
        for (int q = 0; q < 16; ++q) bc[(sg * 16 + q) * 129 + kk] = cv[q] + off; }
    __syncthreads();
    {
        float qf[16], kf[16];
        { float t8[8]; unpack8(qraw[0], t8);
#pragma unroll
            for (int i = 0; i < 8; ++i) qf[i] = t8[i];
            unpack8(qraw[1], t8);
#pragma unroll
            for (int i = 0; i < 8; ++i) qf[8 + i] = t8[i];
            unpack8(kraw[0], t8);
#pragma unroll
            for (int i = 0; i < 8; ++i) kf[i] = t8[i];
            unpack8(kraw[1], t8);
#pragma unroll
            for (int i = 0; i < 8; ++i) kf[8 + i] = t8[i]; }
        float qo[16], ko[16];
#pragma unroll
        for (int i = 0; i < 16; ++i) { const float bb = bc[p * 129 + k0 + i], bl = bc[63 * 129 + k0 + i];
            qo[i] = qf[i] * 0.08838834764831845f * __expf(bb); ko[i] = kf[i] * __expf(-bb);
            g_keT[frag_off(k0 + i, tok, 2)] = f2bf(kf[i] * __expf(bl - bb));
            if (p == 63) g_dec[k0 + i] = __expf(bl); }
        u32x4 q0, q1, k0v, k1v;
        { float t8[8];
#pragma unroll
            for (int i = 0; i < 8; ++i) t8[i] = qo[i];
            q0 = pack8(t8);
#pragma unroll
            for (int i = 0; i < 8; ++i) t8[i] = qo[8 + i];
            q1 = pack8(t8);
#pragma unroll
            for (int i = 0; i < 8; ++i) t8[i] = ko[i];
            k0v = pack8(t8);
#pragma unroll
            for (int i = 0; i < 8; ++i) t8[i] = ko[8 + i];
            k1v = pack8(t8); }
        *(LAS u32x4*)(qd + p * 136 + k0) = q0; *(LAS u32x4*)(qd + p * 136 + k0 + 8) = q1;
        *(LAS u32x4*)(kn + p * 136 + k0) = k0v; *(LAS u32x4*)(kn + p * 136 + k0 + 8) = k1v;
        *(u32x4*)(g_qd + frag_off(p, k0, 4)) = q0; *(u32x4*)(g_qd + frag_off(p, k0 + 8, 4)) = q1; }
    { const int v0 = (tid & 7) * 32, psw = p ^ ((tid & 7) << 3);
#pragma unroll
        for (int j = 0; j < 4; ++j) { const u32x4 wv = vraw[j];
            const unsigned ws_[4] = {wv.x, wv.y, wv.z, wv.w};
#pragma unroll
            for (int q = 0; q < 4; ++q) { vT[(v0 + j * 8 + 2 * q) * 72 + psw] = (bf16_t)(ws_[q] & 0xFFFFu); vT[(v0 + j * 8 + 2 * q + 1) * 72 + psw] = (bf16_t)(ws_[q] >> 16); } } }
    __syncthreads();
    if (d == 0) { const int row = tid >> 1, half = tid & 1;
#pragma unroll
        for (int j = 0; j < 4; ++j) *(u32x4*)(g_vT + frag_off(row, half * 32 + j * 8, 2)) = *(const LAS u32x4*)(vT + row * 72 + (((half * 4 + j) ^ ((row >> 5) & 7)) << 3)); }
    { const int rb = w >> 1;
#pragma unroll
        for (int j = 0; j < 2; ++j) { const int cb = (w & 1) * 2 + j; f32x4 acc = (f32x4){0.f, 0.f, 0.f, 0.f};
#pragma unroll
            for (int ks = 0; ks < 4; ++ks) { const bf16x8 a = *(const LAS bf16x8*)(qd + (rb * 16 + fr) * 136 + ks * 32 + fq * 8); const bf16x8 bt = *(const LAS bf16x8*)(kn + (cb * 16 + fr) * 136 + ks * 32 + fq * 8);
                acc = MFMA16(bt, a, acc); }
            const int pr = rb * 16 + fr, s0 = cb * 16 + 4 * fq;
            u32x2 o; o.x = pk2(s0 + 0 <= pr ? acc[0] : 0.f, s0 + 1 <= pr ? acc[1] : 0.f); o.y = pk2(s0 + 2 <= pr ? acc[2] : 0.f, s0 + 3 <= pr ? acc[3] : 0.f);
            *(LAS u32x2*)(sc + pr * 72 + s0) = o; } }
    __syncthreads();
    if (has_next) lrv_io = gla_lr_load(wsl, nb, nch, d, tid);
    { bf16x8 af[4][2];
#pragma unroll
        for (int rb = 0; rb < 4; ++rb)
#pragma unroll
            for (int ks = 0; ks < 2; ++ks) af[rb][ks] = *(const LAS bf16x8*)(sc + (rb * 16 + fr) * 72 + ks * 32 + fq * 8);
#pragma unroll
        for (int j = 0; j < 2; ++j) { const int cb = w * 2 + j; bf16x8 bf[2];
#pragma unroll
            for (int ks = 0; ks < 2; ++ks) bf[ks] = *(const LAS bf16x8*)(vT + (cb * 16 + fr) * 72 + (((ks * 4 + fq) ^ (cb >> 1)) << 3));
#pragma unroll
            for (int rb = 0; rb < 4; ++rb) { f32x4 acc = (f32x4){0.f, 0.f, 0.f, 0.f};
#pragma unroll
                for (int ks = 0; ks < 2; ++ks) acc = MFMA16(bf[ks], af[rb][ks], acc);
                const int pr = rb * 16 + fr, tk = d ? 63 - pr : pr;
                u32x2 o; o.x = pk2(acc[0], acc[1]); o.y = pk2(acc[2], acc[3]);
                *(u32x2*)(og + (size_t)(rowbase + tk) * 1024 + h * 256 + cb * 16 + 4 * fq) = o; } } }
    __syncthreads();
}

struct GlaOps { bf16x8 qa[4]; bf16x8 va[2][2]; bf16x8 ke[2][2]; f32x4 dc[2]; };
__device__ __forceinline__ void gla_ops_load(GlaOps& o, unsigned char* wsl, int b, int h, int d, int vs, int step, int fr, int fq, int pb, int vvb0, int vb, int kb0) {
    const int ch = step_chunk(d, step);
    const unsigned char* ub = wsl + WS_GLAPREP + (size_t)(((b * NCH + ch) * 4 + h) * 2 + d) * GLA_UNIT;
    const bf16_t* g_qd = (const bf16_t*)ub; const bf16_t* g_keT = (const bf16_t*)(ub + 16384); const bf16_t* g_vT = (const bf16_t*)(ub - (size_t)d * GLA_UNIT + 32768); const float* g_dec = (const float*)(ub + 65536);
#pragma unroll
    for (int ks = 0; ks < 4; ++ks) o.qa[ks] = *(const bf16x8*)(g_qd + frag_tile(pb, ks, 4, fq * 16 + fr));
#pragma unroll
    for (int j = 0; j < 2; ++j) { o.dc[j] = *(const f32x4*)(g_dec + (kb0 + j) * 16 + 4 * fq);
#pragma unroll
        for (int ks = 0; ks < 2; ++ks) { o.va[j][ks] = *(const bf16x8*)(g_vT + frag_tile(vs * 4 + vb + j, ks, 2, fq * 16 + fr)); o.ke[j][ks] = *(const bf16x8*)(g_keT + frag_tile(kb0 + j, ks, 2, fq * 16 + fr)); } }
}
__device__ __forceinline__ void gla_flush(LAS const bf16_t* OTp, unsigned char* wsl, int b, int h, int d, int vs, int step, int tid, const u32x4 oldv) {
    const int ch = step_chunk(d, step), rowbase = chunk_rowbase(b, ch), p = tid >> 3, c8 = (tid & 7) * 8, tk = d ? 63 - p : p;
    bf16_t* op = (bf16_t*)(wsl + WS_OGLA) + (size_t)d * R * 1024 + (size_t)(rowbase + tk) * 1024 + h * 256 + vs * 64 + c8;
    float a[8], o8[8]; unpack8(*(const LAS u32x4*)(OTp + p * 72 + c8), a); unpack8(oldv, o8);
#pragma unroll
    for (int i = 0; i < 8; ++i) a[i] += o8[i];
    *(u32x4*)op = pack8(a);
}
__device__ __forceinline__ u32x4 gla_old(unsigned char* wsl, int b, int h, int d, int vs, int step, int tid) {
    const int ch = step_chunk(d, step), rowbase = chunk_rowbase(b, ch), p = tid >> 3, c8 = (tid & 7) * 8, tk = d ? 63 - p : p;
    return *(const u32x4*)((const bf16_t*)(wsl + WS_OGLA) + (size_t)d * R * 1024 + (size_t)(rowbase + tk) * 1024 + h * 256 + vs * 64 + c8);
}
__device__ __forceinline__ void gla_step(const GlaOps& o, f32x4 (&Sacc)[4], LAS const bf16_t* Sc, LAS bf16_t* Sn, LAS bf16_t* OT, unsigned char* wsl, int b, int h, int d, int vs, int step, int tid, int fr, int fq, int pb, int vvb0, int vb, int kb0, const u32x4 oldv) {
    LAS bf16_t* OTc = OT + (step & 1) * (64 * 72);
#pragma unroll
    for (int j = 0; j < 2; ++j) { const int vvb = vvb0 + j; f32x4 acc = (f32x4){0.f, 0.f, 0.f, 0.f};
#pragma unroll
        for (int ks = 0; ks < 4; ++ks) { const bf16x8 bt = *(const LAS bf16x8*)(Sc + (vvb * 16 + fr) * 136 + ks * 32 + fq * 8); acc = MFMA16(bt, o.qa[ks], acc); }
        u32x2 w; w.x = pk2(acc[0], acc[1]); w.y = pk2(acc[2], acc[3]);
        *(LAS u32x2*)(OTc + (pb * 16 + fr) * 72 + vvb * 16 + 4 * fq) = w; }
#pragma unroll
    for (int j = 0; j < 4; ++j) { const int kj = j & 1, vj = j >> 1; f32x4 acc = Sacc[j] * o.dc[kj];
#pragma unroll
        for (int ks = 0; ks < 2; ++ks) acc = MFMA16(o.ke[kj][ks], o.va[vj][ks], acc);
        Sacc[j] = acc;
        u32x2 w; w.x = pk2(acc[0], acc[1]); w.y = pk2(acc[2], acc[3]);
        *(LAS u32x2*)(Sn + ((vb + vj) * 16 + fr) * 136 + (kb0 + kj) * 16 + 4 * fq) = w; }
    gla_flush(OT + ((step - 1) & 1) * (64 * 72), wsl, b, h, d, vs, step > 0 ? step - 1 : 0, tid, oldv);
}
__device__ __forceinline__ void gla_scan_unit(const Frame& F, int b, int h, int d, int vs) {
    int tid = F.tid; asm volatile("" : "+v"(tid));
    size_t wz_ = 0; asm volatile("" : "+s"(wz_)); unsigned char* wsl = F.ws + wz_;
    const int lane = tid & 63, w = __builtin_amdgcn_readfirstlane(tid >> 6), fr = lane & 15, fq = lane >> 4;
    LAS bf16_t* ST = (LAS bf16_t*)(F.lds);
    LAS bf16_t* OT = (LAS bf16_t*)(F.lds + 34816);
    const int pb = w >> 1, vvb0 = (w & 1) * 2, vb = w >> 1, kb0 = (w & 1) * 4;
    f32x4 Sacc[4];
#pragma unroll
    for (int j = 0; j < 4; ++j) Sacc[j] = (f32x4){0.f, 0.f, 0.f, 0.f};
    GlaOps A, B;
    gla_ops_load(A, wsl, b, h, d, vs, 0, fr, fq, pb, vvb0, vb, kb0);
    __syncthreads();
    for (int i = tid; i < 64 * 136 / 2; i += NTHR) ((LAS unsigned*)ST)[i] = 0u;
    __syncthreads();
    LAS bf16_t* S0 = ST; LAS bf16_t* S1 = ST + 64 * 136;
#pragma unroll 1
    for (int step = 0; step < NCH; step += 2) {
        gla_ops_load(B, wsl, b, h, d, vs, step + 1, fr, fq, pb, vvb0, vb, kb0);
        __builtin_amdgcn_sched_barrier(0);
        gla_step(A, Sacc, S0, S1, OT, wsl, b, h, d, vs, step, tid, fr, fq, pb, vvb0, vb, kb0, step > 0 ? gla_old(wsl, b, h, d, vs, step - 1, tid) : (u32x4){0u, 0u, 0u, 0u});
        __syncthreads();
        if (step + 2 < NCH) gla_ops_load(A, wsl, b, h, d, vs, step + 2, fr, fq, pb, vvb0, vb, kb0);
        __builtin_amdgcn_sched_barrier(0);
        gla_step(B, Sacc, S1, S0, OT, wsl, b, h, d, vs, step + 1, tid, fr, fq, pb, vvb0, vb, kb0, gla_old(wsl, b, h, d, vs, step, tid));
        __syncthreads();
    }
    gla_flush(OT + ((NCH - 1) & 1) * (64 * 72), wsl, b, h, d, vs, NCH - 1, tid, gla_old(wsl, b, h, d, vs, NCH - 1, tid));
}

__device__ __forceinline__ void ld16(const bf16_t* p, float (&x)[16]) { float t8[8]; unpack8(*(const u32x4*)p, t8);
#pragma unroll
    for (int i = 0; i < 8; ++i) x[i] = t8[i];
    unpack8(*(const u32x4*)(p + 8), t8);
#pragma unroll
    for (int i = 0; i < 8; ++i) x[8 + i] = t8[i]; }
template <int BI> __device__ __forceinline__ void tinv_row(LAS float* Ti, LAS const float* Nx, int tid) {
    for (int e = tid; e < BI * 256; e += NTHR) { const int bj = e >> 8, a = (e >> 4) & 15, c = e & 15; float acc = 0.f;
#pragma unroll
        for (int sx = 0; sx < BI * 16; ++sx) acc -= Nx[((BI - 1) * 16 + a) * 52 + sx] * Ti[sx * 68 + bj * 16 + c];
        Ti[(BI * 16 + a) * 68 + bj * 16 + c] = acc; }
}
__device__ __forceinline__ unsigned long long gdn_prep_unit(const Frame& F, int l, int b, int ch, int h, bool load_cw) {
    unsigned long long tacc = 0, tl_ = 0; if (PROBE_GDN) tl_ = wall_clock64();
#define GST(id) do { if (PROBE_GDN) { const unsigned long long tn_ = wall_clock64(); if (PROBE_GDN == (id)) tacc += tn_ - tl_; tl_ = tn_; } } while (0)
    int tid = F.tid; asm volatile("" : "+v"(tid));
    size_t wz_ = 0; asm volatile("" : "+s"(wz_)); unsigned char* wsl = F.ws + wz_;
    const int lane = tid & 63, w = __builtin_amdgcn_readfirstlane(tid >> 6), fr = lane & 15, fq = lane >> 4;
    LAS float* Lm = (LAS float*)(F.lds + 0);
    LAS bf16_t* TH = (LAS bf16_t*)(F.lds + 0);
    LAS bf16_t* TL = (LAS bf16_t*)(F.lds + 9216);
    LAS float* Ti = (LAS float*)(F.lds + 17408);
    LAS float* Nx = (LAS float*)(F.lds + 34816);
    LAS float* gb = (LAS float*)(F.lds + 44800);
    LAS float* bt = (LAS float*)(F.lds + 45312);
    LAS bf16_t* qh = (LAS bf16_t*)(F.lds + 45824);
    LAS bf16_t* kh = (LAS bf16_t*)(F.lds + 63232);
    LAS bf16_t* kbT = (LAS bf16_t*)(F.lds + 80640);
    LAS bf16_t* vbT = (LAS bf16_t*)(F.lds + 99072);
    LAS float* cwL = (LAS float*)(F.lds + 117504);
    const bf16_t* P = (const bf16_t*)(wsl + WS_P); const float* small = (const float*)(wsl + WS_SMALL);
    const int rowbase = chunk_rowbase(b, ch);
    const int T = ch < 4 ? CTXL : SEQ, chl = ch < 4 ? ch : ch - 4;
    unsigned char* ub0 = wsl + WS_GDNPREP + (size_t)(((b * NCH + ch) * 8 + h) * 2) * GDN_UNIT;
    const int t = tid >> 3, c0 = (tid & 7) * 16;
    u32x4 raw[3][3][2];
    { const int ts = chl * 64 + t; const u32x4 z4 = (u32x4){0u, 0u, 0u, 0u};
#pragma unroll
        for (int part = 0; part < 3; ++part) { const bf16_t* xp = P + (size_t)(rowbase + t) * NP + PC_GDN_Q + part * 1024 + h * 128 + c0;
            raw[part][0][0] = (ts - 1 >= 0) ? *(const u32x4*)(xp - NP) : z4; raw[part][0][1] = (ts - 1 >= 0) ? *(const u32x4*)(xp - NP + 8) : z4;
            raw[part][1][0] = *(const u32x4*)xp; raw[part][1][1] = *(const u32x4*)(xp + 8);
            raw[part][2][0] = (ts + 1 < T) ? *(const u32x4*)(xp + NP) : z4; raw[part][2][1] = (ts + 1 < T) ? *(const u32x4*)(xp + NP + 8) : z4; } }
    f32x4 cwv = (f32x4){0.f, 0.f, 0.f, 0.f};
    if (load_cw && tid < 288) { const int tap = tid / 96, rem = tid % 96, part = rem >> 5, c4 = (rem & 31) * 4;
        cwv = *(const f32x4*)(F.in[I_CONVW] + (size_t)l * 3 * 3072 + tap * 3072 + part * 1024 + h * 128 + c4); }
    float g0a = 0.f, g0b = 0.f, g0l = 0.f, g0t = 0.f;
    if (w < 2) { const int d = w, tok = d ? 63 - lane : lane;
        g0a = small[(size_t)(rowbase + tok) * 64 + 32 + d * 8 + h]; g0b = small[(size_t)(rowbase + tok) * 64 + 48 + d * 8 + h];
        g0l = F.in[I_ALOG][(l * 2 + d) * 8 + h]; g0t = F.in[I_DTB][(l * 2 + d) * 8 + h]; }
    __builtin_amdgcn_sched_barrier(0);
    if (load_cw) {
        if (tid < 288) { const int tap = tid / 96, rem = tid % 96; *(LAS f32x4*)(cwL + tap * 384 + rem * 4) = cwv; }
        __syncthreads(); }
    float qn[16], kn[16], vv[16];
    {
#pragma unroll
        for (int part = 0; part < 3; ++part) {
            const int wc = part * 128 + c0;
            float x0[16], x1[16], x2[16], t8[8];
            unpack8(raw[part][0][0], t8);
#pragma unroll
            for (int i = 0; i < 8; ++i) x0[i] = t8[i];
            unpack8(raw[part][0][1], t8);
#pragma unroll
            for (int i = 0; i < 8; ++i) x0[8 + i] = t8[i];
            unpack8(raw[part][1][0], t8);
#pragma unroll
            for (int i = 0; i < 8; ++i) x1[i] = t8[i];
            unpack8(raw[part][1][1], t8);
#pragma unroll
            for (int i = 0; i < 8; ++i) x1[8 + i] = t8[i];
            unpack8(raw[part][2][0], t8);
#pragma unroll
            for (int i = 0; i < 8; ++i) x2[i] = t8[i];
            unpack8(raw[part][2][1], t8);
#pragma unroll
            for (int i = 0; i < 8; ++i) x2[8 + i] = t8[i];
#pragma unroll
            for (int i = 0; i < 16; ++i) { const float v = siluf_(cwL[wc + i] * x0[i] + cwL[384 + wc + i] * x1[i] + cwL[768 + wc + i] * x2[i]);
                if (part == 0) qn[i] = v; else if (part == 1) kn[i] = v; else vv[i] = v; }
        }
        float sq = 0.f, sk = 0.f;
#pragma unroll
        for (int i = 0; i < 16; ++i) { sq += qn[i] * qn[i]; sk += kn[i] * kn[i]; }
#pragma unroll
        for (int o = 1; o < 8; o <<= 1) { sq += shx(sq, o, lane); sk += shx(sk, o, lane); }
        const float rq = rsqrtf(sq + EPS) * 0.08838834764831845f, rk = rsqrtf(sk + EPS);
#pragma unroll
        for (int i = 0; i < 16; ++i) { qn[i] *= rq; kn[i] *= rk; }
        float t8[8];
#pragma unroll
        for (int i = 0; i < 8; ++i) t8[i] = qn[i];
        *(LAS u32x4*)(qh + t * 136 + c0) = pack8(t8);
#pragma unroll
        for (int i = 0; i < 8; ++i) t8[i] = qn[8 + i];
        *(LAS u32x4*)(qh + t * 136 + c0 + 8) = pack8(t8);
#pragma unroll
        for (int i = 0; i < 8; ++i) t8[i] = kn[i];
        *(LAS u32x4*)(kh + t * 136 + c0) = pack8(t8);
#pragma unroll
        for (int i = 0; i < 8; ++i) t8[i] = kn[8 + i];
        *(LAS u32x4*)(kh + t * 136 + c0 + 8) = pack8(t8); }
    if (w < 2) { const int d = w;
        float g = -__expf(g0l) * softplusf_(g0a + g0t);
#pragma unroll
        for (int o = 1; o < 64; o <<= 1) { const float tt = shup(g, o, lane); if (lane >= o) g += tt; }
        gb[d * 64 + lane] = g; bt[d * 64 + lane] = sigmoidf_(g0b);
        if (lane == 63) *(float*)(ub0 + (size_t)d * GDN_UNIT + 73728) = __expf(g); }
    __syncthreads();
    GST(1);
#pragma unroll 1
    for (int d = 0; d < 2; ++d) {
        unsigned char* ub = ub0 + (size_t)d * GDN_UNIT;
        bf16_t* g_nw = (bf16_t*)ub; bf16_t* g_uT = (bf16_t*)(ub + 16384); bf16_t* g_at = (bf16_t*)(ub + 32768); bf16_t* g_qd = (bf16_t*)(ub + 40960); bf16_t* g_kdT = (bf16_t*)(ub + 57344);
        LAS const float* gbd = gb + d * 64; LAS const float* btd = bt + d * 64;
        { const int p = d ? 63 - t : t, psw = p ^ ((tid & 7) << 3);
            const float bcp = gbd[p], bl = gbd[63], beta = btd[p], eq = __expf(bcp), ek = __expf(bl - bcp), sk = beta * eq;
            float t8[8];
#pragma unroll
            for (int i = 0; i < 8; ++i) t8[i] = qn[i] * eq;
            *(u32x4*)(g_qd + frag_off(p, c0, 4)) = pack8(t8);
#pragma unroll
            for (int i = 0; i < 8; ++i) t8[i] = qn[8 + i] * eq;
            *(u32x4*)(g_qd + frag_off(p, c0 + 8, 4)) = pack8(t8);
#pragma unroll
            for (int i = 0; i < 16; ++i) { g_kdT[frag_off(c0 + i, p, 2)] = f2bf(kn[i] * ek); kbT[(c0 + i) * 72 + psw] = f2bf(kn[i] * sk); vbT[(c0 + i) * 72 + psw] = f2bf(vv[i] * beta); } }
        __syncthreads();
        GST(2);
        { const bool isq = w >= 4; const int rb = w & 3; LAS const bf16_t* Asrc = isq ? qh : kh;
            const int pr = rb * 16 + fr, tr = d ? 63 - pr : pr;
            bf16x8 af[4];
#pragma unroll
            for (int ks = 0; ks < 4; ++ks) af[ks] = *(const LAS bf16x8*)(Asrc + tr * 136 + ks * 32 + fq * 8);
            const float bp = gbd[pr], betap = btd[pr];
#pragma unroll
            for (int cb = 0; cb < 4; ++cb) { f32x4 acc = (f32x4){0.f, 0.f, 0.f, 0.f}; const int sr = cb * 16 + fr, tsr = d ? 63 - sr : sr;
#pragma unroll
                for (int ks = 0; ks < 4; ++ks) { const bf16x8 bfr = *(const LAS bf16x8*)(kh + tsr * 136 + ks * 32 + fq * 8); acc = MFMA16(bfr, af[ks], acc); }
                const int s0 = cb * 16 + 4 * fq; float o[4];
#pragma unroll
                for (int i = 0; i < 4; ++i) { const int sx = s0 + i; const bool keep = isq ? (sx <= pr) : (sx < pr);
                    const float e = keep ? __expf(bp - gbd[sx]) : 0.f; o[i] = keep ? acc[i] * e * (isq ? 1.0f : betap) : 0.f; }
                if (isq) { u32x2 ov; ov.x = pk2(o[0], o[1]); ov.y = pk2(o[2], o[3]); *(u32x2*)(g_at + frag_off(pr, s0, 2)) = ov; }
                else *(LAS f32x4*)(Lm + pr * 68 + s0) = (f32x4){o[0], o[1], o[2], o[3]}; } }
        __syncthreads();
        GST(3);
        if (w < 4) { const int jb = w, a = lane & 15, g = lane >> 4;
            float bn[4][3][4];
#pragma unroll
            for (int bi = 1; bi < 4; ++bi)
#pragma unroll
                for (int bk = 0; bk < bi; ++bk) if (bk >= jb) {
#pragma unroll
                    for (int ks = 0; ks < 4; ++ks) bn[bi][bk][ks] = Lm[(bi * 16 + ks * 4 + g) * 68 + bk * 16 + a]; }
            { LAS const float* Lb = Lm + (g * 16) * 68 + g * 16; float x[16];
#pragma unroll
                for (int r = 0; r < 16; ++r) { float acc = (r == a) ? 1.0f : 0.0f;
#pragma unroll
                    for (int sx = 0; sx < r; ++sx) acc -= Lb[r * 68 + sx] * x[sx];
                    x[r] = acc; }
#pragma unroll
                for (int r = 0; r < 16; ++r) Ti[(g * 16 + r) * 68 + g * 16 + a] = x[r]; }
            float an[4][4];
#pragma unroll
            for (int bi = 1; bi < 4; ++bi) if (bi > jb) {
#pragma unroll
                for (int ks = 0; ks < 4; ++ks) an[bi][ks] = Ti[(bi * 16 + a) * 68 + bi * 16 + ks * 4 + g]; }
#pragma unroll
            for (int bi = 1; bi < 4; ++bi)
#pragma unroll
                for (int bk = 0; bk < bi; ++bk) if (bk >= jb) { f32x4 acc = (f32x4){0.f, 0.f, 0.f, 0.f};
#pragma unroll
                    for (int ks = 0; ks < 4; ++ks) acc = __builtin_amdgcn_mfma_f32_16x16x4f32(an[bi][ks], bn[bi][bk][ks], acc, 0, 0, 0);
#pragma unroll
                    for (int q = 0; q < 4; ++q) Nx[((bi - 1) * 16 + 4 * g + q) * 52 + bk * 16 + a] = acc[q]; }
#pragma unroll
            for (int bi = 1; bi < 4; ++bi) if (bi > jb) { float la[3][4], lb[3][4];
#pragma unroll
                for (int bk = 0; bk < bi; ++bk) if (bk >= jb) {
#pragma unroll
                    for (int ks = 0; ks < 4; ++ks) { la[bk][ks] = Nx[((bi - 1) * 16 + a) * 52 + bk * 16 + ks * 4 + g]; lb[bk][ks] = Ti[(bk * 16 + ks * 4 + g) * 68 + jb * 16 + a]; } }
                f32x4 acc = (f32x4){0.f, 0.f, 0.f, 0.f};
#pragma unroll
                for (int bk = 0; bk < bi; ++bk) if (bk >= jb) {
#pragma unroll
                    for (int ks = 0; ks < 4; ++ks) acc = __builtin_amdgcn_mfma_f32_16x16x4f32(la[bk][ks], lb[bk][ks], acc, 0, 0, 0); }
#pragma unroll
                for (int q = 0; q < 4; ++q) Ti[(bi * 16 + 4 * g + q) * 68 + jb * 16 + a] = -acc[q]; } }
        __syncthreads();
        GST(5);
        { const int p = tid >> 3, s0 = (tid & 7) * 8; float hi[8], lo[8];
#pragma unroll
            for (int i = 0; i < 8; ++i) { const float v = ((s0 >> 4) <= (p >> 4)) ? Ti[p * 68 + s0 + i] : 0.f; const float hf = bf2f(f2bf(v)); hi[i] = hf; lo[i] = v - hf; }
            *(LAS u32x4*)(TH + p * 72 + s0) = pack8(hi); *(LAS u32x4*)(TL + p * 72 + s0) = pack8(lo); }
        __syncthreads();
        { const bool isu = w >= 4; LAS const bf16_t* Bsrc = isu ? vbT : kbT;
            bf16x8 th[4][2], tl[4][2];
#pragma unroll
            for (int rb = 0; rb < 4; ++rb)
#pragma unroll
                for (int ks = 0; ks < 2; ++ks) { th[rb][ks] = *(const LAS bf16x8*)(TH + (rb * 16 + fr) * 72 + ks * 32 + fq * 8); tl[rb][ks] = *(const LAS bf16x8*)(TL + (rb * 16 + fr) * 72 + ks * 32 + fq * 8); }
#pragma unroll
            for (int jj = 0; jj < 2; ++jj) { const int cb = (w & 3) * 2 + jj;
                bf16x8 bf[2];
#pragma unroll
                for (int ks = 0; ks < 2; ++ks) bf[ks] = *(const LAS bf16x8*)(Bsrc + (cb * 16 + fr) * 72 + (((ks * 4 + fq) ^ cb) << 3));
#pragma unroll
                for (int rb = 0; rb < 4; ++rb) { f32x4 acc = (f32x4){0.f, 0.f, 0.f, 0.f};
                    if (!isu) {
#pragma unroll
                        for (int ks = 0; ks < 2; ++ks) { acc = MFMA16(bf[ks], th[rb][ks], acc); acc = MFMA16(bf[ks], tl[rb][ks], acc); }
                        u32x2 ov; ov.x = pk2(-acc[0], -acc[1]); ov.y = pk2(-acc[2], -acc[3]);
                        *(u32x2*)(g_nw + frag_off(rb * 16 + fr, cb * 16 + 4 * fq, 4)) = ov;
                    } else {
#pragma unroll
                        for (int ks = 0; ks < 2; ++ks) { acc = MFMA16(th[rb][ks], bf[ks], acc); acc = MFMA16(tl[rb][ks], bf[ks], acc); }
                        u32x2 ov; ov.x = pk2(acc[0], acc[1]); ov.y = pk2(acc[2], acc[3]);
                        *(u32x2*)(g_uT + (((cb * 4 + rb) << 8) + (fq * 16 + fr) * 4)) = ov;
                    } } } }
        __syncthreads();
        GST(6);
    }
    return tacc;
#undef GST
}

struct GdnOps { bf16x8 wa[4]; u32x2 uw[2]; bf16x8 qa[4]; bf16x8 aa[2]; bf16x8 kd[2]; float cd; };
__device__ __forceinline__ void gdn_ops_load(GdnOps& o, unsigned char* wsl, int b, int h, int d, int vs, int step, int fr, int fq, int pb, int vvb0, int kb0) {
    const int ch = step_chunk(d, step);
    const unsigned char* ub = wsl + WS_GDNPREP + (size_t)(((b * NCH + ch) * 8 + h) * 2 + d) * GDN_UNIT;
    const bf16_t* g_nw = (const bf16_t*)ub; const bf16_t* g_uT = (const bf16_t*)(ub + 16384); const bf16_t* g_at = (const bf16_t*)(ub + 32768); const bf16_t* g_qd = (const bf16_t*)(ub + 40960); const bf16_t* g_kdT = (const bf16_t*)(ub + 57344);
#pragma unroll
    for (int ks = 0; ks < 4; ++ks) o.wa[ks] = *(const bf16x8*)(g_nw + frag_tile(pb, ks, 4, fq * 16 + fr));
#pragma unroll
    for (int j = 0; j < 2; ++j) o.uw[j] = *(const u32x2*)(g_uT + ((((vs * 4 + vvb0 + j) * 4 + pb) << 8) + (fq * 16 + fr) * 4));
#pragma unroll
    for (int ks = 0; ks < 4; ++ks) o.qa[ks] = *(const bf16x8*)(g_qd + frag_tile(pb, ks, 4, fq * 16 + fr));
#pragma unroll
    for (int ks = 0; ks < 2; ++ks) o.aa[ks] = *(const bf16x8*)(g_at + frag_tile(pb, ks, 2, fq * 16 + fr));
#pragma unroll
    for (int ks = 0; ks < 2; ++ks) o.kd[ks] = *(const bf16x8*)(g_kdT + frag_tile(pb * 2 + (kb0 >> 2), ks, 2, fq * 16 + fr));
    o.cd = *(const float*)(ub + 73728);
}
__device__ __forceinline__ void gdn_flush(LAS const bf16_t* OTp, unsigned char* wsl, int b, int h, int d, int vs, int step, int tid) {
    const int ch = step_chunk(d, step), rowbase = chunk_rowbase(b, ch), p = tid >> 3, c8 = (tid & 7) * 8, tk = d ? 63 - p : p;
    *(u32x4*)((bf16_t*)(wsl + WS_OGDN) + (size_t)d * R * 1024 + (size_t)(rowbase + tk) * 1024 + h * 128 + vs * 64 + c8) = *(const LAS u32x4*)(OTp + p * 72 + c8);
}
__device__ __forceinline__ void gdn_step(const GdnOps& o, f32x4 (&Sacc)[4], LAS const bf16_t* Sc, LAS bf16_t* Sn, LAS bf16_t* VN, LAS bf16_t* OT, unsigned char* wsl, int b, int h, int d, int vs, int step, int tid, int fr, int fq, int pb, int vvb0, int vb, int kb0) {
    LAS bf16_t* OTc = OT + (step & 1) * (64 * 72);
    gdn_flush(OT + ((step - 1) & 1) * (64 * 72), wsl, b, h, d, vs, step > 0 ? step - 1 : 0, tid);
    bf16x8 sb[2][4];
#pragma unroll
    for (int j = 0; j < 2; ++j)
#pragma unroll
        for (int ks = 0; ks < 4; ++ks) sb[j][ks] = *(const LAS bf16x8*)(Sc + ((vvb0 + j) * 16 + fr) * 136 + ks * 32 + fq * 8);
#pragma unroll
    for (int j = 0; j < 2; ++j) { const int vvb = vvb0 + j;
        f32x4 acc = (f32x4){lo16(o.uw[j].x), hi16(o.uw[j].x), lo16(o.uw[j].y), hi16(o.uw[j].y)};
#pragma unroll
        for (int ks = 0; ks < 4; ++ks) acc = MFMA16(o.wa[ks], sb[j][ks], acc);
        u32x2 w; w.x = pk2(acc[0], acc[1]); w.y = pk2(acc[2], acc[3]);
        *(LAS u32x2*)(VN + (vvb * 16 + fr) * 72 + pb * 16 + 4 * fq) = w; }
    __syncthreads();
#pragma unroll
    for (int j = 0; j < 2; ++j) { const int vvb = vvb0 + j; f32x4 acc = (f32x4){0.f, 0.f, 0.f, 0.f};
#pragma unroll
        for (int ks = 0; ks < 4; ++ks) { const bf16x8 sbr = *(const LAS bf16x8*)(Sc + (vvb * 16 + fr) * 136 + ks * 32 + fq * 8); acc = MFMA16(sbr, o.qa[ks], acc); }
#pragma unroll
        for (int ks = 0; ks < 2; ++ks) { const bf16x8 bv = *(const LAS bf16x8*)(VN + (vvb * 16 + fr) * 72 + ks * 32 + fq * 8); acc = MFMA16(bv, o.aa[ks], acc); }
        u32x2 w; w.x = pk2(acc[0], acc[1]); w.y = pk2(acc[2], acc[3]);
        *(LAS u32x2*)(OTc + (pb * 16 + fr) * 72 + vvb * 16 + 4 * fq) = w; }
    { const int kbw = pb * 2 + (kb0 >> 2);
#pragma unroll
        for (int j = 0; j < 4; ++j) { f32x4 acc = Sacc[j] * o.cd;
#pragma unroll
            for (int ks = 0; ks < 2; ++ks) { const bf16x8 va = *(const LAS bf16x8*)(VN + (j * 16 + fr) * 72 + ks * 32 + fq * 8); acc = MFMA16(o.kd[ks], va, acc); }
            Sacc[j] = acc;
            u32x2 w; w.x = pk2(acc[0], acc[1]); w.y = pk2(acc[2], acc[3]);
            *(LAS u32x2*)(Sn + (j * 16 + fr) * 136 + kbw * 16 + 4 * fq) = w; } }
}
__device__ __forceinline__ void gdn_scan_unit(const Frame& F, int b, int h, int d, int vs) {
    int tid = F.tid; asm volatile("" : "+v"(tid));
    size_t wz_ = 0; asm volatile("" : "+s"(wz_)); unsigned char* wsl = F.ws + wz_;
    const int lane = tid & 63, w = __builtin_amdgcn_readfirstlane(tid >> 6), fr = lane & 15, fq = lane >> 4;
    LAS bf16_t* ST = (LAS bf16_t*)(F.lds);
    LAS bf16_t* VN = (LAS bf16_t*)(F.lds + 34816);
    LAS bf16_t* OT = (LAS bf16_t*)(F.lds + 44032);
    const int pb = w >> 1, vvb0 = (w & 1) * 2, vb = w >> 1, kb0 = (w & 1) * 4;
    f32x4 Sacc[4];
#pragma unroll
    for (int j = 0; j < 4; ++j) Sacc[j] = (f32x4){0.f, 0.f, 0.f, 0.f};
    GdnOps A, B;
    gdn_ops_load(A, wsl, b, h, d, vs, 0, fr, fq, pb, vvb0, kb0);
    __syncthreads();
    for (int i = tid; i < 64 * 136 / 2; i += NTHR) ((LAS unsigned*)ST)[i] = 0u;
    __syncthreads();
    LAS bf16_t* S0 = ST; LAS bf16_t* S1 = ST + 64 * 136;
#pragma unroll 1
    for (int step = 0; step < NCH; step += 2) {
        gdn_ops_load(B, wsl, b, h, d, vs, step + 1, fr, fq, pb, vvb0, kb0);
        __builtin_amdgcn_sched_barrier(0);
        gdn_step(A, Sacc, S0, S1, VN, OT, wsl, b, h, d, vs, step, tid, fr, fq, pb, vvb0, vb, kb0);
        __syncthreads();
        if (step + 2 < NCH) gdn_ops_load(A, wsl, b, h, d, vs, step + 2, fr, fq, pb, vvb0, kb0);
        __builtin_amdgcn_sched_barrier(0);
        gdn_step(B, Sacc, S1, S0, VN, OT, wsl, b, h, d, vs, step + 1, tid, fr, fq, pb, vvb0, vb, kb0);
        __syncthreads();
    }
    gdn_flush(OT + ((NCH - 1) & 1) * (64 * 72), wsl, b, h, d, vs, NCH - 1, tid);
}

__device__ __forceinline__ void scan_pair_unit(const Frame& F, int ua, int ud) {
    int tid = F.tid; asm volatile("" : "+v"(tid));
    size_t wz_ = 0; asm volatile("" : "+s"(wz_)); unsigned char* wsl = F.ws + wz_;
    const int lane = tid & 63, w = __builtin_amdgcn_readfirstlane(tid >> 6), fr = lane & 15, fq = lane >> 4;
    const int vsA = ua & 3, dA = (ua >> 2) & 1, hAx = (ua >> 3) & 3, bA = ua >> 5;
    const int vsD = ud & 1, dD = (ud >> 1) & 1, hD = (ud >> 2) & 7, bD = ud >> 5;
    LAS bf16_t* STa = (LAS bf16_t*)(F.lds);
    LAS bf16_t* OTa = (LAS bf16_t*)(F.lds + 34816);
    LAS bf16_t* STd = (LAS bf16_t*)(F.lds + 53248);
    LAS bf16_t* VN = (LAS bf16_t*)(F.lds + 88064);
    LAS bf16_t* OTd = (LAS bf16_t*)(F.lds + 97280);
    const int pb = w >> 1, vvb0 = (w & 1) * 2, vb = w >> 1, kb0 = (w & 1) * 4, vbA = (w & 1) * 2, kbA = (w >> 1) * 2;
    f32x4 SaccA[4], SaccD[4];
#pragma unroll
    for (int j = 0; j < 4; ++j) { SaccA[j] = (f32x4){0.f, 0.f, 0.f, 0.f}; SaccD[j] = (f32x4){0.f, 0.f, 0.f, 0.f}; }
    GlaOps GA; GdnOps GD;
    gla_ops_load(GA, wsl, bA, hAx, dA, vsA, 0, fr, fq, pb, vvb0, vbA, kbA);
    u32x4 oldv = gla_old(wsl, bA, hAx, dA, vsA, 0, tid);
    __builtin_amdgcn_sched_barrier(0);
    gdn_ops_load(GD, wsl, bD, hD, dD, vsD, 0, fr, fq, pb, vvb0, kb0);
    __builtin_amdgcn_sched_barrier(0);
    __syncthreads();
    for (int i = tid; i < 64 * 136 / 2; i += NTHR) { ((LAS unsigned*)STa)[i] = 0u; ((LAS unsigned*)STd)[i] = 0u; }
    for (int i = tid; i < 64 * 72 / 2; i += NTHR) { ((LAS unsigned*)(OTa + 64 * 72))[i] = 0u; ((LAS unsigned*)(OTd + 64 * 72))[i] = 0u; }
    __syncthreads();
#pragma unroll 1
    for (int step = 0; step < NCH; ++step) {
        const int cur = step & 1;
        __builtin_amdgcn_sched_barrier(0);
        gla_step(GA, SaccA, STa + cur * (64 * 136), STa + (cur ^ 1) * (64 * 136), OTa, wsl, bA, hAx, dA, vsA, step, tid, fr, fq, pb, vvb0, vbA, kbA, oldv);
        __builtin_amdgcn_sched_barrier(0);
        __syncthreads();
        gla_ops_load(GA, wsl, bA, hAx, dA, vsA, step + 1 < NCH ? step + 1 : NCH - 1, fr, fq, pb, vvb0, vbA, kbA);
        __builtin_amdgcn_sched_barrier(0);
        gdn_step(GD, SaccD, STd + cur * (64 * 136), STd + (cur ^ 1) * (64 * 136), VN, OTd, wsl, bD, hD, dD, vsD, step, tid, fr, fq, pb, vvb0, vb, kb0);
        __syncthreads();
        oldv = gla_old(wsl, bA, hAx, dA, vsA, step, tid);
        __builtin_amdgcn_sched_barrier(0);
        gdn_ops_load(GD, wsl, bD, hD, dD, vsD, step + 1 < NCH ? step + 1 : NCH - 1, fr, fq, pb, vvb0, kb0);
        __builtin_amdgcn_sched_barrier(0);
    }
    gla_flush(OTa + ((NCH - 1) & 1) * (64 * 72), wsl, bA, hAx, dA, vsA, NCH - 1, tid, oldv);
    gdn_flush(OTd + ((NCH - 1) & 1) * (64 * 72), wsl, bD, hD, dD, vsD, NCH - 1, tid);
}

__device__ __forceinline__ void merge_row_load(u32x4 (&a)[18], int r, int lane, int hw, const bf16_t* __restrict__ P, const bf16_t* __restrict__ oga, const bf16_t* __restrict__ ogd) {
    const int c0 = lane * 16;
    { const bf16_t* a0 = oga + (size_t)r * 1024 + c0; const bf16_t* a1 = a0 + (size_t)R * 1024; const bf16_t* zp = P + (size_t)r * NP + PC_GLA_Z + c0;
        a[0] = *(const u32x4*)a0; a[1] = *(const u32x4*)(a0 + 8); a[2] = *(const u32x4*)a1; a[3] = *(const u32x4*)(a1 + 8); a[4] = *(const u32x4*)zp; a[5] = *(const u32x4*)(zp + 8); }
    { const bf16_t* a0 = ogd + (size_t)r * 1024 + c0; const bf16_t* a1 = a0 + (size_t)R * 1024; const bf16_t* zp = P + (size_t)r * NP + PC_GDN_Z + c0;
        a[6] = *(const u32x4*)a0; a[7] = *(const u32x4*)(a0 + 8); a[8] = *(const u32x4*)a1; a[9] = *(const u32x4*)(a1 + 8); a[10] = *(const u32x4*)zp; a[11] = *(const u32x4*)(zp + 8); }
    { const int T = r < RL ? SEQ : CTXL, ts = r < RL ? (r & (SEQ - 1)) : ((r - RL) & (CTXL - 1)), segbase = r - ts;
        const int e = ts - 1 + hw, v = ts - 1 - hw; const bool eok = (ts > 0) && (e < T), vok = v >= 0; const u32x4 z4 = (u32x4){0u, 0u, 0u, 0u};
        const bf16_t* ep = P + (size_t)(segbase + (eok ? e : ts)) * NP + PC_POOL + c0; const bf16_t* vp = P + (size_t)(segbase + (vok ? v : ts)) * NP + PC_POOL + c0; const bf16_t* sp = P + (size_t)r * NP + PC_POOL + c0;
        a[12] = eok ? *(const u32x4*)ep : z4; a[13] = eok ? *(const u32x4*)(ep + 8) : z4; a[14] = vok ? *(const u32x4*)vp : z4; a[15] = vok ? *(const u32x4*)(vp + 8) : z4;
        a[16] = *(const u32x4*)sp; a[17] = *(const u32x4*)(sp + 8); }
}
__device__ __forceinline__ void phase_merge_prep(const Frame& F, int l, int nrows) {
    int tid = F.tid; asm volatile("" : "+v"(tid));
    size_t wz_ = 0; asm volatile("" : "+s"(wz_)); unsigned char* wsl = F.ws + wz_;
    int bxl = F.bx; asm volatile("" : "+s"(bxl)); (void)bxl;
    const int lane = tid & 63, wave = __builtin_amdgcn_readfirstlane(tid >> 6); (void)lane; (void)wave;
    const bf16_t* __restrict__ P = (const bf16_t*)(wsl + WS_P);
    const bf16_t* __restrict__ oga = (const bf16_t*)(wsl + WS_OGLA); const bf16_t* __restrict__ ogd = (const bf16_t*)(wsl + WS_OGDN);
    bf16_t* __restrict__ yga = (bf16_t*)(wsl + WS_Y3); bf16_t* __restrict__ ygd = yga + 1024; bf16_t* __restrict__ pld = yga + 2048;
    const float* __restrict__ gnw = F.in[I_GLANW] + l * 256; const float* __restrict__ dnw = F.in[I_GDNNW] + l * 128;
    const int c0 = lane * 16, hw = 1 << (lane >> 4);
    const int nwv = F.G * 8, nper = (nrows + nwv - 1) / nwv, r0 = (bxl * 8 + wave) * nper, r1 = min(r0 + nper, nrows);
    if (r0 >= r1) return;
    float s[16];
#pragma unroll
    for (int i = 0; i < 16; ++i) s[i] = 0.f;
    u32x4 cu[18];
    merge_row_load(cu, r0, lane, hw, P, oga, ogd);
#pragma unroll 1
    for (int r = r0; r < r1; ++r) {
        u32x4 nx[18];
        merge_row_load(nx, (r + 1 < r1) ? r + 1 : r, lane, hw, P, oga, ogd);
        __builtin_amdgcn_sched_barrier(0);
        { float o[16], z[16], t8[8];
            unpack8(cu[0], t8);
#pragma unroll
            for (int i = 0; i < 8; ++i) o[i] = t8[i];
            unpack8(cu[1], t8);
#pragma unroll
            for (int i = 0; i < 8; ++i) o[8 + i] = t8[i];
            unpack8(cu[2], t8);
#pragma unroll
            for (int i = 0; i < 8; ++i) o[i] += t8[i];
            unpack8(cu[3], t8);
#pragma unroll
            for (int i = 0; i < 8; ++i) o[8 + i] += t8[i];
            unpack8(cu[4], t8);
#pragma unroll
            for (int i = 0; i < 8; ++i) z[i] = t8[i];
            unpack8(cu[5], t8);
#pragma unroll
            for (int i = 0; i < 8; ++i) z[8 + i] = t8[i];
            float ss = 0.f;
#pragma unroll
            for (int i = 0; i < 16; ++i) ss += o[i] * o[i];
#pragma unroll
            for (int q = 1; q < 16; q <<= 1) ss += shx(ss, q, lane);
            const float rs = rsqrtf(ss * (1.0f / 256.0f) + EPS); const int vv0 = (lane & 15) * 16;
            u32x4 w0, w1;
#pragma unroll
            for (int i = 0; i < 8; ++i) t8[i] = o[i] * rs * gnw[vv0 + i] * siluf_(z[i]);
            w0 = pack8(t8);
#pragma unroll
            for (int i = 0; i < 8; ++i) t8[i] = o[8 + i] * rs * gnw[vv0 + 8 + i] * siluf_(z[8 + i]);
            w1 = pack8(t8);
            *(u32x4*)(yga + (size_t)r * 3072 + c0) = w0; *(u32x4*)(yga + (size_t)r * 3072 + c0 + 8) = w1; }
        { float o[16], z[16], t8[8];
            unpack8(cu[6], t8);
#pragma unroll
            for (int i = 0; i < 8; ++i) o[i] = t8[i];
            unpack8(cu[7], t8);
#pragma unroll
            for (int i = 0; i < 8; ++i) o[8 + i] = t8[i];
            unpack8(cu[8], t8);
#pragma unroll
            for (int i = 0; i < 8; ++i) o[i] += t8[i];
            unpack8(cu[9], t8);
#pragma unroll
            for (int i = 0; i < 8; ++i) o[8 + i] += t8[i];
            unpack8(cu[10], t8);
#pragma unroll
            for (int i = 0; i < 8; ++i) z[i] = t8[i];
            unpack8(cu[11], t8);
#pragma unroll
            for (int i = 0; i < 8; ++i) z[8 + i] = t8[i];
            float ss = 0.f;
#pragma unroll
            for (int i = 0; i < 16; ++i) ss += o[i] * o[i];
#pragma unroll
            for (int q = 1; q < 8; q <<= 1) ss += shx(ss, q, lane);
            const float rs = rsqrtf(ss * (1.0f / 128.0f) + EPS); const int vv0 = (lane & 7) * 16;
            u32x4 w0, w1;
#pragma unroll
            for (int i = 0; i < 8; ++i) t8[i] = o[i] * rs * dnw[vv0 + i] * siluf_(z[i]);
            w0 = pack8(t8);
#pragma unroll
            for (int i = 0; i < 8; ++i) t8[i] = o[8 + i] * rs * dnw[vv0 + 8 + i] * siluf_(z[8 + i]);
            w1 = pack8(t8);
            *(u32x4*)(ygd + (size_t)r * 3072 + c0) = w0; *(u32x4*)(ygd + (size_t)r * 3072 + c0 + 8) = w1; }
        { const int T = r < RL ? SEQ : CTXL, ts = r < RL ? (r & (SEQ - 1)) : ((r - RL) & (CTXL - 1)), segbase = r - ts;
            const int lo = max(ts - hw, 0), hi = min(ts + hw, T);
            float t8[8];
            if (r == r0 || ts == 0) {
#pragma unroll
                for (int i = 0; i < 16; ++i) s[i] = 0.f;
#pragma unroll 1
                for (int hb = 0; hb < 4; ++hb) { u32x4 ra[4], rb[4]; const u32x4 z4 = (u32x4){0u, 0u, 0u, 0u};
#pragma unroll
                    for (int jq = 0; jq < 4; ++jq) { const int t = lo + hb * 4 + jq; const bool ok = t < hi; const bf16_t* up = P + (size_t)(segbase + (ok ? t : lo)) * NP + PC_POOL + c0;
                        ra[jq] = ok ? *(const u32x4*)up : z4; rb[jq] = ok ? *(const u32x4*)(up + 8) : z4; }
#pragma unroll
                    for (int jq = 0; jq < 4; ++jq) { unpack8(ra[jq], t8);
#pragma unroll
                        for (int i = 0; i < 8; ++i) s[i] += t8[i];
                        unpack8(rb[jq], t8);
#pragma unroll
                        for (int i = 0; i < 8; ++i) s[8 + i] += t8[i]; } }
            } else {
                unpack8(cu[12], t8);
#pragma unroll
                for (int i = 0; i < 8; ++i) s[i] += t8[i];
                unpack8(cu[13], t8);
#pragma unroll
                for (int i = 0; i < 8; ++i) s[8 + i] += t8[i];
                unpack8(cu[14], t8);
#pragma unroll
                for (int i = 0; i < 8; ++i) s[i] -= t8[i];
                unpack8(cu[15], t8);
#pragma unroll
                for (int i = 0; i < 8; ++i) s[8 + i] -= t8[i]; }
            const float inv = 1.0f / (float)(hi - lo);
            u32x4 w0, w1;
            unpack8(cu[16], t8);
#pragma unroll
            for (int i = 0; i < 8; ++i) t8[i] = s[i] * inv - t8[i];
            w0 = pack8(t8);
            unpack8(cu[17], t8);
#pragma unroll
            for (int i = 0; i < 8; ++i) t8[i] = s[8 + i] * inv - t8[i];
            w1 = pack8(t8);
            *(u32x4*)(pld + (size_t)r * 3072 + c0) = w0; *(u32x4*)(pld + (size_t)r * 3072 + c0 + 8) = w1; }
#pragma unroll
        for (int i = 0; i < 18; ++i) cu[i] = nx[i];
    }
}

template <int VAR> __device__ __forceinline__ void phase_convglu(const Frame& F, int l, int nrows) {
    int tid = F.tid; asm volatile("" : "+v"(tid));
    const int lane = tid & 63, wave = __builtin_amdgcn_readfirstlane(tid >> 6);
    size_t wz_ = 0; asm volatile("" : "+s"(wz_)); unsigned char* wsl = F.ws + wz_;
    int bxl = F.bx; asm volatile("" : "+s"(bxl));
    const bf16_t* av = (const bf16_t*)(wsl + WS_AV); bf16_t* gout = (bf16_t*)(wsl + WS_G) + (VAR ? (size_t)R * DFF : 0);
    const float* cw = F.in[I_FFNCONV] + (size_t)l * 9 * DFF;
    const int nit = (nrows > RL) ? 396 : 352, n4 = (nrows > RL) ? 348 : 224, nwi = n4 * 4 + (nit - n4) * 3;
    for (int wq = bxl; wq < nwi; wq += F.G) {
        int wi, xs, CSEG;
        if (wq < n4 * 4) { wi = wq >> 2; xs = (wq & 3) * 16; CSEG = 16; } else { const int e = wq - n4 * 4, sg = e % 3; wi = n4 + e / 3; xs = sg * 22; CSEG = sg < 2 ? 22 : 20; }
        int strip, ck;
        if (wi < 352) { ck = wi % 11; strip = (wi / 11) * 8 + wave; } else { ck = (wi - 352) % 11; strip = 256 + ((wi - 352) / 11) * 8 + wave; }
        const int c = (ck * 64 + lane) * 8;
        int row0, W, x0; bool up, dn;
        if (strip < 256) { const int gy = strip & 31; row0 = (strip >> 5) * SEQ + gy * 64; W = 64; x0 = xs; up = gy > 0; dn = gy < 31; }
        else { const int t = strip - 256; row0 = RL + (t >> 2) * CTXL; W = CTXL; x0 = (t & 3) * 64 + xs; up = false; dn = false; }
        float wt[9][8];
#pragma unroll
        for (int k = 0; k < 9; ++k) { const f32x4 w0 = *(const f32x4*)(cw + k * DFF + c), w1 = *(const f32x4*)(cw + k * DFF + c + 4);
#pragma unroll
            for (int i = 0; i < 4; ++i) { wt[k][i] = w0[i]; wt[k][4 + i] = w1[i]; } }
        const bf16_t* base = av + (size_t)row0 * NAV + c;
        const long rstep = (long)W * NAV;
        u32x4 win[3][3];
        const u32x4 zero4 = (u32x4){0u, 0u, 0u, 0u};
        const bool rok[3] = {up, true, dn};
#pragma unroll
        for (int r = 0; r < 3; ++r) { const bf16_t* rp = base + (long)(r - 1) * rstep;
            win[r][1] = (rok[r] && x0 > 0) ? *(const u32x4*)(rp + (long)(x0 - 1) * NAV) : zero4;
            win[r][2] = rok[r] ? *(const u32x4*)(rp + (long)x0 * NAV) : zero4; }
        u32x4 nw[2][3], vv[2];
#define CG_LOAD(XB) do { _Pragma("unroll") for (int j = 0; j < 2; ++j) { _Pragma("unroll") for (int r = 0; r < 3; ++r) \
            nw[j][r] = (rok[r] && ((XB) + j + 1 < W) && ((XB) + j < x0 + CSEG)) ? *(const u32x4*)(base + (long)(r - 1) * rstep + (long)((XB) + j + 1) * NAV) : zero4; \
            vv[j] = ((XB) + j < x0 + CSEG) ? *(const u32x4*)(base + (long)((XB) + j) * NAV + DFF) : zero4; } } while (0)
        CG_LOAD(x0);
        for (int xb = x0; xb < x0 + CSEG; xb += 2) {
            u32x4 cw_[2][3], cv[2];
#pragma unroll
            for (int j = 0; j < 2; ++j) { cv[j] = vv[j];
#pragma unroll
                for (int r = 0; r < 3; ++r) cw_[j][r] = nw[j][r]; }
            CG_LOAD(xb + 2);
#pragma unroll
            for (int j = 0; j < 2; ++j) {
                float acc[8];
#pragma unroll
                for (int i = 0; i < 8; ++i) acc[i] = 0.f;
#pragma unroll
                for (int r = 0; r < 3; ++r) { win[r][0] = win[r][1]; win[r][1] = win[r][2]; win[r][2] = cw_[j][r];
#pragma unroll
                    for (int dx = 0; dx < 3; ++dx) { float f8[8]; unpack8(win[r][dx], f8);
#pragma unroll
                        for (int i = 0; i < 8; ++i) acc[i] += f8[i] * wt[r * 3 + dx][i]; } }
                float v8[8]; unpack8(cv[j], v8);
#pragma unroll
                for (int i = 0; i < 8; ++i) v8[i] = (VAR == 2) ? acc[i] * v8[i] : acc[i] * __builtin_amdgcn_rcpf(1.0f + __expf(-acc[i])) * v8[i];
                if (VAR != 3 || acc[0] == 12345.f) *(u32x4*)(gout + (size_t)(row0 + xb + j) * DFF + c) = pack8(v8); }
        }
#undef CG_LOAD
    }
}

#ifndef PROBE_MASK
#define PROBE_MASK 0u
#endif
#ifndef PROBE_MULT
#define PROBE_MULT 1
#endif
#define PT0(id) do { if (PROBE_MASK & (1u << (id))) pt0 = wall_clock64(); } while (0)
#define PT1(id) do { if (PROBE_MASK & (1u << (id))) pacc += wall_clock64() - pt0; } while (0)
__global__ void __launch_bounds__(512, 2) fwd(Args args) {
    extern __shared__ __attribute__((aligned(16))) unsigned char lds_raw[];
    Frame F;
    F.lds = (LAS unsigned char*)lds_raw; F.ws = args.ws; F.in = args.in; F.out = args.out;
    F.tid = threadIdx.x; F.lane = F.tid & 63; F.wave = __builtin_amdgcn_readfirstlane(F.tid >> 6); F.G = gridDim.x; F.bx = blockIdx.x;
    volatile LAS unsigned* misc = (volatile LAS unsigned*)(F.lds + MISC_OFF);
    if (F.tid < 4) misc[F.tid] = 0u;
    __syncthreads();
    XcdBarrier bar = xcd_barrier_post((unsigned*)(F.ws + WS_CTL), misc);
    unsigned char* ws = F.ws; int bx = F.bx;
#define mods ((float*)(ws + WS_MODS))
#define xres ((bf16_t*)(ws + WS_XRES))
#define hA ((bf16_t*)(ws + WS_HA))
#define P ((bf16_t*)(ws + WS_P))
#define small ((float*)(ws + WS_SMALL))

    unsigned long long pt0 = 0, pacc = 0; (void)pt0;
    PT0(0);
#ifndef SK_MODS
    phase_mods(F);
#endif
    PT1(0);
    for (int l = 0; l < DEPTH; ++l) {
        const bool last = (l == DEPTH - 1);
        const int Mrows = last ? RL : R;
        const float* mods_l = mods + (size_t)l * 9 * 12288;
        PT0(1);
#ifndef SK_W
        if (l == 0) phase_weights(F, 0, 0, bx, F.G);
#endif
        PT1(1);
        if (l == 0) { PT0(0); xcd_barrier(bar); phase_mods_reduce(F); xcd_barrier(bar); PT1(0); }
        PT0(2);
        if (l == 0) phase_norm<true>(F, F.in[I_X], F.in[I_CTX], xres, F.in[I_N1W] + l * D, mods_l, 0, hA, R);
        else phase_norm<false>(F, xres, xres + (size_t)RL * D, nullptr, F.in[I_N1W] + l * D, mods_l, 0, hA, R);
        xcd_barrier(bar);
        { size_t wz_ = 0; asm volatile("" : "+s"(wz_)); ws = F.ws + wz_; } asm volatile("" : "+s"(bx));
        PT1(2);
        PT0(3);
        { pg8::Sched S; S.init(hA, D, 0, ws + WS_WIN, D, 0, last ? RL : R, NIN, 1, F.G, bx);
          if (last) { S.xtra = 8 * 15; S.xpm0 = RL / 256; }
          pg8::EpiInProj E{P, small};
#if !defined(SK_GEMM) && !defined(SK_GEMM0)
          pg8::gemm_phase<decltype(E), 4>(F.lds, D, D, D, S, E);
#endif
          }
        { const int TAIL = (last ? (RL / 256 * (NIN / 256) + 8 * 15) : (R / 256 * (NIN / 256))) % 256;
          if (F.G == 256 && bx >= TAIL) phase_weights(F, l, 1, bx - TAIL, 256 - TAIL); else if (F.G != 256) phase_weights(F, l, 1, bx, F.G); }
        xcd_barrier(bar);
        { size_t wz_ = 0; asm volatile("" : "+s"(wz_)); ws = F.ws + wz_; } asm volatile("" : "+s"(bx));
        PT1(3);
        PT0(4);
#ifndef SK_GLAPREP
        { int tid_ = F.tid; asm volatile("" : "+v"(tid_)); int hdprev = -1;
          f32x4 lrv_ = (f32x4){0.f, 0.f, 0.f, 0.f}; if (bx < NB * NCH * 4 * 2) lrv_ = gla_lr_load(ws, (bx >> 3) / NCH, (bx >> 3) % NCH, bx & 1, tid_);
          for (int u = bx; u < NB * NCH * 4 * 2; u += F.G) { const int d = u & 1, h = (u >> 1) & 3, ch = (u >> 3) % NCH, b = (u >> 3) / NCH, un = u + F.G;
            const bool hn = un < NB * NCH * 4 * 2 && (un & 7) == (u & 7);
            gla_prep_unit(F, l, b, ch, h, d, lrv_, (u & 7) != hdprev, hn, (un >> 3) / NCH, (un >> 3) % NCH); hdprev = u & 7;
            if (!hn && un < NB * NCH * 4 * 2) lrv_ = gla_lr_load(ws, (un >> 3) / NCH, (un >> 3) % NCH, un & 1, tid_); } }
#endif
        PT1(4); PT0(5);
#ifndef SK_GDNPREP
        { int hprev = -1;
          for (int u = bx; u < NB * NCH * 8; u += F.G) { const int h = u & 7, ch = (u >> 3) % NCH, b = (u >> 3) / NCH; const unsigned long long dt_ = gdn_prep_unit(F, l, b, ch, h, h != hprev); hprev = h; if (PROBE_GDN) pacc += dt_; } }
#endif
        xcd_barrier(bar);
        { size_t wz_ = 0; asm volatile("" : "+s"(wz_)); ws = F.ws + wz_; } asm volatile("" : "+s"(bx));
        PT1(5);
        PT0(6);
#if !defined(SK_GLASCAN) && !defined(SK_GDNSCAN)
        for (int u = bx; u < 256; u += F.G) { const int xx = u & 7, yy = u >> 3; scan_pair_unit(F, (((yy >> 2) * 8 + xx) << 2) | (yy & 3), (((yy >> 1) * 8 + xx) << 1) | (yy & 1)); }
#endif
        PT1(6); PT0(7);
        xcd_barrier(bar);
        { size_t wz_ = 0; asm volatile("" : "+s"(wz_)); ws = F.ws + wz_; } asm volatile("" : "+s"(bx));
        PT1(7);
        PT0(8);
#ifndef SK_MERGE
        phase_merge_prep(F, l, Mrows);
#endif
        xcd_barrier(bar);
        { size_t wz_ = 0; asm volatile("" : "+s"(wz_)); ws = F.ws + wz_; } asm volatile("" : "+s"(bx));
        PT1(8);
        PT0(9);
        PT1(9); PT0(10);
        if (!last) { pg8::Sched S; S.init(ws + WS_Y3, 3072, 0, ws + WS_WBR, 3072, 0, Mrows, D, 1, F.G, bx, 192);
          pg8::EpiBranch<3> E{P, hA};
          pg8::gemm_phase<decltype(E), 3>(F.lds, 3072, 3072, 3072, S, E); }
        else { pg8::Sched S; S.init(ws + WS_Y3, 3072, 0, ws + WS_WBR, 3072, 0, Mrows, D, 1, F.G, bx);
          pg8::EpiBranch<4> E{P, hA};
          pg8::gemm_phase<decltype(E), 4>(F.lds, 3072, 3072, 3072, S, E); }
        xcd_barrier(bar);
        { size_t wz_ = 0; asm volatile("" : "+s"(wz_)); ws = F.ws + wz_; } asm volatile("" : "+s"(bx));
        PT1(10);
        PT0(12);
        if (!last) { pg8::Sched S; S.init(hA, D, 0, ws + WS_WOUT, D, 0, Mrows, D, 1, F.G, bx, 192);
          pg8::EpiResid<3> E{xres, mods_l + 2 * D};
          pg8::gemm_phase<decltype(E), 3>(F.lds, D, D, D, S, E); }
        else { pg8::Sched S; S.init(hA, D, 0, ws + WS_WOUT, D, 0, Mrows, D, 1, F.G, bx);
          pg8::EpiResid<4> E{xres, mods_l + 2 * D};
          pg8::gemm_phase<decltype(E), 4>(F.lds, D, D, D, S, E); }
        xcd_barrier(bar);
        { size_t wz_ = 0; asm volatile("" : "+s"(wz_)); ws = F.ws + wz_; } asm volatile("" : "+s"(bx));
        PT1(12);
        PT0(13);
        phase_norm<false>(F, xres, xres + (size_t)RL * D, nullptr, F.in[I_N2W] + l * D, mods_l, 3, hA, Mrows);
        xcd_barrier(bar);
        { size_t wz_ = 0; asm volatile("" : "+s"(wz_)); ws = F.ws + wz_; } asm volatile("" : "+s"(bx));
        PT1(13);
        PT0(14);
        { pg8::Sched S; S.init(hA, D, 0, ws + WS_WUP, D, 0, Mrows, NAV, 1, F.G, bx);
          pg8::EpiBf16 E{(bf16_t*)(ws + WS_AV), NAV};
#if !defined(SK_GEMM) && !defined(SK_GEMM6)
          pg8::gemm_phase<decltype(E), 4>(F.lds, D, D, D, S, E);
#endif
          }
        if (!last) { constexpr int TAIL = (R / 256 * (NAV / 256)) % 256;
          if (F.G == 256 && bx >= TAIL) phase_weights(F, l + 1, 0, bx - TAIL, 256 - TAIL); else if (F.G != 256) phase_weights(F, l + 1, 0, bx, F.G); }
        xcd_barrier(bar);
        { size_t wz_ = 0; asm volatile("" : "+s"(wz_)); ws = F.ws + wz_; } asm volatile("" : "+s"(bx));
        PT1(14);
        PT0(15);
#ifndef SK_CONV
        phase_convglu<0>(F, l, Mrows);
#if defined(CONV_ABL)
        phase_convglu<CONV_ABL>(F, l, Mrows);
#endif
#endif
        xcd_barrier(bar);
        { size_t wz_ = 0; asm volatile("" : "+s"(wz_)); ws = F.ws + wz_; } asm volatile("" : "+s"(bx));
        PT1(15);
        PT0(16);
        if (!last) { pg8::Sched S; S.init(ws + WS_G, DFF, 0, ws + WS_WDN, DFF, 0, Mrows, D, 1, F.G, bx, 192);
          pg8::EpiResid<3> E{xres, mods_l + 5 * D};
          pg8::gemm_phase<decltype(E), 3>(F.lds, DFF, DFF, DFF, S, E); }
        else { pg8::Sched S; S.init(ws + WS_G, DFF, 0, ws + WS_WDN, DFF, 0, Mrows, D, 1, F.G, bx);
          pg8::EpiResid<4> E{xres, mods_l + 5 * D};
          pg8::gemm_phase<decltype(E), 4>(F.lds, DFF, DFF, DFF, S, E); }
        xcd_barrier(bar);
        { size_t wz_ = 0; asm volatile("" : "+s"(wz_)); ws = F.ws + wz_; } asm volatile("" : "+s"(bx));
        PT1(16);
    }
    if (PROBE_MASK || PROBE_GDN) { const unsigned long long w0 = wall_clock64(); while (wall_clock64() - w0 < pacc * PROBE_MULT) __builtin_amdgcn_s_sleep(8); }
    phase_final_norm(F, xres, F.in[I_FINALW], F.out);
#undef mods
#undef xres
#undef hA
#undef P
#undef small
}

extern "C" void kernel_launch(void* const* d_in, const int* in_sizes, int n_in, void* d_out, int out_size, void* d_ws, size_t ws_size, hipStream_t stream) {
    static int grid = 0;
    if (grid == 0) {
        if (n_in != 26 || in_sizes[0] != RL * D || out_size != RL * D || ws_size < WS_END) { fprintf(stderr, "kernel_launch: unexpected shapes / workspace (%zu needed, %zu given)\n", (size_t)WS_END, ws_size); grid = -1; return; }
        int dev = 0, cus = 0, per_cu = 0;
        if (hipGetDevice(&dev) != hipSuccess || hipDeviceGetAttribute(&cus, hipDeviceAttributeMultiprocessorCount, dev) != hipSuccess) { grid = -1; return; }
        if (hipFuncSetAttribute((const void*)fwd, hipFuncAttributeMaxDynamicSharedMemorySize, LDS_BYTES) != hipSuccess) { fprintf(stderr, "kernel_launch: hipFuncSetAttribute failed\n"); grid = -1; return; }
        if (hipOccupancyMaxActiveBlocksPerMultiprocessor(&per_cu, (const void*)fwd, NTHR, LDS_BYTES) != hipSuccess || per_cu < 1) { fprintf(stderr, "kernel_launch: occupancy query says %d\n", per_cu); (void)hipGetLastError(); grid = -1; return; }
        grid = cus;
    }
    if (grid < 0) return;
    if (hipMemsetAsync((char*)d_ws + WS_CTL, 0, ZERO_BYTES, stream) != hipSuccess) return;
    Args a{};
    for (int i = 0; i < 26; ++i) a.in[i] = (const float*)d_in[i];
    a.out = (float*)d_out; a.ws = (unsigned char*)d_ws;
    hipLaunchKernelGGL(fwd, dim3(grid), dim3(NTHR), LDS_BYTES, stream, a);
}
```
